# Optimizing an MI355X kernel written in HIP

```python
import jax, jax.numpy as jnp
from jax import lax
import numpy as np

D_MODEL = 1024
BATCH = 4
SEQ = 4096
DEPTH = 2

D_MIX = D_MODEL
D_LRU = D_MIX // 2
LRU_HEADS = 8
LRU_HEAD_DIM = D_LRU // LRU_HEADS
CONV_WIDTH = 4
LRU_C = 8.0
D_HGRN = D_MIX - D_LRU
HGRN_HEADS = 8
HGRN_HEAD_DIM = D_HGRN // HGRN_HEADS
HGRN_CHUNK = 64
N_GROUPS = 4
EXPERTS_PER_GROUP = 8
N_EXPERTS = N_GROUPS * EXPERTS_PER_GROUP
TOP_K = 2
D_EXPERT = D_MODEL // 2
MOE_BLOCK = 128
NORM_EPS = 1e-6
PROJ_WIDTH = 2 * D_LRU + 5 * D_HGRN

kernel_name = 'hybrid_rglru_hgrn2_hmoe_encoder'


def rms_norm(x, w):
    xf = x.astype(jnp.float32)
    y = xf * lax.rsqrt(jnp.mean(xf * xf, axis=-1, keepdims=True) + NORM_EPS)
    return (y * w.astype(jnp.float32)).astype(x.dtype)


def centred_depthwise_conv(x, w, b):
    pad_l = CONV_WIDTH // 2
    pad_r = CONV_WIDTH - 1 - pad_l
    y = lax.conv_general_dilated(x, w[:, None, :].astype(x.dtype), window_strides=(1,),
                                 padding=[(pad_l, pad_r)], dimension_numbers=('NWC', 'WIO', 'NWC'),
                                 feature_group_count=x.shape[-1])
    return y + b.astype(x.dtype)


def linear_scan(a, b, reverse):
    def combine(left, right):
        a_l, b_l = left
        a_r, b_r = right
        return a_l * a_r, a_r * b_l + b_r
    _, h = lax.associative_scan(combine, (a, b), reverse=reverse, axis=1)
    return h


def rg_lru_direction(xc, wa, ba, wx, bx, lam, reverse):
    bsz, seq, _ = xc.shape
    xh = xc.reshape(bsz, seq, LRU_HEADS, LRU_HEAD_DIM)
    r = jax.nn.sigmoid(jnp.einsum('bshi,hij->bshj', xh, wa).reshape(bsz, seq, D_LRU) + ba)
    i = jax.nn.sigmoid(jnp.einsum('bshi,hij->bshj', xh, wx).reshape(bsz, seq, D_LRU) + bx)
    log_a = -LRU_C * r * jax.nn.softplus(-lam)
    u = jnp.sqrt(-jnp.expm1(2.0 * log_a)) * (i * xc)
    return linear_scan(jnp.exp(log_a), u, reverse)


def hgrn2_chunkwise(q, k, v, log_f):
    bsz, seq, heads, dk = q.shape
    dv = v.shape[-1]
    n_chunks = seq // HGRN_CHUNK

    def to_chunks(t):
        return t.reshape(bsz, n_chunks, HGRN_CHUNK, heads, t.shape[-1]).transpose(1, 0, 3, 2, 4)

    incl = jnp.tril(jnp.ones((HGRN_CHUNK, HGRN_CHUNK), dtype=bool))[:, :, None]

    def step(state, chunk):
        qc, kc, vc, lf = chunk
        b = jnp.cumsum(lf, axis=2)
        inter = jnp.einsum('bhtd,bhde->bhte', qc * jnp.exp(b), state)
        diff = b[:, :, :, None, :] - b[:, :, None, :, :]
        decay = jnp.exp(jnp.where(incl, diff, -jnp.inf))
        scores = jnp.einsum('bhtd,bhsd,bhtsd->bhts', qc, kc, decay)
        intra = jnp.einsum('bhts,bhse->bhte', scores, vc)
        b_last = b[:, :, -1:, :]
        new_state = (jnp.exp(b_last[:, :, 0, :])[..., None] * state
                     + jnp.einsum('bhsd,bhse->bhde', kc * jnp.exp(b_last - b), vc))
        return new_state, inter + intra

    state0 = jnp.zeros((bsz, heads, dk, dv), jnp.float32)
    _, o = lax.scan(step, state0, (to_chunks(q), to_chunks(k), to_chunks(v), to_chunks(log_f)))
    return o.transpose(1, 0, 3, 2, 4).reshape(bsz, seq, heads, dv)


def hgrn2_direction(q, v, f_logit, lb, reverse):
    f = lb + (1.0 - lb) * jax.nn.sigmoid(f_logit)
    log_f = jnp.log(f)
    k = 1.0 - f
    if reverse:
        flip = lambda t: jnp.flip(t, axis=1)
        return flip(hgrn2_chunkwise(flip(q), flip(k), flip(v), flip(log_f)))
    return hgrn2_chunkwise(q, k, v, log_f)


def hybrid_mixer(h, w_in, conv_w, conv_b, lru_wa, lru_ba, lru_wx, lru_bx, lru_lambda,
                 norm_lru_w, lb, norm_hgrn_w, w_out):
    f32 = jnp.float32
    bsz, seq, _ = h.shape
    proj = h @ w_in
    cuts = [D_LRU, 2 * D_LRU, 2 * D_LRU + D_HGRN, 2 * D_LRU + 2 * D_HGRN,
            2 * D_LRU + 3 * D_HGRN, 2 * D_LRU + 4 * D_HGRN]
    x_lru, y_lru, q, f_fwd, f_bwd, v_in, g = jnp.split(proj, cuts, axis=-1)

    xc = centred_depthwise_conv(x_lru, conv_w, conv_b).astype(f32)
    lru = (rg_lru_direction(xc, lru_wa[0].astype(f32), lru_ba[0].astype(f32), lru_wx[0].astype(f32),
                            lru_bx[0].astype(f32), lru_lambda[0].astype(f32), False)
           + rg_lru_direction(xc, lru_wa[1].astype(f32), lru_ba[1].astype(f32), lru_wx[1].astype(f32),
                              lru_bx[1].astype(f32), lru_lambda[1].astype(f32), True))
    lru = rms_norm(lru * jax.nn.gelu(y_lru.astype(f32)), norm_lru_w)

    heads = lambda t: t.astype(f32).reshape(bsz, seq, HGRN_HEADS, HGRN_HEAD_DIM)
    qh, vh = heads(q), heads(v_in)
    lbh = lb.astype(f32).reshape(HGRN_HEADS, HGRN_HEAD_DIM)
    hg = hgrn2_direction(qh, vh, heads(f_fwd), lbh, False) + hgrn2_direction(qh, vh, heads(f_bwd), lbh, True)
    hg = rms_norm(hg, norm_hgrn_w.reshape(HGRN_HEADS, HGRN_HEAD_DIM)) * jax.nn.silu(heads(g))

    merged = jnp.concatenate([lru, hg.reshape(bsz, seq, D_HGRN)], axis=-1).astype(h.dtype)
    return merged @ w_out


def hierarchical_moe(h, wg_r, bg_r, we_r, be_r, w_gate, w_up, w_down):
    f32 = jnp.float32
    bsz, seq, d = h.shape
    xf = h.reshape(-1, d)
    m = xf.shape[0]
    g_logits = (xf @ wg_r + bg_r).astype(f32)
    g_idx = jnp.argmax(g_logits, axis=-1)
    p_group = jnp.take_along_axis(jax.nn.softmax(g_logits, axis=-1), g_idx[:, None], axis=1)[:, 0]
    e_logits = (xf @ we_r + be_r).astype(f32).reshape(m, N_GROUPS, EXPERTS_PER_GROUP)
    e_in_g = jnp.take_along_axis(e_logits, g_idx[:, None, None], axis=1)[:, 0]
    top_v, top_i = lax.top_k(e_in_g, TOP_K)
    w_tok = p_group[:, None] * jax.nn.softmax(top_v, axis=-1)
    expert = g_idx[:, None] * EXPERTS_PER_GROUP + top_i

    n_assign = m * TOP_K
    e_flat = expert.reshape(-1).astype(jnp.int32)
    tok_flat = jnp.repeat(jnp.arange(m, dtype=jnp.int32), TOP_K)
    w_flat = w_tok.reshape(-1)
    order = jnp.argsort(e_flat)
    e_s, tok_s, w_s = e_flat[order], tok_flat[order], w_flat[order]
    counts = jnp.bincount(e_flat, length=N_EXPERTS).astype(jnp.int32)
    start = jnp.cumsum(counts) - counts
    padded = ((counts + MOE_BLOCK - 1) // MOE_BLOCK) * MOE_BLOCK
    pend = jnp.cumsum(padded)
    pstart = pend - padded
    dest = pstart[e_s] + (jnp.arange(n_assign, dtype=jnp.int32) - start[e_s])
    n_rows = n_assign + N_EXPERTS * MOE_BLOCK
    n_blocks = n_rows // MOE_BLOCK
    tok_buf = jnp.zeros((n_rows,), jnp.int32).at[dest].set(tok_s)
    w_buf = jnp.zeros((n_rows,), f32).at[dest].set(w_s)
    blk_start = jnp.arange(n_blocks, dtype=jnp.int32) * MOE_BLOCK
    blk_expert = jnp.minimum(jnp.sum(pend[None, :] <= blk_start[:, None], axis=1), N_EXPERTS - 1)
    x_buf = xf[tok_buf].reshape(n_blocks, MOE_BLOCK, d)

    def expert_block(args):
        xb, e = args
        return (jax.nn.silu(xb @ w_gate[e]) * (xb @ w_up[e])) @ w_down[e]

    y_buf = lax.map(expert_block, (x_buf, blk_expert)).reshape(n_rows, d)
    y = jnp.zeros((m, d), h.dtype).at[tok_buf].add((y_buf * w_buf[:, None]).astype(h.dtype))
    return y.reshape(bsz, seq, d)


def setup_inputs(seed: int = 0) -> dict:
    key = jax.random.key(seed)
    ks = jax.random.split(key, 26)
    f32 = jnp.float32
    nrm = lambda k, shape, scale: jax.random.normal(k, shape, f32) * scale
    a_lo = 0.9 ** (1.0 / LRU_C)
    a_hi = 0.999 ** (1.0 / LRU_C)
    a0 = jax.random.uniform(ks[12], (DEPTH, 2, D_LRU), f32, minval=a_lo, maxval=a_hi)
    return {
        'x': nrm(ks[0], (BATCH, SEQ, D_MODEL), 1.0),
        'c': nrm(ks[1], (BATCH, D_MODEL), 1.0),
        'ada_w': nrm(ks[2], (DEPTH, D_MODEL, 6 * D_MODEL), 0.5 * D_MODEL ** -0.5),
        'ada_b': nrm(ks[3], (DEPTH, 6 * D_MODEL), 0.02),
        'norm_mix_w': 1.0 + nrm(ks[4], (DEPTH, D_MODEL), 0.02),
        'w_in': nrm(ks[5], (DEPTH, D_MODEL, PROJ_WIDTH), D_MODEL ** -0.5),
        'conv_w': nrm(ks[6], (DEPTH, CONV_WIDTH, D_LRU), 0.5),
        'conv_b': nrm(ks[7], (DEPTH, D_LRU), 0.02),
        'lru_wa': nrm(ks[8], (DEPTH, 2, LRU_HEADS, LRU_HEAD_DIM, LRU_HEAD_DIM), LRU_HEAD_DIM ** -0.5),
        'lru_ba': nrm(ks[9], (DEPTH, 2, D_LRU), 0.02),
        'lru_wx': nrm(ks[10], (DEPTH, 2, LRU_HEADS, LRU_HEAD_DIM, LRU_HEAD_DIM), LRU_HEAD_DIM ** -0.5),
        'lru_bx': nrm(ks[11], (DEPTH, 2, D_LRU), 0.02),
        'lru_lambda': jnp.log(a0) - jnp.log1p(-a0),
        'norm_lru_w': 1.0 + nrm(ks[13], (DEPTH, D_LRU), 0.02),
        'hgrn_lb': nrm(ks[14], (DEPTH, D_HGRN), 0.5),
        'norm_hgrn_w': 1.0 + nrm(ks[15], (DEPTH, D_HGRN), 0.02),
        'w_out': nrm(ks[16], (DEPTH, D_MIX, D_MODEL), D_MIX ** -0.5),
        'norm_ffn_w': 1.0 + nrm(ks[17], (DEPTH, D_MODEL), 0.02),
        'router_group_w': nrm(ks[18], (DEPTH, D_MODEL, N_GROUPS), D_MODEL ** -0.5),
        'router_group_b': nrm(ks[19], (DEPTH, N_GROUPS), 0.01),
        'router_expert_w': nrm(ks[20], (DEPTH, D_MODEL, N_EXPERTS), D_MODEL ** -0.5),
        'router_expert_b': nrm(ks[21], (DEPTH, N_EXPERTS), 0.01),
        'expert_w_gate': nrm(ks[22], (DEPTH, N_EXPERTS, D_MODEL, D_EXPERT), D_MODEL ** -0.5),
        'expert_w_up': nrm(ks[23], (DEPTH, N_EXPERTS, D_MODEL, D_EXPERT), D_MODEL ** -0.5),
        'expert_w_down': nrm(ks[24], (DEPTH, N_EXPERTS, D_EXPERT, D_MODEL), D_EXPERT ** -0.5),
        'final_norm_w': 1.0 + nrm(ks[25], (D_MODEL,), 0.02),
    }


def reference(x, c, ada_w, ada_b, norm_mix_w, w_in, conv_w, conv_b, lru_wa, lru_ba, lru_wx, lru_bx,
              lru_lambda, norm_lru_w, hgrn_lb, norm_hgrn_w, w_out, norm_ffn_w, router_group_w,
              router_group_b, router_expert_w, router_expert_b, expert_w_gate, expert_w_up,
              expert_w_down, final_norm_w):
    lb_cum = jnp.cumsum(jax.nn.softmax(hgrn_lb.astype(jnp.float32), axis=0), axis=0)
    lb_all = lb_cum - lb_cum[0:1]
    cond = jax.nn.silu(c)
    for l in range(DEPTH):
        mod = (cond @ ada_w[l] + ada_b[l])[:, None, :]
        sh_mix, sc_mix, g_mix, sh_ffn, sc_ffn, g_ffn = jnp.split(mod, 6, axis=-1)
        h = rms_norm(x, norm_mix_w[l]) * (1.0 + sc_mix) + sh_mix
        x = x + g_mix * hybrid_mixer(h, w_in[l], conv_w[l], conv_b[l], lru_wa[l], lru_ba[l], lru_wx[l],
                                     lru_bx[l], lru_lambda[l], norm_lru_w[l], lb_all[l], norm_hgrn_w[l],
                                     w_out[l])
        h = rms_norm(x, norm_ffn_w[l]) * (1.0 + sc_ffn) + sh_ffn
        x = x + g_ffn * hierarchical_moe(h, router_group_w[l], router_group_b[l], router_expert_w[l],
                                         router_expert_b[l], expert_w_gate[l], expert_w_up[l],
                                         expert_w_down[l])
    return rms_norm(x, final_norm_w)
```

```cpp
#include <hip/hip_runtime.h>
#include <stdint.h>
#include <stdio.h>

#ifndef MK_PER_PHASE
#define MK_PER_PHASE 0
#endif

#define LAS __attribute__((address_space(3)))
typedef unsigned short bf16_t;
typedef short bf16x8 __attribute__((ext_vector_type(8)));
typedef float f32x4 __attribute__((ext_vector_type(4)));
typedef float f32x2 __attribute__((ext_vector_type(2)));
typedef unsigned u32x4 __attribute__((ext_vector_type(4)));
typedef unsigned u32x2 __attribute__((ext_vector_type(2)));

constexpr int NB = 4, SEQ = 4096, DM = 1024, MTOK = NB * SEQ, DEPTH = 2;
constexpr int DLRU = 512, DHG = 512, PROJ = 3584, NEXP = 32, DEXP = 512, NGRP = 4, EPG = 8;
constexpr int MPAD = 40960;
constexpr float NORM_EPS = 1e-6f;
constexpr int NWAVES = 8, NTHREADS = 512;

constexpr size_t WS_CTL = 0;
constexpr size_t CTL_ZERO_BYTES = 32768;
constexpr size_t CTL_CNT_OFF = 16384;
constexpr size_t WS_MOD = 65536;
constexpr size_t WS_WIN = WS_MOD + 196608;
constexpr size_t WS_WOUT = WS_WIN + (size_t)DEPTH * PROJ * DM * 2;
constexpr size_t WS_WGU = WS_WOUT + (size_t)DEPTH * DM * DM * 2;
constexpr size_t WS_WD = WS_WGU + (size_t)DEPTH * NEXP * 1024 * 1024 * 2;
constexpr size_t WS_R1 = WS_WD + (size_t)DEPTH * NEXP * 1024 * 512 * 2;
constexpr size_t WS_R2 = WS_R1 + (size_t)MTOK * PROJ * 2;
constexpr size_t WS_R3 = WS_R2 + (size_t)MPAD * 512 * 2;
constexpr size_t WS_XA = WS_R3 + (size_t)MTOK * DM * 2;
constexpr size_t WS_TOKINFO = WS_XA + (size_t)MTOK * DM * 4;
constexpr size_t WS_TOKW = WS_TOKINFO + (size_t)MTOK * 16;
constexpr size_t WS_ROWTOK = WS_TOKW + (size_t)MTOK * 8;
constexpr size_t WS_ROWW = WS_ROWTOK + (size_t)MPAD * 4;
constexpr size_t WS_END = WS_ROWW + (size_t)MPAD * 4;

constexpr int LDS_STAGE = 131072;
constexpr int LDS_MISC = LDS_STAGE;
constexpr int LDS_BYTES = LDS_STAGE + 2048;

#define XB_TMO      128
#define XB_XCNT(j)  (256  + 64 * (j))
#define XB_XSUB(j)  (1280 + 64 * (j))
#define XB_XGEN(j)  (2304 + 64 * (j))
#define XB_TOP      3328
#define XB_TOPGEN   3392
#define XCD_BAR_WORDS 3456
#define XB_SPIN_CAP (1u << 22)

__device__ __forceinline__ unsigned xb_ld(unsigned* p)              { return __hip_atomic_load(p, __ATOMIC_RELAXED, __HIP_MEMORY_SCOPE_AGENT); }
__device__ __forceinline__ unsigned xb_add(unsigned* p, unsigned v) { return __hip_atomic_fetch_add(p, v, __ATOMIC_RELAXED, __HIP_MEMORY_SCOPE_AGENT); }
__device__ __forceinline__ unsigned xb_xcc_id() { return (unsigned)__builtin_amdgcn_s_getreg((3 << 11) | 20) & 0xFu; }
#define XB_SPIN(cond, bar) do { unsigned _sp = 0; while (cond) { __builtin_amdgcn_s_sleep(1); \
    if ((++_sp & 255u) == 0u) { if (xb_ld(&(bar)[XB_TMO])) break; if (_sp > XB_SPIN_CAP) { atomicAdd(&(bar)[XB_TMO], 1u); break; } } } } while (0)

struct XcdBarrier { unsigned* bar; unsigned x; volatile LAS unsigned* st; };

__device__ __forceinline__ XcdBarrier xcd_barrier_post(unsigned* bar, volatile LAS unsigned* st) {
    XcdBarrier b; b.bar = bar; b.x = xb_xcc_id(); b.st = st;
    if (threadIdx.x == 0) (void)xb_add(&bar[XB_XCNT(b.x)], 1u);
    return b;
}
__device__ __forceinline__ void xcd_barrier_complete(unsigned* bar, unsigned x, unsigned& nloc, unsigned& nx) {
    const unsigned G = gridDim.x * gridDim.y * gridDim.z;
    unsigned sum, cnt, mine, sp = 0u;
    for (;;) {
        sum = 0u; cnt = 0u; mine = 0u;
#pragma unroll
        for (unsigned j = 0; j < 16; ++j) { const unsigned c = xb_ld(&bar[XB_XCNT(j)]); sum += c; cnt += (c > 0u) ? 1u : 0u; mine = (j == x) ? c : mine; }
        if (sum == G) break;
        __builtin_amdgcn_s_sleep(1);
        if ((++sp & 255u) == 0u) { if (xb_ld(&bar[XB_TMO])) break; if (sp > XB_SPIN_CAP) { atomicAdd(&bar[XB_TMO], 1u); break; } }
    }
    nloc = mine > 0u ? mine : 1u; nx = cnt > 0u ? cnt : 1u;
}
__device__ __forceinline__ void xcd_barrier(const XcdBarrier& b) {
    asm volatile("s_waitcnt vmcnt(0)" ::: "memory");
    __syncthreads();
    if (threadIdx.x == 0) {
        unsigned* bar = b.bar;
        __builtin_amdgcn_s_waitcnt(0);
        unsigned nloc = b.st[0], nx = b.st[1];
        if (nloc == 0u) { xcd_barrier_complete(bar, b.x, nloc, nx); b.st[0] = nloc; b.st[1] = nx; }
        const unsigned old = xb_add(&bar[XB_XSUB(b.x)], 1u);
        const unsigned gen = old / nloc;
        if (old + 1u == (gen + 1u) * nloc) {
            __builtin_amdgcn_fence(__ATOMIC_RELEASE, "agent");
            asm volatile("s_waitcnt vmcnt(0)" ::: "memory");
            const unsigned og = xb_add(&bar[XB_TOP], 1u);
            const unsigned tg = og / nx;
            if (og + 1u == (tg + 1u) * nx) xb_add(&bar[XB_TOPGEN], 1u);
            else XB_SPIN(xb_ld(&bar[XB_TOPGEN]) == tg, bar);
            __builtin_amdgcn_fence(__ATOMIC_ACQUIRE, "agent");
            xb_add(&bar[XB_XGEN(b.x)], 1u);
            asm volatile("s_waitcnt vmcnt(0)" ::: "memory");
        } else {
            XB_SPIN(xb_ld(&bar[XB_XGEN(b.x)]) == gen, bar);
            __builtin_amdgcn_fence(__ATOMIC_ACQUIRE, "agent");
            asm volatile("s_waitcnt vmcnt(0)" ::: "memory");
        }
    }
    __syncthreads();
}

__device__ __forceinline__ float bf2f(bf16_t b) { return __uint_as_float(((unsigned)b) << 16); }
__device__ __forceinline__ bf16_t f2bf(float f) { unsigned u = __float_as_uint(f); u += 0x7FFFu + ((u >> 16) & 1u); return (bf16_t)(u >> 16); }
__device__ __forceinline__ unsigned cvt_pk_bf16(float lo, float hi) { unsigned r; asm volatile("v_cvt_pk_bf16_f32 %0, %1, %2" : "=v"(r) : "v"(lo), "v"(hi)); return r; }
__device__ __forceinline__ float wave_sum(float v) {
#pragma unroll
    for (int m = 32; m >= 1; m >>= 1) v += __shfl_xor(v, m, 64);
    return v;
}
__device__ __forceinline__ float sigmoidf_(float x) { return 1.0f / (1.0f + __expf(-x)); }
__device__ __forceinline__ float siluf_(float x) { return x * sigmoidf_(x); }
__device__ __forceinline__ float gelu_tanh(float x) {
    const float u = 0.7978845608028654f * (x + 0.044715f * x * x * x);
    const float t = 1.0f - 2.0f / (__expf(2.0f * u) + 1.0f);
    return 0.5f * x * (1.0f + t);
}
__device__ __forceinline__ float rdlane(float v, int l) { return __int_as_float(__builtin_amdgcn_readlane(__float_as_int(v), l)); }

namespace pg8 {
constexpr int BM = 256, BK = 64, HALF = 128, HTB = HALF * BK * 2, STAGE_BYTES = 8 * HTB, NXCD = 8, WGM = 8;
__host__ __device__ __forceinline__ int lds_byte(int r, int c) { const int st = (r >> 4) * 2 + (c >> 5), rr = r & 15, cc = c & 31, ob = rr * 64 + cc * 2; return st * 1024 + (ob ^ (((ob >> 9) & 1) << 5)); }
__host__ __device__ __forceinline__ void stage_rc(int b, int& R, int& C) { const int st = b / 1024, sb = b % 1024, swz = sb ^ (((sb >> 9) & 1) << 5); R = (st >> 1) * 16 + swz / 64; C = (st & 1) * 32 + (swz % 64) / 2; }
__host__ __device__ __forceinline__ int perm32(int rho) { const int n = rho >> 4, i = rho & 15; return 8 * (i >> 2) + 4 * n + (i & 3); }

struct Unit { int pm, pn; };
struct Gemm { const bf16_t* A; const bf16_t* Bt; int M, N, K; };

struct StaticOrder {
    int nM, nN, nwg, G, c;
    __host__ __device__ void init(int M, int N, int G_, int c_) { nM = M / BM; nN = N / BM; nwg = nM * nN; G = G_; c = c_; }
    __host__ __device__ bool next(int i, Unit& u) const {
        const long L = (long)i * G + c; if (L >= nwg) return false;
        int wgid = (int)L; { const int q = nwg / NXCD, r = nwg % NXCD, xcd = wgid % NXCD, off = wgid / NXCD; wgid = (xcd < r ? xcd * (q + 1) : r * (q + 1) + (xcd - r) * q) + off; }
        const int nig = WGM * nN, gid = wgid / nig, fm = gid * WGM, gsz = (nM - fm) < WGM ? (nM - fm) : WGM;
        u.pm = fm + ((wgid % nig) % gsz); u.pn = (wgid % nig) / gsz; return true;
    }
    __device__ __forceinline__ void a_ready(const Unit&) const {}
    __device__ __forceinline__ void done(const Unit&) const {}
};

struct MoeOrder {
    const LAS int* ulist;
    __device__ __forceinline__ bool next(int i, Unit& u) const {
        const int pm = __builtin_amdgcn_readfirstlane(ulist[2 * i]); if (pm < 0) return false;
        u.pm = pm; u.pn = __builtin_amdgcn_readfirstlane(ulist[2 * i + 1]); return true;
    }
    __device__ __forceinline__ void a_ready(const Unit&) const {}
    __device__ __forceinline__ void done(const Unit&) const {}
};

struct EpiBf16 {
    static constexpr bool PERM = true;
    bf16_t* O; int ldc;
    __device__ __forceinline__ void operator()(const f32x4 (&acc)[2][2][4][2], const Unit& u, int wr, int wc, int fr, int fq) const {
        const int row0 = u.pm * BM + wr * 64 + fr, col0 = u.pn * BM + wc * 32 + 8 * fq;
#pragma unroll
        for (int ai = 0; ai < 2; ++ai)
#pragma unroll
            for (int m = 0; m < 4; ++m) { bf16_t* rowp = O + (size_t)(row0 + ai * HALF + m * 16) * ldc + col0;
#pragma unroll
                for (int bj = 0; bj < 2; ++bj) { const f32x4 v0 = acc[ai][bj][m][0], v1 = acc[ai][bj][m][1];
                    u32x4 o; o[0] = cvt_pk_bf16(v0[0], v0[1]); o[1] = cvt_pk_bf16(v0[2], v0[3]); o[2] = cvt_pk_bf16(v1[0], v1[1]); o[3] = cvt_pk_bf16(v1[2], v1[3]);
                    *(u32x4*)(rowp + bj * HALF) = o; } }
    }
};
struct EpiResid {
    static constexpr bool PERM = false;
    const float* XI; float* XO; const float* gate;
    __device__ __forceinline__ void operator()(const f32x4 (&acc)[2][2][4][2], const Unit& u, int wr, int wc, int fr, int fq) const {
        const int row0 = u.pm * BM + wr * 64 + fr, col0 = u.pn * BM + wc * 32 + 4 * fq;
        const int b = (u.pm * BM) / SEQ;
        f32x4 gv[2][2];
#pragma unroll
        for (int bj = 0; bj < 2; ++bj)
#pragma unroll
            for (int n = 0; n < 2; ++n) gv[bj][n] = *(const f32x4*)(gate + (size_t)b * 6 * DM + col0 + bj * HALF + n * 16);
#pragma unroll
        for (int ai = 0; ai < 2; ++ai)
#pragma unroll
            for (int m = 0; m < 4; ++m) { const size_t ro = (size_t)(row0 + ai * HALF + m * 16) * DM + col0;
#pragma unroll
                for (int bj = 0; bj < 2; ++bj)
#pragma unroll
                    for (int n = 0; n < 2; ++n) { const f32x4 xi = *(const f32x4*)(XI + ro + bj * HALF + n * 16);
                        *(f32x4*)(XO + ro + bj * HALF + n * 16) = xi + gv[bj][n] * acc[ai][bj][m][n]; } }
    }
};
struct EpiGateUp {
    static constexpr bool PERM = true;
    bf16_t* H;
    __device__ __forceinline__ void operator()(const f32x4 (&acc)[2][2][4][2], const Unit& u, int wr, int wc, int fr, int fq) const {
        const int row0 = u.pm * BM + wr * 64 + fr, col0 = (u.pn & 3) * 128 + wc * 32 + 8 * fq;
#pragma unroll
        for (int ai = 0; ai < 2; ++ai)
#pragma unroll
            for (int m = 0; m < 4; ++m) { bf16_t* rowp = H + (size_t)(row0 + ai * HALF + m * 16) * DEXP + col0;
                float h[8];
#pragma unroll
                for (int n = 0; n < 2; ++n)
#pragma unroll
                    for (int q = 0; q < 4; ++q) { const float g = acc[ai][0][m][n][q], up = acc[ai][1][m][n][q]; h[n * 4 + q] = g / (1.0f + __expf(-g)) * up; }
                u32x4 o; o[0] = cvt_pk_bf16(h[0], h[1]); o[1] = cvt_pk_bf16(h[2], h[3]); o[2] = cvt_pk_bf16(h[4], h[5]); o[3] = cvt_pk_bf16(h[6], h[7]);
                *(u32x4*)rowp = o; }
    }
};
struct EpiDown {
    static constexpr bool PERM = true;
    bf16_t* Y; const int* rowtok; const float* roww;
    __device__ __forceinline__ void operator()(const f32x4 (&acc)[2][2][4][2], const Unit& u, int wr, int wc, int fr, int fq) const {
        const int row0 = u.pm * BM + wr * 64 + fr, col0 = (u.pn & 3) * BM + wc * 32 + 8 * fq;
#pragma unroll
        for (int ai = 0; ai < 2; ++ai)
#pragma unroll
            for (int m = 0; m < 4; ++m) { const int row = row0 + ai * HALF + m * 16; const int rt = rowtok[row];
                if (rt >= 0) { const float w = roww[row]; bf16_t* rowp = Y + (size_t)rt * DM + col0;
#pragma unroll
                    for (int bj = 0; bj < 2; ++bj) { const f32x4 v0 = acc[ai][bj][m][0] * w, v1 = acc[ai][bj][m][1] * w;
                        u32x4 o; o[0] = cvt_pk_bf16(v0[0], v0[1]); o[1] = cvt_pk_bf16(v0[2], v0[3]); o[2] = cvt_pk_bf16(v1[0], v1[1]); o[3] = cvt_pk_bf16(v1[2], v1[3]);
                        *(u32x4*)(rowp + bj * HALF) = o; } } }
    }
};

template <class Epi, class Sched>
__device__ __forceinline__ void gemm_phase(LAS unsigned char* lds, const Gemm g, const Sched& S, const Epi& E) {
    const int tid = threadIdx.x, wid = __builtin_amdgcn_readfirstlane(tid >> 6), lane = tid & 63, wr = wid >> 2, wc = wid & 3, fr = lane & 15, fq = lane >> 4;
    const int K = g.K, nt = K / BK;
    unsigned voffA[2], voffB[2];
#pragma unroll
    for (int i = 0; i < 2; ++i) { int R, C; stage_rc(tid * 16 + i * 8192, R, C); const int Rb = Epi::PERM ? ((R & ~31) + perm32(R & 31)) : R;
        voffA[i] = (unsigned)(R * K + C) * 2u; voffB[i] = (unsigned)(Rb * K + C) * 2u; }
    const size_t kstep = (size_t)(BK * 2);
    const size_t hstep = (size_t)HALF * K * 2;
    const size_t tstep = 2 * hstep;
    const unsigned ldsw = (unsigned)wid * 1024u;
    const int aoff = lds_byte(wr * 64 + fr, fq * 8), boff = lds_byte(wc * 32 + fr, fq * 8);
#define PG8_SA(b, h) (((b) * 2 + (h)) * HTB)
#define PG8_SB(b, h) ((4 + (b) * 2 + (h)) * HTB)
#define PG8_STAGE(bufoff, gbase, voff) do { _Pragma("unroll") for (int _i = 0; _i < 2; ++_i) \
        __builtin_amdgcn_global_load_lds((const unsigned*)((const char*)(gbase) + (voff)[_i]), (LAS unsigned*)(lds + (bufoff) + ldsw + _i * 8192), 16, 0, 0); } while (0)
#define PG8_LDA(dst, b, h) do { _Pragma("unroll") for (int m = 0; m < 4; ++m) _Pragma("unroll") for (int k = 0; k < 2; ++k) dst[m][k] = *(const LAS bf16x8*)(lds + PG8_SA(b, h) + aoff + m * 2048 + k * 1024); } while (0)
#define PG8_LDB(dst, b, h) do { _Pragma("unroll") for (int n = 0; n < 2; ++n) _Pragma("unroll") for (int k = 0; k < 2; ++k) dst[n][k] = *(const LAS bf16x8*)(lds + PG8_SB(b, h) + boff + n * 2048 + k * 1024); } while (0)
#define PG8_MMA(ai, bj, At, Bt) do { __builtin_amdgcn_s_setprio(1); _Pragma("unroll") for (int m = 0; m < 4; ++m) _Pragma("unroll") for (int n = 0; n < 2; ++n) _Pragma("unroll") for (int k = 0; k < 2; ++k) \
        acc[ai][bj][m][n] = __builtin_amdgcn_mfma_f32_16x16x32_bf16(Bt[n][k], At[m][k], acc[ai][bj][m][n], 0, 0, 0); __builtin_amdgcn_s_setprio(0); } while (0)
#define PG8_WAIT_V(n) asm volatile("s_waitcnt vmcnt(" #n ")" ::: "memory")
#define PG8_WAIT_L(n) asm volatile("s_waitcnt lgkmcnt(" #n ")" ::: "memory")
#define PG8_BAR __builtin_amdgcn_s_barrier()
#define PG8_SCHED __builtin_amdgcn_sched_barrier(0)
    Unit cur, nxt; int ui = 0;
    if (!S.next(0, cur)) return;
    f32x4 acc[2][2][4][2];
#pragma unroll
    for (int a = 0; a < 2; ++a)
#pragma unroll
        for (int b = 0; b < 2; ++b)
#pragma unroll
            for (int m = 0; m < 4; ++m)
#pragma unroll
                for (int n = 0; n < 2; ++n) acc[a][b][m][n] = (f32x4){0.f, 0.f, 0.f, 0.f};
    bf16x8 At[4][2], B0[2][2], B1[2][2];
    const char* cA = (const char*)g.A + (size_t)cur.pm * tstep; const char* cB = (const char*)g.Bt + (size_t)cur.pn * tstep;
    S.a_ready(cur);
    PG8_STAGE(PG8_SB(0, 0), cB, voffB); PG8_STAGE(PG8_SA(0, 0), cA, voffA); PG8_STAGE(PG8_SB(0, 1), cB + hstep, voffB); PG8_STAGE(PG8_SA(0, 1), cA + hstep, voffA);
    if (wr == 1) PG8_BAR;
    PG8_WAIT_V(4); PG8_BAR;
    PG8_STAGE(PG8_SB(1, 0), cB + kstep, voffB); PG8_STAGE(PG8_SA(1, 0), cA + kstep, voffA); PG8_STAGE(PG8_SB(1, 1), cB + hstep + kstep, voffB);
    PG8_WAIT_V(6); PG8_BAR;
    for (;;) {
        const bool has_next = S.next(ui + 1, nxt);
        const char* nA = has_next ? (const char*)g.A + (size_t)nxt.pm * tstep : cA; const char* nB = has_next ? (const char*)g.Bt + (size_t)nxt.pn * tstep : cB;
        for (int t = 0; t < nt; t += 2) {
            const bool last = (t == nt - 2);
            const char* a1 = cA + (size_t)(t + 1) * kstep;
            const char* a2 = last ? nA : cA + (size_t)(t + 2) * kstep; const char* b2 = last ? nB : cB + (size_t)(t + 2) * kstep;
            const char* a3 = a2 + kstep; const char* b3 = b2 + kstep;
            if (last && has_next) S.a_ready(nxt);
            PG8_LDB(B0, 0, 0); PG8_SCHED; PG8_LDA(At, 0, 0); PG8_STAGE(PG8_SA(1, 1), a1 + hstep, voffA);
            PG8_WAIT_L(8); PG8_BAR; PG8_WAIT_L(0); PG8_MMA(0, 0, At, B0); PG8_BAR; PG8_SCHED;
            PG8_LDB(B1, 0, 1); PG8_STAGE(PG8_SB(0, 0), b2, voffB);
            PG8_BAR; PG8_WAIT_L(0); PG8_MMA(0, 1, At, B1); PG8_BAR;
            PG8_LDA(At, 0, 1); PG8_STAGE(PG8_SA(0, 0), a2, voffA);
            PG8_BAR; PG8_WAIT_L(0); PG8_MMA(1, 0, At, B0); PG8_BAR; PG8_SCHED;
            PG8_STAGE(PG8_SB(0, 1), b2 + hstep, voffB);
            PG8_WAIT_V(6); PG8_BAR; PG8_MMA(1, 1, At, B1); PG8_BAR;
            PG8_LDB(B0, 1, 0); PG8_SCHED; PG8_LDA(At, 1, 0); PG8_STAGE(PG8_SA(0, 1), a2 + hstep, voffA);
            PG8_WAIT_L(8); PG8_BAR; PG8_WAIT_L(0); PG8_MMA(0, 0, At, B0); PG8_BAR; PG8_SCHED;
            PG8_LDB(B1, 1, 1); PG8_STAGE(PG8_SB(1, 0), b3, voffB);
            PG8_BAR; PG8_WAIT_L(0); PG8_MMA(0, 1, At, B1); PG8_BAR;
            PG8_LDA(At, 1, 1); PG8_STAGE(PG8_SA(1, 0), a3, voffA);
            PG8_BAR; PG8_WAIT_L(0); PG8_MMA(1, 0, At, B0); PG8_BAR; PG8_SCHED;
            PG8_STAGE(PG8_SB(1, 1), b3 + hstep, voffB);
            PG8_WAIT_V(6); PG8_BAR; PG8_MMA(1, 1, At, B1); PG8_BAR;
        }
        E(acc, cur, wr, wc, fr, fq); S.done(cur);
        if (!has_next) break;
#pragma unroll
        for (int a = 0; a < 2; ++a)
#pragma unroll
            for (int b = 0; b < 2; ++b)
#pragma unroll
                for (int m = 0; m < 4; ++m)
#pragma unroll
                    for (int n = 0; n < 2; ++n) acc[a][b][m][n] = (f32x4){0.f, 0.f, 0.f, 0.f};
        cur = nxt; cA = nA; cB = nB; ++ui;
    }
    PG8_WAIT_V(0);
    if (wr == 0) PG8_BAR;
    PG8_BAR;
#undef PG8_SA
#undef PG8_SB
#undef PG8_STAGE
#undef PG8_LDA
#undef PG8_LDB
#undef PG8_MMA
#undef PG8_WAIT_V
#undef PG8_WAIT_L
#undef PG8_BAR
#undef PG8_SCHED
}
}

struct Params {
    const float* x; const float* c; const float* ada_w; const float* ada_b; const float* norm_mix_w; const float* w_in; const float* conv_w; const float* conv_b;
    const float* lru_wa; const float* lru_ba; const float* lru_wx; const float* lru_bx; const float* lru_lambda; const float* norm_lru_w; const float* hgrn_lb;
    const float* norm_hgrn_w; const float* w_out; const float* norm_ffn_w; const float* rg_w; const float* rg_b; const float* re_w; const float* re_b;
    const float* e_gate; const float* e_up; const float* e_down; const float* final_w;
    float* out; unsigned char* ws;
    long long ph_lo, ph_hi;
};

typedef const __attribute__((address_space(4))) Params* KParams;
__device__ __forceinline__ KParams get_params() { KParams q = (KParams)__builtin_amdgcn_kernarg_segment_ptr(); asm volatile("" : "+s"(q)); return q; }

struct Ctx {
    LAS unsigned char* lds; int tid, lane, wave, G, gwave, nwaves;
};

__device__ __forceinline__ void cvt_tile(const Ctx& F, const float* src, int ldn, bf16_t* dst, int ldd) {
    LAS unsigned char* slab = F.lds + F.wave * 8704;
    const int q = F.lane >> 4, n4 = (F.lane & 15) * 4;
    f32x4 v[16];
#pragma unroll
    for (int i = 0; i < 16; ++i) { const int k = 8 * (i >> 1) + 2 * q + (i & 1); v[i] = *(const f32x4*)(src + (size_t)k * ldn + n4); }
#pragma unroll
    for (int p = 0; p < 8; ++p) { const int k0 = 8 * p + 2 * q;
#pragma unroll
        for (int j = 0; j < 4; ++j) *(LAS unsigned*)(slab + (n4 + j) * 136 + k0 * 2) = cvt_pk_bf16(v[2 * p][j], v[2 * p + 1][j]); }
#pragma unroll
    for (int i = 0; i < 16; ++i) { const int n = 4 * i + q, ch = F.lane & 15;
        const u32x2 w = *(const LAS u32x2*)(slab + n * 136 + ch * 8);
        *(u32x2*)(dst + (size_t)n * ldd + ch * 4) = w; }
}

__device__ __forceinline__ void phase_prologue(KParams p, const Ctx& F) {
    bf16_t* WinT = (bf16_t*)(p->ws + WS_WIN); bf16_t* WoutT = (bf16_t*)(p->ws + WS_WOUT); bf16_t* WguT = (bf16_t*)(p->ws + WS_WGU); bf16_t* WdT = (bf16_t*)(p->ws + WS_WD);
    constexpr int T_IN = 16 * 56, T_OUT = 16 * 16, T_E = NEXP * 128, T_L = T_IN + T_OUT + 3 * T_E;
    for (int task = F.gwave; task < DEPTH * T_L; task += F.nwaves) {
        const int l = task / T_L; int r = task % T_L;
        if (r < T_IN) { const int kt = r / 56, nt = r % 56;
            cvt_tile(F, p->w_in + (size_t)l * DM * PROJ + (size_t)kt * 64 * PROJ + nt * 64, PROJ, WinT + ((size_t)l * PROJ + nt * 64) * DM + kt * 64, DM);
        } else if (r < T_IN + T_OUT) { r -= T_IN; const int kt = r / 16, nt = r % 16;
            cvt_tile(F, p->w_out + (size_t)l * DM * DM + (size_t)kt * 64 * DM + nt * 64, DM, WoutT + ((size_t)l * DM + nt * 64) * DM + kt * 64, DM);
        } else if (r < T_IN + T_OUT + 2 * T_E) { r -= T_IN + T_OUT; const int up = r / T_E; r %= T_E; const int e = r / 128, rr = r % 128, kt = rr / 8, nt = rr % 8, n0 = nt * 64;
            const float* src = (up ? p->e_up : p->e_gate) + ((size_t)(l * NEXP + e) * DM + kt * 64) * DEXP + n0;
            const size_t drow = (size_t)(l * NEXP + e) * 1024 + 256 * (n0 >> 7) + 128 * up + (n0 & 127);
            cvt_tile(F, src, DEXP, WguT + drow * DM + kt * 64, DM);
        } else { r -= T_IN + T_OUT + 2 * T_E; const int e = r / 128, rr = r % 128, kt = rr / 16, nt = rr % 16;
            const float* src = p->e_down + ((size_t)(l * NEXP + e) * DEXP + kt * 64) * DM + nt * 64;
            cvt_tile(F, src, DM, WdT + ((size_t)(l * NEXP + e) * 1024 + nt * 64) * DEXP + kt * 64, DEXP);
        }
    }
    __syncthreads();
    LAS float* sc = (LAS float*)F.lds;
    LAS float* red = (LAS float*)(F.lds + 16384);
    for (int i = F.tid; i < NB * DM; i += NTHREADS) sc[i] = siluf_(p->c[i]);
    __syncthreads();
    float* mod = (float*)(p->ws + WS_MOD);
    for (int t = blockIdx.x; t < DEPTH * 96; t += F.G) {
        const int l = t / 96, n0 = (t % 96) * 64;
        const float* w = p->ada_w + (size_t)l * DM * 6 * DM + n0 + F.lane;
        float a0 = 0.f, a1 = 0.f, a2 = 0.f, a3 = 0.f;
        const int k0 = F.wave * 128;
#pragma unroll 8
        for (int k = k0; k < k0 + 128; ++k) { const float wv = w[(size_t)k * 6 * DM]; a0 += sc[k] * wv; a1 += sc[DM + k] * wv; a2 += sc[2 * DM + k] * wv; a3 += sc[3 * DM + k] * wv; }
        red[(F.wave * 4 + 0) * 64 + F.lane] = a0; red[(F.wave * 4 + 1) * 64 + F.lane] = a1; red[(F.wave * 4 + 2) * 64 + F.lane] = a2; red[(F.wave * 4 + 3) * 64 + F.lane] = a3;
        __syncthreads();
        if (F.tid < 256) { const int b = F.tid >> 6, ln = F.tid & 63; float s = p->ada_b[l * 6 * DM + n0 + ln];
#pragma unroll
            for (int w8 = 0; w8 < 8; ++w8) s += red[(w8 * 4 + b) * 64 + ln];
            mod[((size_t)l * NB + b) * 6 * DM + n0 + ln] = s; }
        __syncthreads();
    }
}

__device__ __forceinline__ void phase_norm1(KParams p, const Ctx& F, int l, const float* xin) {
    const float* mod = (const float*)(p->ws + WS_MOD) + (size_t)l * NB * 6 * DM;
    bf16_t* h = (bf16_t*)(p->ws + WS_R2);
    const float* nw = p->norm_mix_w + l * DM;
    for (int row = F.gwave; row < MTOK; row += F.nwaves) {
        const int b = row >> 12; const float* xr = xin + (size_t)row * DM;
        f32x4 v[4]; float ss = 0.f;
#pragma unroll
        for (int i = 0; i < 4; ++i) { v[i] = *(const f32x4*)(xr + F.lane * 4 + 256 * i); ss += v[i][0] * v[i][0] + v[i][1] * v[i][1] + v[i][2] * v[i][2] + v[i][3] * v[i][3]; }
        ss = wave_sum(ss); const float rstd = rsqrtf(ss * (1.0f / DM) + NORM_EPS);
#pragma unroll
        for (int i = 0; i < 4; ++i) { const int col = F.lane * 4 + 256 * i;
            const f32x4 w4 = *(const f32x4*)(nw + col), sh = *(const f32x4*)(mod + (size_t)b * 6 * DM + col), s1 = *(const f32x4*)(mod + (size_t)b * 6 * DM + DM + col);
            f32x4 o = v[i] * rstd * w4 * (s1 + 1.0f) + sh;
            u32x2 pk; pk[0] = cvt_pk_bf16(o[0], o[1]); pk[1] = cvt_pk_bf16(o[2], o[3]);
            *(u32x2*)(h + (size_t)row * DM + col) = pk; }
    }
}

__device__ __forceinline__ void phase_conv(KParams p, const Ctx& F, int l) {
    const bf16_t* proj = (const bf16_t*)(p->ws + WS_R1); float* xc = (float*)(p->ws + WS_XA);
    const float* cw = p->conv_w + l * 4 * DLRU; const float* cb = p->conv_b + l * DLRU;
    for (int it = blockIdx.x * NTHREADS + F.tid; it < MTOK * (DLRU / 4); it += F.G * NTHREADS) {
        const int row = it >> 7, c4 = (it & 127) * 4, t = row & (SEQ - 1);
        f32x4 acc = *(const f32x4*)(cb + c4);
#pragma unroll
        for (int k = 0; k < 4; ++k) { const int tt = t + k - 2;
            if (tt >= 0 && tt < SEQ) { const u32x2 pv = *(const u32x2*)(proj + (size_t)(row + k - 2) * PROJ + c4); const f32x4 w4 = *(const f32x4*)(cw + k * DLRU + c4);
                acc[0] += w4[0] * __uint_as_float(pv[0] << 16); acc[1] += w4[1] * __uint_as_float(pv[0] & 0xFFFF0000u);
                acc[2] += w4[2] * __uint_as_float(pv[1] << 16); acc[3] += w4[3] * __uint_as_float(pv[1] & 0xFFFF0000u); } }
        *(f32x4*)(xc + (size_t)row * DLRU + c4) = acc;
    }
}

__device__ __forceinline__ void lru_seq(KParams p, const Ctx& F, int l, int b, int h) {
    const bf16_t* proj = (const bf16_t*)(p->ws + WS_R1); const float* xc = (const float*)(p->ws + WS_XA); float* tmpz = (float*)(p->ws + WS_XA) + (size_t)MTOK * DLRU;
    const int c = h * 64 + F.lane;
    for (int d = 0; d < 2; ++d) {
        float wa_r[64], wx_r[64];
        const float* wa = p->lru_wa + ((size_t)(l * 2 + d) * 8 + h) * 4096 + F.lane; const float* wx = p->lru_wx + ((size_t)(l * 2 + d) * 8 + h) * 4096 + F.lane;
#pragma unroll
        for (int i = 0; i < 64; ++i) { wa_r[i] = wa[i * 64]; wx_r[i] = wx[i * 64]; }
        const float ba = p->lru_ba[(l * 2 + d) * DLRU + c], bx = p->lru_bx[(l * 2 + d) * DLRU + c], lam = p->lru_lambda[(l * 2 + d) * DLRU + c];
        const float cc = -8.0f * log1pf(expf(-lam));
        float hst = 0.f;
        for (int step = 0; step < SEQ; ++step) {
            const int t = d == 0 ? step : SEQ - 1 - step; const size_t row = (size_t)b * SEQ + t;
            const float xv = xc[row * DLRU + c];
            float ra = ba, rx = bx;
#pragma unroll
            for (int i = 0; i < 64; ++i) { const float xi = rdlane(xv, i); ra += xi * wa_r[i]; rx += xi * wx_r[i]; }
            const float r = sigmoidf_(ra), ig = sigmoidf_(rx), la = cc * r, a = expf(la);
            const float u = sqrtf(fmaxf(-expm1f(2.0f * la), 0.f)) * (ig * xv);
            hst = a * hst + u;
            if (d == 0) tmpz[row * DLRU + c] = hst;
            else { const float yv = bf2f(proj[row * PROJ + DLRU + c]); tmpz[row * DLRU + c] = (tmpz[row * DLRU + c] + hst) * gelu_tanh(yv); }
        }
    }
}

__device__ __forceinline__ float hgrn_lb(KParams p, int l, int ch) {
    if (l == 0) return 0.f;
    const float a = p->hgrn_lb[ch], b = p->hgrn_lb[DHG + ch]; const float m = fmaxf(a, b); const float ea = expf(a - m), eb = expf(b - m);
    return eb / (ea + eb);
}

__device__ __forceinline__ void hgrn_seq(KParams p, const Ctx& F, int l, int b, int h) {
    const bf16_t* proj = (const bf16_t*)(p->ws + WS_R1); float* tmpo = (float*)(p->ws + WS_R2); bf16_t* merged = (bf16_t*)(p->ws + WS_R3);
    const int ch = h * 64 + F.lane;
    const float lbv = hgrn_lb(p, l, ch), nw = p->norm_hgrn_w[l * DHG + ch];
    for (int d = 0; d < 2; ++d) {
        float S[64];
#pragma unroll
        for (int i = 0; i < 64; ++i) S[i] = 0.f;
        const int fcol = (d == 0 ? 1536 : 2048) + ch;
        for (int step = 0; step < SEQ; ++step) {
            const int t = d == 0 ? step : SEQ - 1 - step; const size_t row = (size_t)b * SEQ + t; const bf16_t* pr = proj + row * PROJ;
            const float fl = bf2f(pr[fcol]), qv = bf2f(pr[1024 + ch]), vv = bf2f(pr[2560 + ch]);
            const float f = lbv + (1.0f - lbv) * sigmoidf_(fl), k = 1.0f - f;
            float o = 0.f;
#pragma unroll
            for (int i = 0; i < 64; ++i) { const float fd = rdlane(f, i), kd = rdlane(k, i), qd = rdlane(qv, i); S[i] = fd * S[i] + kd * vv; o += qd * S[i]; }
            if (d == 0) tmpo[row * DHG + ch] = o;
            else { const float ot = tmpo[row * DHG + ch] + o; const float ms = wave_sum(ot * ot) * (1.0f / 64.0f);
                const float gv = bf2f(pr[3072 + ch]); const float y = ot * rsqrtf(ms + NORM_EPS) * nw * siluf_(gv);
                merged[row * DM + DLRU + ch] = f2bf(y); }
        }
    }
}

__device__ __forceinline__ void phase_mixer_seq(KParams p, const Ctx& F, int l) {
    if (F.wave == 0 && (int)blockIdx.x < 64) {
        const int id = blockIdx.x;
        if (id < 32) lru_seq(p, F, l, id >> 3, id & 7); else hgrn_seq(p, F, l, (id - 32) >> 3, (id - 32) & 7);
    }
}

__device__ __forceinline__ void phase_lru_norm(KParams p, const Ctx& F, int l) {
    const float* tmpz = (const float*)(p->ws + WS_XA) + (size_t)MTOK * DLRU; bf16_t* merged = (bf16_t*)(p->ws + WS_R3); const float* nw = p->norm_lru_w + l * DLRU;
    for (int row = F.gwave; row < MTOK; row += F.nwaves) {
        f32x4 v[2]; float ss = 0.f;
#pragma unroll
        for (int i = 0; i < 2; ++i) { v[i] = *(const f32x4*)(tmpz + (size_t)row * DLRU + F.lane * 4 + 256 * i); ss += v[i][0] * v[i][0] + v[i][1] * v[i][1] + v[i][2] * v[i][2] + v[i][3] * v[i][3]; }
        ss = wave_sum(ss); const float rstd = rsqrtf(ss * (1.0f / DLRU) + NORM_EPS);
#pragma unroll
        for (int i = 0; i < 2; ++i) { const int col = F.lane * 4 + 256 * i; const f32x4 w4 = *(const f32x4*)(nw + col); const f32x4 o = v[i] * rstd * w4;
            u32x2 pk; pk[0] = cvt_pk_bf16(o[0], o[1]); pk[1] = cvt_pk_bf16(o[2], o[3]); *(u32x2*)(merged + (size_t)row * DM + col) = pk; }
    }
}

__device__ __forceinline__ void phase_route(KParams p, const Ctx& F, int l) {
    const float* mod = (const float*)(p->ws + WS_MOD) + (size_t)l * NB * 6 * DM;
    const float* xa = (const float*)(p->ws + WS_XA); bf16_t* h2 = (bf16_t*)(p->ws + WS_R2);
    const float* nw = p->norm_ffn_w + l * DM;
    int* cnt = (int*)(p->ws + WS_CTL + CTL_CNT_OFF) + l * NEXP;
    int* tokinfo = (int*)(p->ws + WS_TOKINFO); float* tokw = (float*)(p->ws + WS_TOKW);
    LAS float* hrow = (LAS float*)(F.lds + F.wave * 4096);
    const float* rew = p->re_w + (size_t)l * DM * NEXP; const float* rgw = p->rg_w + (size_t)l * DM * NGRP;
    for (int row = F.gwave; row < MTOK; row += F.nwaves) {
        const int b = row >> 12; const float* xr = xa + (size_t)row * DM;
        f32x4 v[4]; float ss = 0.f;
#pragma unroll
        for (int i = 0; i < 4; ++i) { v[i] = *(const f32x4*)(xr + F.lane * 4 + 256 * i); ss += v[i][0] * v[i][0] + v[i][1] * v[i][1] + v[i][2] * v[i][2] + v[i][3] * v[i][3]; }
        ss = wave_sum(ss); const float rstd = rsqrtf(ss * (1.0f / DM) + NORM_EPS);
#pragma unroll
        for (int i = 0; i < 4; ++i) { const int col = F.lane * 4 + 256 * i;
            const f32x4 w4 = *(const f32x4*)(nw + col), sh = *(const f32x4*)(mod + (size_t)b * 6 * DM + 3 * DM + col), s1 = *(const f32x4*)(mod + (size_t)b * 6 * DM + 4 * DM + col);
            const f32x4 o = v[i] * rstd * w4 * (s1 + 1.0f) + sh;
            u32x2 pk; pk[0] = cvt_pk_bf16(o[0], o[1]); pk[1] = cvt_pk_bf16(o[2], o[3]);
            *(u32x2*)(h2 + (size_t)row * DM + col) = pk;
            *(LAS f32x4*)(hrow + col) = o; }
        const int ks = F.lane >> 3, o4 = F.lane & 7;
        f32x4 ae = (f32x4){0.f, 0.f, 0.f, 0.f};
#pragma unroll 8
        for (int i = 0; i < 128; ++i) { const int k = ks + 8 * i; const float hv = hrow[k]; const f32x4 wv = *(const f32x4*)(rew + (size_t)k * NEXP + o4 * 4); ae += wv * hv; }
#pragma unroll
        for (int m = 8; m <= 32; m <<= 1) { ae[0] += __shfl_xor(ae[0], m, 64); ae[1] += __shfl_xor(ae[1], m, 64); ae[2] += __shfl_xor(ae[2], m, 64); ae[3] += __shfl_xor(ae[3], m, 64); }
        f32x4 ag = (f32x4){0.f, 0.f, 0.f, 0.f};
#pragma unroll 4
        for (int i = 0; i < 16; ++i) { const int k = F.lane + 64 * i; const float hv = hrow[k]; const f32x4 wv = *(const f32x4*)(rgw + (size_t)k * NGRP); ag += wv * hv; }
        ag[0] = wave_sum(ag[0]); ag[1] = wave_sum(ag[1]); ag[2] = wave_sum(ag[2]); ag[3] = wave_sum(ag[3]);
        float gl[4];
#pragma unroll
        for (int j = 0; j < 4; ++j) gl[j] = ag[j] + p->rg_b[l * NGRP + j];
        int gi = 0; float gm = gl[0];
#pragma unroll
        for (int j = 1; j < 4; ++j) if (gl[j] > gm) { gm = gl[j]; gi = j; }
        float gs = 0.f;
#pragma unroll
        for (int j = 0; j < 4; ++j) gs += __expf(gl[j] - gm);
        const float pg = 1.0f / gs;
        gi = __builtin_amdgcn_readfirstlane(gi);
        float el[8];
#pragma unroll
        for (int j = 0; j < 4; ++j) { el[j] = __shfl(ae[j], 2 * gi, 64) + p->re_b[l * NEXP + gi * 8 + j]; el[4 + j] = __shfl(ae[j], 2 * gi + 1, 64) + p->re_b[l * NEXP + gi * 8 + 4 + j]; }
        int i0 = 0; float v0 = el[0];
#pragma unroll
        for (int j = 1; j < 8; ++j) if (el[j] > v0) { v0 = el[j]; i0 = j; }
        int i1 = -1; float v1 = -3.0e38f;
#pragma unroll
        for (int j = 0; j < 8; ++j) if (j != i0 && el[j] > v1) { v1 = el[j]; i1 = j; }
        const float ex = __expf(v1 - v0); const float w0 = pg / (1.0f + ex), w1 = pg * ex / (1.0f + ex);
        if (F.lane == 0) {
            const int e0 = gi * 8 + i0, e1 = gi * 8 + i1;
            const int p0 = atomicAdd(&cnt[e0], 1), p1 = atomicAdd(&cnt[e1], 1);
            *(int4*)(tokinfo + (size_t)row * 4) = make_int4(e0, p0, e1, p1);
            *(float2*)(tokw + (size_t)row * 2) = make_float2(w0, w1);
        }
    }
}

constexpr int MOE_MAX_UNITS = 8;
__device__ __forceinline__ void build_tile_table(KParams p, const Ctx& F, int l) {
    LAS int* tst = (LAS int*)(F.lds + LDS_MISC + 64);
    LAS int* ulist = (LAS int*)(F.lds + LDS_MISC + 256);
    const int* cnt = (const int*)(p->ws + WS_CTL + CTL_CNT_OFF) + l * NEXP;
    if (F.tid == 0) { int acc = 0; for (int e = 0; e < NEXP; ++e) { tst[e] = acc; acc += (__hip_atomic_load(cnt + e, __ATOMIC_RELAXED, __HIP_MEMORY_SCOPE_AGENT) + 255) >> 8; } tst[NEXP] = acc; }
    __syncthreads();
    if (F.tid <= MOE_MAX_UNITS) { const int L = F.tid * F.G + (int)blockIdx.x, tm = tst[NEXP]; int pm = -1, pn = 0;
        if (F.tid < MOE_MAX_UNITS && L < tm * 4) { const int mt = L >> 2; int e = 0; for (int k = 1; k < NEXP; ++k) e += (tst[k] <= mt) ? 1 : 0; pm = mt; pn = e * 4 + (L & 3); }
        ulist[2 * F.tid] = pm; ulist[2 * F.tid + 1] = pn; }
    __syncthreads();
}

__device__ __forceinline__ void phase_permute(KParams p, const Ctx& F, int l) {
    build_tile_table(p, F, l);
    const LAS int* tst = (const LAS int*)(F.lds + LDS_MISC + 64);
    const bf16_t* h2 = (const bf16_t*)(p->ws + WS_R2); bf16_t* xperm = (bf16_t*)(p->ws + WS_R1);
    const int* tokinfo = (const int*)(p->ws + WS_TOKINFO); const float* tokw = (const float*)(p->ws + WS_TOKW);
    int* rowtok = (int*)(p->ws + WS_ROWTOK); float* roww = (float*)(p->ws + WS_ROWW);
    const int* cnt = (const int*)(p->ws + WS_CTL + CTL_CNT_OFF) + l * NEXP;
    for (int row = F.gwave; row < MTOK; row += F.nwaves) {
        const int4 ti = *(const int4*)(tokinfo + (size_t)row * 4); const float2 tw = *(const float2*)(tokw + (size_t)row * 2);
        const int r0 = tst[ti.x] * 256 + ti.y, r1 = tst[ti.z] * 256 + ti.w;
        const u32x4 a = *(const u32x4*)(h2 + (size_t)row * DM + F.lane * 8), b2 = *(const u32x4*)(h2 + (size_t)row * DM + 512 + F.lane * 8);
        *(u32x4*)(xperm + (size_t)r0 * DM + F.lane * 8) = a; *(u32x4*)(xperm + (size_t)r0 * DM + 512 + F.lane * 8) = b2;
        *(u32x4*)(xperm + (size_t)r1 * DM + F.lane * 8) = a; *(u32x4*)(xperm + (size_t)r1 * DM + 512 + F.lane * 8) = b2;
        if (F.lane == 0) { rowtok[r0] = row * 2; rowtok[r1] = row * 2 + 1; roww[r0] = tw.x; roww[r1] = tw.y; }
    }
    if ((int)blockIdx.x < NEXP) { const int e = blockIdx.x; const int c = __hip_atomic_load(cnt + e, __ATOMIC_RELAXED, __HIP_MEMORY_SCOPE_AGENT);
        const int lo = tst[e] * 256 + c, hi = tst[e + 1] * 256;
        for (int r = lo + F.tid; r < hi; r += NTHREADS) { rowtok[r] = -1; roww[r] = 0.f; } }
}

template <bool FINAL>
__device__ __forceinline__ void phase_combine(KParams p, const Ctx& F, int l, float* xo) {
    const float* mod = (const float*)(p->ws + WS_MOD) + (size_t)l * NB * 6 * DM;
    const float* xa = (const float*)(p->ws + WS_XA); const bf16_t* y = (const bf16_t*)(p->ws + WS_R1);
    for (int row = F.gwave; row < MTOK; row += F.nwaves) {
        const int b = row >> 12; f32x4 v[4]; float ss = 0.f;
#pragma unroll
        for (int i = 0; i < 4; ++i) { const int col = F.lane * 4 + 256 * i;
            const f32x4 xv = *(const f32x4*)(xa + (size_t)row * DM + col), g = *(const f32x4*)(mod + (size_t)b * 6 * DM + 5 * DM + col);
            const u32x2 y0 = *(const u32x2*)(y + (size_t)(row * 2) * DM + col), y1 = *(const u32x2*)(y + (size_t)(row * 2 + 1) * DM + col);
            f32x4 ys; ys[0] = __uint_as_float(y0[0] << 16) + __uint_as_float(y1[0] << 16); ys[1] = __uint_as_float(y0[0] & 0xFFFF0000u) + __uint_as_float(y1[0] & 0xFFFF0000u);
            ys[2] = __uint_as_float(y0[1] << 16) + __uint_as_float(y1[1] << 16); ys[3] = __uint_as_float(y0[1] & 0xFFFF0000u) + __uint_as_float(y1[1] & 0xFFFF0000u);
            v[i] = xv + g * ys; ss += v[i][0] * v[i][0] + v[i][1] * v[i][1] + v[i][2] * v[i][2] + v[i][3] * v[i][3]; }
        if (FINAL) { ss = wave_sum(ss); const float rstd = rsqrtf(ss * (1.0f / DM) + NORM_EPS);
#pragma unroll
            for (int i = 0; i < 4; ++i) { const int col = F.lane * 4 + 256 * i; const f32x4 w4 = *(const f32x4*)(p->final_w + col); *(f32x4*)(p->out + (size_t)row * DM + col) = v[i] * rstd * w4; }
        } else {
#pragma unroll
            for (int i = 0; i < 4; ++i) *(f32x4*)(xo + (size_t)row * DM + F.lane * 4 + 256 * i) = v[i];
        }
    }
}

constexpr int PH_PER_LAYER = 11, N_PHASES = 1 + DEPTH * PH_PER_LAYER;

__device__ __forceinline__ Ctx make_ctx(LAS unsigned char* lds) {
    int tz = threadIdx.x; asm volatile("" : "+v"(tz));
    Ctx F; F.lds = lds; F.tid = tz; F.lane = tz & 63; F.wave = __builtin_amdgcn_readfirstlane(tz >> 6);
    F.G = gridDim.x; F.gwave = blockIdx.x * NWAVES + F.wave; F.nwaves = F.G * NWAVES; return F;
}

__global__ void __launch_bounds__(NTHREADS, 2) mega(Params p_unused) {
    (void)p_unused;
    extern __shared__ __attribute__((aligned(16))) unsigned char lds_raw[];
    LAS unsigned char* const lds = (LAS unsigned char*)lds_raw;
    int lo, hi; XcdBarrier bar;
    { KParams P = get_params(); lo = (int)P->ph_lo; hi = (int)P->ph_hi;
      if (threadIdx.x < 4) ((LAS unsigned*)(lds + LDS_MISC))[threadIdx.x] = 0u;
      __syncthreads();
      bar.bar = (unsigned*)(P->ws + WS_CTL); bar.x = 0; bar.st = nullptr;
      if (hi - lo > 1) bar = xcd_barrier_post((unsigned*)(P->ws + WS_CTL), (volatile LAS unsigned*)(lds + LDS_MISC)); }
#ifndef DBG_MASK
#define DBG_MASK 0xFFFFFFFFu
#endif
#define IN(k) ((((DBG_MASK) >> ((k) == 0 ? 0 : (((k) - 1) % PH_PER_LAYER) + 1)) & 1u) && lo <= (k) && (k) < hi)
#define SEAM(k) do { if (IN(k) && IN((k) + 1)) xcd_barrier(bar); } while (0)
#define SITE KParams P = get_params(); const Ctx F = make_ctx(lds);

    if (IN(0)) { SITE phase_prologue(P, F); }
    SEAM(0);
    for (int l = 0; l < DEPTH; ++l) {
        const int base = 1 + l * PH_PER_LAYER;
        if (IN(base + 0)) { SITE phase_norm1(P, F, l, (l == 0) ? P->x : P->out); }
        SEAM(base + 0);
        if (IN(base + 1)) { SITE
            pg8::Gemm g{(const bf16_t*)(P->ws + WS_R2), (const bf16_t*)(P->ws + WS_WIN) + (size_t)l * PROJ * DM, MTOK, PROJ, DM};
            pg8::StaticOrder S; S.init(MTOK, PROJ, F.G, (int)blockIdx.x);
            pg8::EpiBf16 E{(bf16_t*)(P->ws + WS_R1), PROJ};
            pg8::gemm_phase(F.lds, g, S, E);
        }
        SEAM(base + 1);
        if (IN(base + 2)) { SITE phase_conv(P, F, l); }
        SEAM(base + 2);
        if (IN(base + 3)) { SITE phase_mixer_seq(P, F, l); }
        SEAM(base + 3);
        if (IN(base + 4)) { SITE phase_lru_norm(P, F, l); }
        SEAM(base + 4);
        if (IN(base + 5)) { SITE
            pg8::Gemm g{(const bf16_t*)(P->ws + WS_R3), (const bf16_t*)(P->ws + WS_WOUT) + (size_t)l * DM * DM, MTOK, DM, DM};
            pg8::StaticOrder S; S.init(MTOK, DM, F.G, (int)blockIdx.x);
            pg8::EpiResid E{(l == 0) ? P->x : P->out, (float*)(P->ws + WS_XA), (const float*)(P->ws + WS_MOD) + (size_t)l * NB * 6 * DM + 2 * DM};
            pg8::gemm_phase(F.lds, g, S, E);
        }
        SEAM(base + 5);
        if (IN(base + 6)) { SITE phase_route(P, F, l); }
        SEAM(base + 6);
        if (IN(base + 7)) { SITE phase_permute(P, F, l); }
        SEAM(base + 7);
        if (IN(base + 8)) { SITE
            build_tile_table(P, F, l);
            pg8::Gemm g{(const bf16_t*)(P->ws + WS_R1), (const bf16_t*)(P->ws + WS_WGU) + (size_t)l * NEXP * 1024 * DM, MPAD, NEXP * 1024, DM};
            pg8::MoeOrder S{(const LAS int*)(F.lds + LDS_MISC + 256)};
            pg8::EpiGateUp E{(bf16_t*)(P->ws + WS_R2)};
            pg8::gemm_phase(F.lds, g, S, E);
        }
        SEAM(base + 8);
        if (IN(base + 9)) { SITE
            build_tile_table(P, F, l);
            pg8::Gemm g{(const bf16_t*)(P->ws + WS_R2), (const bf16_t*)(P->ws + WS_WD) + (size_t)l * NEXP * 1024 * DEXP, MPAD, NEXP * 1024, DEXP};
            pg8::MoeOrder S{(const LAS int*)(F.lds + LDS_MISC + 256)};
            pg8::EpiDown E{(bf16_t*)(P->ws + WS_R1), (const int*)(P->ws + WS_ROWTOK), (const float*)(P->ws + WS_ROWW)};
            pg8::gemm_phase(F.lds, g, S, E);
        }
        SEAM(base + 9);
        if (IN(base + 10)) { SITE if (l == DEPTH - 1) phase_combine<true>(P, F, l, nullptr); else phase_combine<false>(P, F, l, P->out); }
        SEAM(base + 10);
    }
#undef IN
#undef SEAM
#undef SITE
}

extern "C" void kernel_launch(void* const* d_in, const int* in_sizes, int n_in, void* d_out, int out_size, void* d_ws, size_t ws_size, hipStream_t stream) {
    static int grid = 0;
    if (grid == 0) {
        if (n_in != 26 || in_sizes[0] != MTOK * DM || out_size != MTOK * DM || ws_size < WS_END) {
            fprintf(stderr, "kernel_launch: unexpected shapes (n_in %d, in0 %d, out %d, ws %zu, need %zu); nothing launched\n", n_in, n_in > 0 ? in_sizes[0] : -1, out_size, ws_size, (size_t)WS_END); grid = -1; return; }
        int dev = 0, cus = 0, per_cu = 0;
        if (hipGetDevice(&dev) != hipSuccess || hipDeviceGetAttribute(&cus, hipDeviceAttributeMultiprocessorCount, dev) != hipSuccess) { fprintf(stderr, "kernel_launch: device query failed\n"); grid = -1; return; }
        if (hipFuncSetAttribute((const void*)mega, hipFuncAttributeMaxDynamicSharedMemorySize, LDS_BYTES) != hipSuccess) { fprintf(stderr, "kernel_launch: hipFuncSetAttribute failed\n"); grid = -1; return; }
        if (hipOccupancyMaxActiveBlocksPerMultiprocessor(&per_cu, (const void*)mega, NTHREADS, LDS_BYTES) != hipSuccess || per_cu < 1)
            fprintf(stderr, "kernel_launch: note: occupancy query reports %d workgroups per CU\n", per_cu);
        (void)hipGetLastError();
        grid = cus;
    }
    if (grid < 0) return;
    if (hipMemsetAsync((char*)d_ws + WS_CTL, 0, CTL_ZERO_BYTES, stream) != hipSuccess) { fprintf(stderr, "kernel_launch: memset failed\n"); return; }
    Params p{};
    const float** pf = (const float**)&p;
    for (int i = 0; i < 26; ++i) pf[i] = (const float*)d_in[i];
    p.out = (float*)d_out; p.ws = (unsigned char*)d_ws;
#if MK_PER_PHASE
    for (int ph = 0; ph < N_PHASES; ++ph) { p.ph_lo = ph; p.ph_hi = ph + 1;
        hipLaunchKernelGGL(mega, dim3(grid), dim3(NTHREADS), LDS_BYTES, stream, p);
        const hipError_t le = hipPeekAtLastError();
        if (le != hipSuccess) { fprintf(stderr, "kernel_launch: launch %d failed: %s\n", ph, hipGetErrorName(le)); break; } }
#else
    p.ph_lo = 0; p.ph_hi = N_PHASES;
    hipLaunchKernelGGL(mega, dim3(grid), dim3(NTHREADS), LDS_BYTES, stream, p);
    const hipError_t le = hipPeekAtLastError();
    if (le != hipSuccess) fprintf(stderr, "kernel_launch: launch failed: %s\n", hipGetErrorName(le));
#endif
}
```

```cpp
#include <hip/hip_runtime.h>
#include <stdint.h>
#include <stdio.h>

#ifndef MK_PER_PHASE
#define MK_PER_PHASE 0
#endif

#define LAS __attribute__((address_space(3)))
typedef unsigned short bf16_t;
typedef short bf16x8 __attribute__((ext_vector_type(8)));
typedef float f32x4 __attribute__((ext_vector_type(4)));
typedef float f32x2 __attribute__((ext_vector_type(2)));
typedef unsigned u32x4 __attribute__((ext_vector_type(4)));
typedef unsigned u32x2 __attribute__((ext_vector_type(2)));

constexpr int NB = 4, SEQ = 4096, DM = 1024, MTOK = NB * SEQ, DEPTH = 2;
constexpr int DLRU = 512, DHG = 512, PROJ = 3584, NEXP = 32, DEXP = 512, NGRP = 4, EPG = 8;
constexpr int MPAD = 40960;
constexpr float NORM_EPS = 1e-6f;
constexpr int NWAVES = 8, NTHREADS = 512;

constexpr size_t WS_CTL = 0;
constexpr size_t CTL_ZERO_BYTES = 32768;
constexpr size_t CTL_CNT_OFF = 16384;
constexpr size_t WS_MOD = 65536;
constexpr size_t WS_WIN = WS_MOD + 196608;
constexpr size_t WS_WOUT = WS_WIN + (size_t)DEPTH * PROJ * DM * 2;
constexpr size_t WS_WGU = WS_WOUT + (size_t)DEPTH * DM * DM * 2;
constexpr size_t WS_WD = WS_WGU + (size_t)DEPTH * NEXP * 1024 * 1024 * 2;
constexpr size_t WS_R1 = WS_WD + (size_t)DEPTH * NEXP * 1024 * 512 * 2;
constexpr size_t WS_R2 = WS_R1 + (size_t)MTOK * PROJ * 2;
constexpr size_t WS_R3 = WS_R2 + (size_t)MPAD * 512 * 2;
constexpr size_t WS_XA = WS_R3 + (size_t)MTOK * DM * 2;
constexpr size_t WS_TOKINFO = WS_XA + (size_t)MTOK * DM * 4;
constexpr size_t WS_TOKW = WS_TOKINFO + (size_t)MTOK * 16;
constexpr size_t WS_ROWTOK = WS_TOKW + (size_t)MTOK * 8;
constexpr size_t WS_ROWW = WS_ROWTOK + (size_t)MPAD * 4;
constexpr size_t WS_LRUW = WS_ROWW + (size_t)MPAD * 4;
constexpr size_t WS_SUMA = WS_LRUW + 524288;
constexpr size_t WS_SUMH = WS_SUMA + 1048576;
constexpr size_t WS_END = WS_SUMH + 1048576;

constexpr int LDS_STAGE = 139264;
constexpr int LDS_MISC = LDS_STAGE;
constexpr int LDS_BYTES = LDS_STAGE + 2048;

#define XB_TMO      128
#define XB_XCNT(j)  (256  + 64 * (j))
#define XB_XSUB(j)  (1280 + 64 * (j))
#define XB_XGEN(j)  (2304 + 64 * (j))
#define XB_TOP      3328
#define XB_TOPGEN   3392
#define XCD_BAR_WORDS 3456
#define XB_SPIN_CAP (1u << 22)

__device__ __forceinline__ unsigned xb_ld(unsigned* p)              { return __hip_atomic_load(p, __ATOMIC_RELAXED, __HIP_MEMORY_SCOPE_AGENT); }
__device__ __forceinline__ unsigned xb_add(unsigned* p, unsigned v) { return __hip_atomic_fetch_add(p, v, __ATOMIC_RELAXED, __HIP_MEMORY_SCOPE_AGENT); }
__device__ __forceinline__ unsigned xb_xcc_id() { return (unsigned)__builtin_amdgcn_s_getreg((3 << 11) | 20) & 0xFu; }
#define XB_SPIN(cond, bar) do { unsigned _sp = 0; while (cond) { __builtin_amdgcn_s_sleep(1); \
    if ((++_sp & 255u) == 0u) { if (xb_ld(&(bar)[XB_TMO])) break; if (_sp > XB_SPIN_CAP) { atomicAdd(&(bar)[XB_TMO], 1u); break; } } } } while (0)

struct XcdBarrier { unsigned* bar; unsigned x; volatile LAS unsigned* st; };

__device__ __forceinline__ XcdBarrier xcd_barrier_post(unsigned* bar, volatile LAS unsigned* st) {
    XcdBarrier b; b.bar = bar; b.x = xb_xcc_id(); b.st = st;
    if (threadIdx.x == 0) (void)xb_add(&bar[XB_XCNT(b.x)], 1u);
    return b;
}
__device__ __forceinline__ void xcd_barrier_complete(unsigned* bar, unsigned x, unsigned& nloc, unsigned& nx) {
    const unsigned G = gridDim.x * gridDim.y * gridDim.z;
    unsigned sum, cnt, mine, sp = 0u;
    for (;;) {
        sum = 0u; cnt = 0u; mine = 0u;
#pragma unroll
        for (unsigned j = 0; j < 16; ++j) { const unsigned c = xb_ld(&bar[XB_XCNT(j)]); sum += c; cnt += (c > 0u) ? 1u : 0u; mine = (j == x) ? c : mine; }
        if (sum == G) break;
        __builtin_amdgcn_s_sleep(1);
        if ((++sp & 255u) == 0u) { if (xb_ld(&bar[XB_TMO])) break; if (sp > XB_SPIN_CAP) { atomicAdd(&bar[XB_TMO], 1u); break; } }
    }
    nloc = mine > 0u ? mine : 1u; nx = cnt > 0u ? cnt : 1u;
}
__device__ __forceinline__ void xcd_barrier(const XcdBarrier& b) {
    asm volatile("s_waitcnt vmcnt(0)" ::: "memory");
    __syncthreads();
    if (threadIdx.x == 0) {
        unsigned* bar = b.bar;
        __builtin_amdgcn_s_waitcnt(0);
        unsigned nloc = b.st[0], nx = b.st[1];
        if (nloc == 0u) { xcd_barrier_complete(bar, b.x, nloc, nx); b.st[0] = nloc; b.st[1] = nx; }
        const unsigned old = xb_add(&bar[XB_XSUB(b.x)], 1u);
        const unsigned gen = old / nloc;
        if (old + 1u == (gen + 1u) * nloc) {
            __builtin_amdgcn_fence(__ATOMIC_RELEASE, "agent");
            asm volatile("s_waitcnt vmcnt(0)" ::: "memory");
            const unsigned og = xb_add(&bar[XB_TOP], 1u);
            const unsigned tg = og / nx;
            if (og + 1u == (tg + 1u) * nx) xb_add(&bar[XB_TOPGEN], 1u);
            else XB_SPIN(xb_ld(&bar[XB_TOPGEN]) == tg, bar);
            __builtin_amdgcn_fence(__ATOMIC_ACQUIRE, "agent");
            xb_add(&bar[XB_XGEN(b.x)], 1u);
            asm volatile("s_waitcnt vmcnt(0)" ::: "memory");
        } else {
            XB_SPIN(xb_ld(&bar[XB_XGEN(b.x)]) == gen, bar);
            __builtin_amdgcn_fence(__ATOMIC_ACQUIRE, "agent");
            asm volatile("s_waitcnt vmcnt(0)" ::: "memory");
        }
    }
    __syncthreads();
}

__device__ __forceinline__ float bf2f(bf16_t b) { return __uint_as_float(((unsigned)b) << 16); }
__device__ __forceinline__ bf16_t f2bf(float f) { unsigned u = __float_as_uint(f); u += 0x7FFFu + ((u >> 16) & 1u); return (bf16_t)(u >> 16); }
__device__ __forceinline__ unsigned cvt_pk_bf16(float lo, float hi) { unsigned r; asm volatile("v_cvt_pk_bf16_f32 %0, %1, %2" : "=v"(r) : "v"(lo), "v"(hi)); return r; }
__device__ __forceinline__ float wave_sum(float v) {
#pragma unroll
    for (int m = 32; m >= 1; m >>= 1) v += __shfl_xor(v, m, 64);
    return v;
}
__device__ __forceinline__ float sigmoidf_(float x) { return __builtin_amdgcn_rcpf(1.0f + __expf(-x)); }
__device__ __forceinline__ float siluf_(float x) { return x * sigmoidf_(x); }
__device__ __forceinline__ float gelu_tanh(float x) {
    const float u = 0.7978845608028654f * (x + 0.044715f * x * x * x);
    const float t = 1.0f - 2.0f / (__expf(2.0f * u) + 1.0f);
    return 0.5f * x * (1.0f + t);
}
__device__ __forceinline__ float rdlane(float v, int l) { return __int_as_float(__builtin_amdgcn_readlane(__float_as_int(v), l)); }

namespace pg8 {
constexpr int BM = 256, BK = 64, HALF = 128, HTB = HALF * BK * 2, STAGE_BYTES = 8 * HTB, NXCD = 8, WGM = 8;
__host__ __device__ __forceinline__ int lds_byte(int r, int c) { const int st = (r >> 4) * 2 + (c >> 5), rr = r & 15, cc = c & 31, ob = rr * 64 + cc * 2; return st * 1024 + (ob ^ (((ob >> 9) & 1) << 5)); }
__host__ __device__ __forceinline__ void stage_rc(int b, int& R, int& C) { const int st = b / 1024, sb = b % 1024, swz = sb ^ (((sb >> 9) & 1) << 5); R = (st >> 1) * 16 + swz / 64; C = (st & 1) * 32 + (swz % 64) / 2; }
__host__ __device__ __forceinline__ int perm32(int rho) { const int n = rho >> 4, i = rho & 15; return 8 * (i >> 2) + 4 * n + (i & 3); }

struct Unit { int pm, pn; };
struct Gemm { const bf16_t* A; const bf16_t* Bt; int M, N, K; };

struct StaticOrder {
    int nM, nN, nwg, G, c;
    __host__ __device__ void init(int M, int N, int G_, int c_) { nM = M / BM; nN = N / BM; nwg = nM * nN; G = G_; c = c_; }
    __host__ __device__ bool next(int i, Unit& u) const {
        const long L = (long)i * G + c; if (L >= nwg) return false;
        int wgid = (int)L; { const int q = nwg / NXCD, r = nwg % NXCD, xcd = wgid % NXCD, off = wgid / NXCD; wgid = (xcd < r ? xcd * (q + 1) : r * (q + 1) + (xcd - r) * q) + off; }
        const int nig = WGM * nN, gid = wgid / nig, fm = gid * WGM, gsz = (nM - fm) < WGM ? (nM - fm) : WGM;
        u.pm = fm + ((wgid % nig) % gsz); u.pn = (wgid % nig) / gsz; return true;
    }
    __device__ __forceinline__ void a_ready(const Unit&) const {}
    __device__ __forceinline__ void done(const Unit&) const {}
};

struct MoeOrder {
    const LAS int* ulist;
    __device__ __forceinline__ bool next(int i, Unit& u) const {
        const int pm = __builtin_amdgcn_readfirstlane(ulist[2 * i]); if (pm < 0) return false;
        u.pm = pm; u.pn = __builtin_amdgcn_readfirstlane(ulist[2 * i + 1]); return true;
    }
    __device__ __forceinline__ void a_ready(const Unit&) const {}
    __device__ __forceinline__ void done(const Unit&) const {}
};

struct EpiBf16 {
    static constexpr bool PERM = true;
    bf16_t* O; int ldc;
    __device__ __forceinline__ void operator()(const f32x4 (&acc)[2][2][4][2], const Unit& u, int wr, int wc, int fr, int fq) const {
        const int row0 = u.pm * BM + wr * 64 + fr, col0 = u.pn * BM + wc * 32 + 8 * fq;
#pragma unroll
        for (int ai = 0; ai < 2; ++ai)
#pragma unroll
            for (int m = 0; m < 4; ++m) { bf16_t* rowp = O + (size_t)(row0 + ai * HALF + m * 16) * ldc + col0;
#pragma unroll
                for (int bj = 0; bj < 2; ++bj) { const f32x4 v0 = acc[ai][bj][m][0], v1 = acc[ai][bj][m][1];
                    u32x4 o; o[0] = cvt_pk_bf16(v0[0], v0[1]); o[1] = cvt_pk_bf16(v0[2], v0[3]); o[2] = cvt_pk_bf16(v1[0], v1[1]); o[3] = cvt_pk_bf16(v1[2], v1[3]);
                    *(u32x4*)(rowp + bj * HALF) = o; } }
    }
};
struct EpiResid {
    static constexpr bool PERM = false;
    const float* XI; float* XO; const float* gate;
    __device__ __forceinline__ void operator()(const f32x4 (&acc)[2][2][4][2], const Unit& u, int wr, int wc, int fr, int fq) const {
        const int row0 = u.pm * BM + wr * 64 + fr, col0 = u.pn * BM + wc * 32 + 4 * fq;
        const int b = (u.pm * BM) / SEQ;
        f32x4 gv[2][2];
#pragma unroll
        for (int bj = 0; bj < 2; ++bj)
#pragma unroll
            for (int n = 0; n < 2; ++n) gv[bj][n] = *(const f32x4*)(gate + (size_t)b * 6 * DM + col0 + bj * HALF + n * 16);
#pragma unroll
        for (int ai = 0; ai < 2; ++ai)
#pragma unroll
            for (int m = 0; m < 4; ++m) { const size_t ro = (size_t)(row0 + ai * HALF + m * 16) * DM + col0;
#pragma unroll
                for (int bj = 0; bj < 2; ++bj)
#pragma unroll
                    for (int n = 0; n < 2; ++n) { const f32x4 xi = *(const f32x4*)(XI + ro + bj * HALF + n * 16);
                        *(f32x4*)(XO + ro + bj * HALF + n * 16) = xi + gv[bj][n] * acc[ai][bj][m][n]; } }
    }
};
struct EpiGateUp {
    static constexpr bool PERM = true;
    bf16_t* H;
    __device__ __forceinline__ void operator()(const f32x4 (&acc)[2][2][4][2], const Unit& u, int wr, int wc, int fr, int fq) const {
        const int row0 = u.pm * BM + wr * 64 + fr, col0 = (u.pn & 3) * 128 + wc * 32 + 8 * fq;
#pragma unroll
        for (int ai = 0; ai < 2; ++ai)
#pragma unroll
            for (int m = 0; m < 4; ++m) { bf16_t* rowp = H + (size_t)(row0 + ai * HALF + m * 16) * DEXP + col0;
                float h[8];
#pragma unroll
                for (int n = 0; n < 2; ++n)
#pragma unroll
                    for (int q = 0; q < 4; ++q) { const float g = acc[ai][0][m][n][q], up = acc[ai][1][m][n][q]; h[n * 4 + q] = g / (1.0f + __expf(-g)) * up; }
                u32x4 o; o[0] = cvt_pk_bf16(h[0], h[1]); o[1] = cvt_pk_bf16(h[2], h[3]); o[2] = cvt_pk_bf16(h[4], h[5]); o[3] = cvt_pk_bf16(h[6], h[7]);
                *(u32x4*)rowp = o; }
    }
};
struct EpiDown {
    static constexpr bool PERM = true;
    bf16_t* Y; const int* rowtok; const float* roww;
    __device__ __forceinline__ void operator()(const f32x4 (&acc)[2][2][4][2], const Unit& u, int wr, int wc, int fr, int fq) const {
        const int row0 = u.pm * BM + wr * 64 + fr, col0 = (u.pn & 3) * BM + wc * 32 + 8 * fq;
#pragma unroll
        for (int ai = 0; ai < 2; ++ai)
#pragma unroll
            for (int m = 0; m < 4; ++m) { const int row = row0 + ai * HALF + m * 16; const int rt = rowtok[row];
                if (rt >= 0) { const float w = roww[row]; bf16_t* rowp = Y + (size_t)rt * DM + col0;
#pragma unroll
                    for (int bj = 0; bj < 2; ++bj) { const f32x4 v0 = acc[ai][bj][m][0] * w, v1 = acc[ai][bj][m][1] * w;
                        u32x4 o; o[0] = cvt_pk_bf16(v0[0], v0[1]); o[1] = cvt_pk_bf16(v0[2], v0[3]); o[2] = cvt_pk_bf16(v1[0], v1[1]); o[3] = cvt_pk_bf16(v1[2], v1[3]);
                        *(u32x4*)(rowp + bj * HALF) = o; } } }
    }
};

template <class Epi, class Sched>
__device__ __forceinline__ void gemm_phase(LAS unsigned char* lds, const Gemm g, const Sched& S, const Epi& E) {
    const int tid = threadIdx.x, wid = __builtin_amdgcn_readfirstlane(tid >> 6), lane = tid & 63, wr = wid >> 2, wc = wid & 3, fr = lane & 15, fq = lane >> 4;
    const int K = g.K, nt = K / BK;
    unsigned voffA[2], voffB[2];
#pragma unroll
    for (int i = 0; i < 2; ++i) { int R, C; stage_rc(tid * 16 + i * 8192, R, C); const int Rb = Epi::PERM ? ((R & ~31) + perm32(R & 31)) : R;
        voffA[i] = (unsigned)(R * K + C) * 2u; voffB[i] = (unsigned)(Rb * K + C) * 2u; }
    const size_t kstep = (size_t)(BK * 2);
    const size_t hstep = (size_t)HALF * K * 2;
    const size_t tstep = 2 * hstep;
    const unsigned ldsw = (unsigned)wid * 1024u;
    const int aoff = lds_byte(wr * 64 + fr, fq * 8), boff = lds_byte(wc * 32 + fr, fq * 8);
#define PG8_SA(b, h) (((b) * 2 + (h)) * HTB)
#define PG8_SB(b, h) ((4 + (b) * 2 + (h)) * HTB)
#define PG8_STAGE(bufoff, gbase, voff) do { _Pragma("unroll") for (int _i = 0; _i < 2; ++_i) \
        __builtin_amdgcn_global_load_lds((const unsigned*)((const char*)(gbase) + (voff)[_i]), (LAS unsigned*)(lds + (bufoff) + ldsw + _i * 8192), 16, 0, 0); } while (0)
#define PG8_LDA(dst, b, h) do { _Pragma("unroll") for (int m = 0; m < 4; ++m) _Pragma("unroll") for (int k = 0; k < 2; ++k) dst[m][k] = *(const LAS bf16x8*)(lds + PG8_SA(b, h) + aoff + m * 2048 + k * 1024); } while (0)
#define PG8_LDB(dst, b, h) do { _Pragma("unroll") for (int n = 0; n < 2; ++n) _Pragma("unroll") for (int k = 0; k < 2; ++k) dst[n][k] = *(const LAS bf16x8*)(lds + PG8_SB(b, h) + boff + n * 2048 + k * 1024); } while (0)
#define PG8_MMA(ai, bj, At, Bt) do { __builtin_amdgcn_s_setprio(1); _Pragma("unroll") for (int m = 0; m < 4; ++m) _Pragma("unroll") for (int n = 0; n < 2; ++n) _Pragma("unroll") for (int k = 0; k < 2; ++k) \
        acc[ai][bj][m][n] = __builtin_amdgcn_mfma_f32_16x16x32_bf16(Bt[n][k], At[m][k], acc[ai][bj][m][n], 0, 0, 0); __builtin_amdgcn_s_setprio(0); } while (0)
#define PG8_WAIT_V(n) asm volatile("s_waitcnt vmcnt(" #n ")" ::: "memory")
#define PG8_WAIT_L(n) asm volatile("s_waitcnt lgkmcnt(" #n ")" ::: "memory")
#define PG8_BAR __builtin_amdgcn_s_barrier()
#define PG8_SCHED __builtin_amdgcn_sched_barrier(0)
    Unit cur, nxt; int ui = 0;
    if (!S.next(0, cur)) return;
    f32x4 acc[2][2][4][2];
#pragma unroll
    for (int a = 0; a < 2; ++a)
#pragma unroll
        for (int b = 0; b < 2; ++b)
#pragma unroll
            for (int m = 0; m < 4; ++m)
#pragma unroll
                for (int n = 0; n < 2; ++n) acc[a][b][m][n] = (f32x4){0.f, 0.f, 0.f, 0.f};
    bf16x8 At[4][2], B0[2][2], B1[2][2];
    const char* cA = (const char*)g.A + (size_t)cur.pm * tstep; const char* cB = (const char*)g.Bt + (size_t)cur.pn * tstep;
    S.a_ready(cur);
    PG8_STAGE(PG8_SB(0, 0), cB, voffB); PG8_STAGE(PG8_SA(0, 0), cA, voffA); PG8_STAGE(PG8_SB(0, 1), cB + hstep, voffB); PG8_STAGE(PG8_SA(0, 1), cA + hstep, voffA);
    if (wr == 1) PG8_BAR;
    PG8_WAIT_V(4); PG8_BAR;
    PG8_STAGE(PG8_SB(1, 0), cB + kstep, voffB); PG8_STAGE(PG8_SA(1, 0), cA + kstep, voffA); PG8_STAGE(PG8_SB(1, 1), cB + hstep + kstep, voffB);
    PG8_WAIT_V(6); PG8_BAR;
    for (;;) {
        const bool has_next = S.next(ui + 1, nxt);
        const char* nA = has_next ? (const char*)g.A + (size_t)nxt.pm * tstep : cA; const char* nB = has_next ? (const char*)g.Bt + (size_t)nxt.pn * tstep : cB;
        for (int t = 0; t < nt; t += 2) {
            const bool last = (t == nt - 2);
            const char* a1 = cA + (size_t)(t + 1) * kstep;
            const char* a2 = last ? nA : cA + (size_t)(t + 2) * kstep; const char* b2 = last ? nB : cB + (size_t)(t + 2) * kstep;
            const char* a3 = a2 + kstep; const char* b3 = b2 + kstep;
            if (last && has_next) S.a_ready(nxt);
            PG8_LDB(B0, 0, 0); PG8_SCHED; PG8_LDA(At, 0, 0); PG8_STAGE(PG8_SA(1, 1), a1 + hstep, voffA);
            PG8_WAIT_L(8); PG8_BAR; PG8_WAIT_L(0); PG8_MMA(0, 0, At, B0); PG8_BAR; PG8_SCHED;
            PG8_LDB(B1, 0, 1); PG8_STAGE(PG8_SB(0, 0), b2, voffB);
            PG8_BAR; PG8_WAIT_L(0); PG8_MMA(0, 1, At, B1); PG8_BAR;
            PG8_LDA(At, 0, 1); PG8_STAGE(PG8_SA(0, 0), a2, voffA);
            PG8_BAR; PG8_WAIT_L(0); PG8_MMA(1, 0, At, B0); PG8_BAR; PG8_SCHED;
            PG8_STAGE(PG8_SB(0, 1), b2 + hstep, voffB);
            PG8_WAIT_V(6); PG8_BAR; PG8_MMA(1, 1, At, B1); PG8_BAR;
            PG8_LDB(B0, 1, 0); PG8_SCHED; PG8_LDA(At, 1, 0); PG8_STAGE(PG8_SA(0, 1), a2 + hstep, voffA);
            PG8_WAIT_L(8); PG8_BAR; PG8_WAIT_L(0); PG8_MMA(0, 0, At, B0); PG8_BAR; PG8_SCHED;
            PG8_LDB(B1, 1, 1); PG8_STAGE(PG8_SB(1, 0), b3, voffB);
            PG8_BAR; PG8_WAIT_L(0); PG8_MMA(0, 1, At, B1); PG8_BAR;
            PG8_LDA(At, 1, 1); PG8_STAGE(PG8_SA(1, 0), a3, voffA);
            PG8_BAR; PG8_WAIT_L(0); PG8_MMA(1, 0, At, B0); PG8_BAR; PG8_SCHED;
            PG8_STAGE(PG8_SB(1, 1), b3 + hstep, voffB);
            PG8_WAIT_V(6); PG8_BAR; PG8_MMA(1, 1, At, B1); PG8_BAR;
        }
        E(acc, cur, wr, wc, fr, fq); S.done(cur);
        if (!has_next) break;
#pragma unroll
        for (int a = 0; a < 2; ++a)
#pragma unroll
            for (int b = 0; b < 2; ++b)
#pragma unroll
                for (int m = 0; m < 4; ++m)
#pragma unroll
                    for (int n = 0; n < 2; ++n) acc[a][b][m][n] = (f32x4){0.f, 0.f, 0.f, 0.f};
        cur = nxt; cA = nA; cB = nB; ++ui;
    }
    PG8_WAIT_V(0);
    if (wr == 0) PG8_BAR;
    PG8_BAR;
#undef PG8_SA
#undef PG8_SB
#undef PG8_STAGE
#undef PG8_LDA
#undef PG8_LDB
#undef PG8_MMA
#undef PG8_WAIT_V
#undef PG8_WAIT_L
#undef PG8_BAR
#undef PG8_SCHED
}
}

struct Params {
    const float* x; const float* c; const float* ada_w; const float* ada_b; const float* norm_mix_w; const float* w_in; const float* conv_w; const float* conv_b;
    const float* lru_wa; const float* lru_ba; const float* lru_wx; const float* lru_bx; const float* lru_lambda; const float* norm_lru_w; const float* hgrn_lb;
    const float* norm_hgrn_w; const float* w_out; const float* norm_ffn_w; const float* rg_w; const float* rg_b; const float* re_w; const float* re_b;
    const float* e_gate; const float* e_up; const float* e_down; const float* final_w;
    float* out; unsigned char* ws;
    long long ph_lo, ph_hi;
};

typedef const __attribute__((address_space(4))) Params* KParams;
__device__ __forceinline__ KParams get_params() { KParams q = (KParams)__builtin_amdgcn_kernarg_segment_ptr(); asm volatile("" : "+s"(q)); return q; }

struct Ctx {
    LAS unsigned char* lds; int tid, lane, wave, G, gwave, nwaves;
};

__device__ __forceinline__ void cvt_tile(const Ctx& F, const float* src, int ldn, bf16_t* dst, int ldd) {
    LAS unsigned char* slab = F.lds + F.wave * 8704;
    const int q = F.lane >> 4, n4 = (F.lane & 15) * 4;
    f32x4 v[16];
#pragma unroll
    for (int i = 0; i < 16; ++i) { const int k = 8 * (i >> 1) + 2 * q + (i & 1); v[i] = *(const f32x4*)(src + (size_t)k * ldn + n4); }
#pragma unroll
    for (int p = 0; p < 8; ++p) { const int k0 = 8 * p + 2 * q;
#pragma unroll
        for (int j = 0; j < 4; ++j) *(LAS unsigned*)(slab + (n4 + j) * 136 + k0 * 2) = cvt_pk_bf16(v[2 * p][j], v[2 * p + 1][j]); }
#pragma unroll
    for (int i = 0; i < 16; ++i) { const int n = 4 * i + q, ch = F.lane & 15;
        const u32x2 w = *(const LAS u32x2*)(slab + n * 136 + ch * 8);
        *(u32x2*)(dst + (size_t)n * ldd + ch * 4) = w; }
}

__device__ __forceinline__ void phase_prologue(KParams p, const Ctx& F) {
    bf16_t* WinT = (bf16_t*)(p->ws + WS_WIN); bf16_t* WoutT = (bf16_t*)(p->ws + WS_WOUT); bf16_t* WguT = (bf16_t*)(p->ws + WS_WGU); bf16_t* WdT = (bf16_t*)(p->ws + WS_WD);
    constexpr int T_IN = 16 * 56, T_OUT = 16 * 16, T_E = NEXP * 128, T_L = T_IN + T_OUT + 3 * T_E;
    for (int task = F.gwave; task < DEPTH * T_L; task += F.nwaves) {
        const int l = task / T_L; int r = task % T_L;
        if (r < T_IN) { const int kt = r / 56, nt = r % 56;
            cvt_tile(F, p->w_in + (size_t)l * DM * PROJ + (size_t)kt * 64 * PROJ + nt * 64, PROJ, WinT + ((size_t)l * PROJ + nt * 64) * DM + kt * 64, DM);
        } else if (r < T_IN + T_OUT) { r -= T_IN; const int kt = r / 16, nt = r % 16;
            cvt_tile(F, p->w_out + (size_t)l * DM * DM + (size_t)kt * 64 * DM + nt * 64, DM, WoutT + ((size_t)l * DM + nt * 64) * DM + kt * 64, DM);
        } else if (r < T_IN + T_OUT + 2 * T_E) { r -= T_IN + T_OUT; const int up = r / T_E; r %= T_E; const int e = r / 128, rr = r % 128, kt = rr / 8, nt = rr % 8, n0 = nt * 64;
            const float* src = (up ? p->e_up : p->e_gate) + ((size_t)(l * NEXP + e) * DM + kt * 64) * DEXP + n0;
            const size_t drow = (size_t)(l * NEXP + e) * 1024 + 256 * (n0 >> 7) + 128 * up + (n0 & 127);
            cvt_tile(F, src, DEXP, WguT + drow * DM + kt * 64, DM);
        } else { r -= T_IN + T_OUT + 2 * T_E; const int e = r / 128, rr = r % 128, kt = rr / 16, nt = rr % 16;
            const float* src = p->e_down + ((size_t)(l * NEXP + e) * DEXP + kt * 64) * DM + nt * 64;
            cvt_tile(F, src, DM, WdT + ((size_t)(l * NEXP + e) * 1024 + nt * 64) * DEXP + kt * 64, DEXP);
        }
    }
    {
        bf16_t* wf = (bf16_t*)(p->ws + WS_LRUW);
        for (int it = blockIdx.x * NTHREADS + F.tid; it < 32768; it += F.G * NTHREADS) {
            const int ln = it & 63, ks = (it >> 6) & 3, ct = (it >> 8) & 1, h = (it >> 9) & 7, m = (it >> 12) & 1, ld = it >> 13;
            const float* src = (m ? p->lru_wx : p->lru_wa) + ((size_t)ld * 8 + h) * 4096 + (size_t)(ks * 16 + 8 * (ln >> 5)) * 64 + ct * 32 + (ln & 31);
            u32x4 o; o[0] = cvt_pk_bf16(src[0], src[64]); o[1] = cvt_pk_bf16(src[128], src[192]); o[2] = cvt_pk_bf16(src[256], src[320]); o[3] = cvt_pk_bf16(src[384], src[448]);
            *(u32x4*)(wf + (size_t)it * 8) = o; }
    }
    __syncthreads();
    LAS float* sc = (LAS float*)F.lds;
    LAS float* red = (LAS float*)(F.lds + 16384);
    for (int i = F.tid; i < NB * DM; i += NTHREADS) sc[i] = siluf_(p->c[i]);
    __syncthreads();
    float* mod = (float*)(p->ws + WS_MOD);
    for (int t = blockIdx.x; t < DEPTH * 96; t += F.G) {
        const int l = t / 96, n0 = (t % 96) * 64;
        const float* w = p->ada_w + (size_t)l * DM * 6 * DM + n0 + F.lane;
        float a0 = 0.f, a1 = 0.f, a2 = 0.f, a3 = 0.f;
        const int k0 = F.wave * 128;
#pragma unroll 8
        for (int k = k0; k < k0 + 128; ++k) { const float wv = w[(size_t)k * 6 * DM]; a0 += sc[k] * wv; a1 += sc[DM + k] * wv; a2 += sc[2 * DM + k] * wv; a3 += sc[3 * DM + k] * wv; }
        red[(F.wave * 4 + 0) * 64 + F.lane] = a0; red[(F.wave * 4 + 1) * 64 + F.lane] = a1; red[(F.wave * 4 + 2) * 64 + F.lane] = a2; red[(F.wave * 4 + 3) * 64 + F.lane] = a3;
        __syncthreads();
        if (F.tid < 256) { const int b = F.tid >> 6, ln = F.tid & 63; float s = p->ada_b[l * 6 * DM + n0 + ln];
#pragma unroll
            for (int w8 = 0; w8 < 8; ++w8) s += red[(w8 * 4 + b) * 64 + ln];
            mod[((size_t)l * NB + b) * 6 * DM + n0 + ln] = s; }
        __syncthreads();
    }
}

__device__ __forceinline__ void phase_norm1(KParams p, const Ctx& F, int l, const float* xin) {
    const float* mod = (const float*)(p->ws + WS_MOD) + (size_t)l * NB * 6 * DM;
    bf16_t* h = (bf16_t*)(p->ws + WS_R2);
    const float* nw = p->norm_mix_w + l * DM;
    for (int row = F.gwave; row < MTOK; row += F.nwaves) {
        const int b = row >> 12; const float* xr = xin + (size_t)row * DM;
        f32x4 v[4]; float ss = 0.f;
#pragma unroll
        for (int i = 0; i < 4; ++i) { v[i] = *(const f32x4*)(xr + F.lane * 4 + 256 * i); ss += v[i][0] * v[i][0] + v[i][1] * v[i][1] + v[i][2] * v[i][2] + v[i][3] * v[i][3]; }
        ss = wave_sum(ss); const float rstd = rsqrtf(ss * (1.0f / DM) + NORM_EPS);
#pragma unroll
        for (int i = 0; i < 4; ++i) { const int col = F.lane * 4 + 256 * i;
            const f32x4 w4 = *(const f32x4*)(nw + col), sh = *(const f32x4*)(mod + (size_t)b * 6 * DM + col), s1 = *(const f32x4*)(mod + (size_t)b * 6 * DM + DM + col);
            f32x4 o = v[i] * rstd * w4 * (s1 + 1.0f) + sh;
            u32x2 pk; pk[0] = cvt_pk_bf16(o[0], o[1]); pk[1] = cvt_pk_bf16(o[2], o[3]);
            *(u32x2*)(h + (size_t)row * DM + col) = pk; }
    }
}

__device__ __forceinline__ void phase_conv(KParams p, const Ctx& F, int l) {
    const bf16_t* proj = (const bf16_t*)(p->ws + WS_R1); float* xc = (float*)(p->ws + WS_XA);
    const float* cw = p->conv_w + l * 4 * DLRU; const float* cb = p->conv_b + l * DLRU;
    for (int it = blockIdx.x * NTHREADS + F.tid; it < MTOK * (DLRU / 4); it += F.G * NTHREADS) {
        const int row = it >> 7, c4 = (it & 127) * 4, t = row & (SEQ - 1);
        f32x4 acc = *(const f32x4*)(cb + c4);
#pragma unroll
        for (int k = 0; k < 4; ++k) { const int tt = t + k - 2;
            if (tt >= 0 && tt < SEQ) { const u32x2 pv = *(const u32x2*)(proj + (size_t)(row + k - 2) * PROJ + c4); const f32x4 w4 = *(const f32x4*)(cw + k * DLRU + c4);
                acc[0] += w4[0] * __uint_as_float(pv[0] << 16); acc[1] += w4[1] * __uint_as_float(pv[0] & 0xFFFF0000u);
                acc[2] += w4[2] * __uint_as_float(pv[1] << 16); acc[3] += w4[3] * __uint_as_float(pv[1] & 0xFFFF0000u); } }
        *(f32x4*)(xc + (size_t)row * DLRU + c4) = acc;
    }
}

__device__ __forceinline__ void lru_seq(KParams p, const Ctx& F, int l, int b, int h) {
    const bf16_t* proj = (const bf16_t*)(p->ws + WS_R1); const float* xc = (const float*)(p->ws + WS_XA); float* tmpz = (float*)(p->ws + WS_XA) + (size_t)MTOK * DLRU;
    const int c = h * 64 + F.lane;
    for (int d = 0; d < 2; ++d) {
        float wa_r[64], wx_r[64];
        const float* wa = p->lru_wa + ((size_t)(l * 2 + d) * 8 + h) * 4096 + F.lane; const float* wx = p->lru_wx + ((size_t)(l * 2 + d) * 8 + h) * 4096 + F.lane;
#pragma unroll
        for (int i = 0; i < 64; ++i) { wa_r[i] = wa[i * 64]; wx_r[i] = wx[i * 64]; }
        const float ba = p->lru_ba[(l * 2 + d) * DLRU + c], bx = p->lru_bx[(l * 2 + d) * DLRU + c], lam = p->lru_lambda[(l * 2 + d) * DLRU + c];
        const float cc = -8.0f * log1pf(expf(-lam));
        float hst = 0.f;
        for (int step = 0; step < SEQ; ++step) {
            const int t = d == 0 ? step : SEQ - 1 - step; const size_t row = (size_t)b * SEQ + t;
            const float xv = xc[row * DLRU + c];
            float ra = ba, rx = bx;
#pragma unroll
            for (int i = 0; i < 64; ++i) { const float xi = rdlane(xv, i); ra += xi * wa_r[i]; rx += xi * wx_r[i]; }
            const float r = sigmoidf_(ra), ig = sigmoidf_(rx), la = cc * r, a = expf(la);
            const float u = sqrtf(fmaxf(-expm1f(2.0f * la), 0.f)) * (ig * xv);
            hst = a * hst + u;
            if (d == 0) tmpz[row * DLRU + c] = hst;
            else { const float yv = bf2f(proj[row * PROJ + DLRU + c]); tmpz[row * DLRU + c] = (tmpz[row * DLRU + c] + hst) * gelu_tanh(yv); }
        }
    }
}

__device__ __forceinline__ float hgrn_lb(KParams p, int l, int ch) {
    if (l == 0) return 0.f;
    const float a = p->hgrn_lb[ch], b = p->hgrn_lb[DHG + ch]; const float m = fmaxf(a, b); const float ea = expf(a - m), eb = expf(b - m);
    return eb / (ea + eb);
}

__device__ __forceinline__ void hgrn_seq(KParams p, const Ctx& F, int l, int b, int h) {
    const bf16_t* proj = (const bf16_t*)(p->ws + WS_R1); float* tmpo = (float*)(p->ws + WS_R2); bf16_t* merged = (bf16_t*)(p->ws + WS_R3);
    const int ch = h * 64 + F.lane;
    const float lbv = hgrn_lb(p, l, ch), nw = p->norm_hgrn_w[l * DHG + ch];
    for (int d = 0; d < 2; ++d) {
        float S[64];
#pragma unroll
        for (int i = 0; i < 64; ++i) S[i] = 0.f;
        const int fcol = (d == 0 ? 1536 : 2048) + ch;
        for (int step = 0; step < SEQ; ++step) {
            const int t = d == 0 ? step : SEQ - 1 - step; const size_t row = (size_t)b * SEQ + t; const bf16_t* pr = proj + row * PROJ;
            const float fl = bf2f(pr[fcol]), qv = bf2f(pr[1024 + ch]), vv = bf2f(pr[2560 + ch]);
            const float f = lbv + (1.0f - lbv) * sigmoidf_(fl), k = 1.0f - f;
            float o = 0.f;
#pragma unroll
            for (int i = 0; i < 64; ++i) { const float fd = rdlane(f, i), kd = rdlane(k, i), qd = rdlane(qv, i); S[i] = fd * S[i] + kd * vv; o += qd * S[i]; }
            if (d == 0) tmpo[row * DHG + ch] = o;
            else { const float ot = tmpo[row * DHG + ch] + o; const float ms = wave_sum(ot * ot) * (1.0f / 64.0f);
                const float gv = bf2f(pr[3072 + ch]); const float y = ot * rsqrtf(ms + NORM_EPS) * nw * siluf_(gv);
                merged[row * DM + DLRU + ch] = f2bf(y); }
        }
    }
}

__device__ __forceinline__ void phase_mixer_seq(KParams p, const Ctx& F, int l) {
#ifdef USE_LRU_SEQ
    if (F.wave == 0 && (int)blockIdx.x < 64) {
        const int id = blockIdx.x;
        if (id < 32) lru_seq(p, F, l, id >> 3, id & 7); else hgrn_seq(p, F, l, (id - 32) >> 3, (id - 32) & 7);
    }
#else
    if (F.wave == 0 && (int)blockIdx.x < 32) hgrn_seq(p, F, l, (int)blockIdx.x >> 3, (int)blockIdx.x & 7);
#endif
}

__device__ __forceinline__ void phase_lru_norm(KParams p, const Ctx& F, int l) {
    const float* tmpz = (const float*)(p->ws + WS_XA) + (size_t)MTOK * DLRU; bf16_t* merged = (bf16_t*)(p->ws + WS_R3); const float* nw = p->norm_lru_w + l * DLRU;
    for (int row = F.gwave; row < MTOK; row += F.nwaves) {
        f32x4 v[2]; float ss = 0.f;
#pragma unroll
        for (int i = 0; i < 2; ++i) { v[i] = *(const f32x4*)(tmpz + (size_t)row * DLRU + F.lane * 4 + 256 * i); ss += v[i][0] * v[i][0] + v[i][1] * v[i][1] + v[i][2] * v[i][2] + v[i][3] * v[i][3]; }
        ss = wave_sum(ss); const float rstd = rsqrtf(ss * (1.0f / DLRU) + NORM_EPS);
#pragma unroll
        for (int i = 0; i < 2; ++i) { const int col = F.lane * 4 + 256 * i; const f32x4 w4 = *(const f32x4*)(nw + col); const f32x4 o = v[i] * rstd * w4;
            u32x2 pk; pk[0] = cvt_pk_bf16(o[0], o[1]); pk[1] = cvt_pk_bf16(o[2], o[3]); *(u32x2*)(merged + (size_t)row * DM + col) = pk; }
    }
}

typedef float f32x16 __attribute__((ext_vector_type(16)));
#define MFMA32(a, b, c) __builtin_amdgcn_mfma_f32_32x32x16_bf16((a), (b), (c), 0, 0, 0)
constexpr int XCP = 1040;
template <bool PASS2>
__device__ __forceinline__ void phase_lru(KParams p, const Ctx& F, int l) {
    const bf16_t* proj = (const bf16_t*)(p->ws + WS_R1);
    float* sumA = (float*)(p->ws + WS_SUMA); float* sumH = (float*)(p->ws + WS_SUMH);
    const bf16x8* wf = (const bf16x8*)(p->ws + WS_LRUW);
    LAS unsigned char* xcb = F.lds; LAS unsigned char* zb = F.lds + 64 * XCP; LAS float* cin = (LAS float*)(F.lds + 128 * XCP);
    const float* cw = p->conv_w + l * 4 * DLRU; const float* cb = p->conv_b + l * DLRU;
    for (int task = blockIdx.x; task < NB * 64; task += F.G) {
        const int b = task >> 6, j = task & 63; const int row0 = b * SEQ + j * 64;
        for (int it = F.tid; it < 64 * 64; it += NTHREADS) {
            const int t = it >> 6, c8 = (it & 63) * 8, tg = j * 64 + t;
            f32x4 a0 = *(const f32x4*)(cb + c8), a1 = *(const f32x4*)(cb + c8 + 4);
#pragma unroll
            for (int k = 0; k < 4; ++k) { const int tt = tg + k - 2;
                if (tt >= 0 && tt < SEQ) { const u32x4 pv = *(const u32x4*)(proj + (size_t)(b * SEQ + tt) * PROJ + c8);
                    const f32x4 w0 = *(const f32x4*)(cw + k * DLRU + c8), w1 = *(const f32x4*)(cw + k * DLRU + c8 + 4);
                    a0[0] += w0[0] * __uint_as_float(pv[0] << 16); a0[1] += w0[1] * __uint_as_float(pv[0] & 0xFFFF0000u);
                    a0[2] += w0[2] * __uint_as_float(pv[1] << 16); a0[3] += w0[3] * __uint_as_float(pv[1] & 0xFFFF0000u);
                    a1[0] += w1[0] * __uint_as_float(pv[2] << 16); a1[1] += w1[1] * __uint_as_float(pv[2] & 0xFFFF0000u);
                    a1[2] += w1[2] * __uint_as_float(pv[3] << 16); a1[3] += w1[3] * __uint_as_float(pv[3] & 0xFFFF0000u); } }
            u32x4 o; o[0] = cvt_pk_bf16(a0[0], a0[1]); o[1] = cvt_pk_bf16(a0[2], a0[3]); o[2] = cvt_pk_bf16(a1[0], a1[1]); o[3] = cvt_pk_bf16(a1[2], a1[3]);
            *(LAS u32x4*)(xcb + t * XCP + c8 * 2) = o;
            if (PASS2) *(LAS u32x4*)(zb + t * XCP + c8 * 2) = *(const u32x4*)(proj + (size_t)(row0 + t) * PROJ + DLRU + c8);
        }
        if (PASS2) {
            const int c = F.tid; float s = 0.f;
            for (int k = 0; k < j; ++k) { const size_t idx = ((size_t)(0 * NB + b) * 64 + k) * DLRU + c; s = sumA[idx] * s + sumH[idx]; }
            cin[c] = s; s = 0.f;
            for (int k = 63; k > j; --k) { const size_t idx = ((size_t)(1 * NB + b) * 64 + k) * DLRU + c; s = sumA[idx] * s + sumH[idx]; }
            cin[DLRU + c] = s;
        }
        __syncthreads();
        {
            const int h = F.wave, r = F.lane & 31, hh = F.lane >> 5;
            const LAS unsigned char* abase = xcb + (32 * ((r >> 2) & 1) + 4 * (r >> 3) + (r & 3)) * XCP + (h * 64 + 8 * hh) * 2;
#pragma unroll 1
            for (int ct = 0; ct < 2; ++ct) {
                const int c = h * 64 + ct * 32 + r;
                float hf[32];
#pragma unroll
                for (int d = 0; d < 2; ++d) {
                    const bf16x8* wba = wf + ((((size_t)(l * 2 + d) * 2 + 0) * 8 + h) * 2 + ct) * 4 * 64 + F.lane;
                    const bf16x8* wbx = wf + ((((size_t)(l * 2 + d) * 2 + 1) * 8 + h) * 2 + ct) * 4 * 64 + F.lane;
                    bf16x8 Ba[4], Bx[4];
#pragma unroll
                    for (int ks = 0; ks < 4; ++ks) { Ba[ks] = wba[ks * 64]; Bx[ks] = wbx[ks * 64]; }
                    const float ba = p->lru_ba[(l * 2 + d) * DLRU + c], bx = p->lru_bx[(l * 2 + d) * DLRU + c];
                    const float cc = -8.0f * log1pf(__expf(-p->lru_lambda[(l * 2 + d) * DLRU + c]));
                    float av[32], uv[32];
#pragma unroll
                    for (int rt = 0; rt < 2; ++rt) {
                        f32x16 za, zx;
#pragma unroll
                        for (int e = 0; e < 16; ++e) { za[e] = 0.f; zx[e] = 0.f; }
#pragma unroll
                        for (int ks = 0; ks < 4; ++ks) { const bf16x8 Af = *(const LAS bf16x8*)(abase + 16 * rt * XCP + ks * 32);
                            za = MFMA32(Af, Ba[ks], za); zx = MFMA32(Af, Bx[ks], zx); }
#pragma unroll
                        for (int reg = 0; reg < 16; ++reg) { const int i = 16 * rt + reg;
                            const float xcv = bf2f(*(const LAS bf16_t*)(xcb + (32 * hh + i) * XCP + c * 2));
                            const float rg = sigmoidf_(za[reg] + ba), ig = sigmoidf_(zx[reg] + bx), la = cc * rg;
                            av[i] = __expf(la); uv[i] = sqrtf(fmaxf(1.0f - __expf(2.0f * la), 0.f)) * (ig * xcv); }
                    }
                    if (d == 0) {
#pragma unroll
                        for (int i = 1; i < 32; ++i) { uv[i] = av[i] * uv[i - 1] + uv[i]; av[i] = av[i] * av[i - 1]; }
                    } else {
#pragma unroll
                        for (int i = 30; i >= 0; --i) { uv[i] = av[i] * uv[i + 1] + uv[i]; av[i] = av[i] * av[i + 1]; }
                    }
                    const float myP = (d == 0) ? av[31] : av[0], myH = (d == 0) ? uv[31] : uv[0];
                    const float oP = __shfl_xor(myP, 32, 64), oH = __shfl_xor(myH, 32, 64);
                    if (!PASS2) {
                        if (hh == 0) { const size_t idx = ((size_t)(d * NB + b) * 64 + j) * DLRU + c;
                            sumA[idx] = myP * oP;
                            sumH[idx] = (d == 0) ? (oH + oP * myH) : (myH + myP * oH); }
                    } else {
                        const float cinv = cin[d * DLRU + c];
                        const bool first = (d == 0) ? (hh == 0) : (hh == 1);
                        const float cy = first ? cinv : (oH + oP * cinv);
                        if (d == 0) {
#pragma unroll
                            for (int i = 0; i < 32; ++i) hf[i] = uv[i] + av[i] * cy;
                        } else {
#pragma unroll
                            for (int i = 0; i < 32; ++i) { const float hs = hf[i] + uv[i] + av[i] * cy;
                                LAS bf16_t* zp = (LAS bf16_t*)(zb + (32 * hh + i) * XCP + c * 2);
                                *zp = f2bf(hs * gelu_tanh(bf2f(*zp))); }
                        }
                    }
                }
            }
        }
        if (PASS2) {
            __syncthreads();
            bf16_t* merged = (bf16_t*)(p->ws + WS_R3); const float* nw = p->norm_lru_w + l * DLRU;
            const f32x4 w0 = *(const f32x4*)(nw + F.lane * 8), w1 = *(const f32x4*)(nw + F.lane * 8 + 4);
#pragma unroll
            for (int q = 0; q < 8; ++q) { const int t = F.wave * 8 + q;
                const u32x4 zv = *(const LAS u32x4*)(zb + t * XCP + F.lane * 16);
                float z[8];
#pragma unroll
                for (int e = 0; e < 4; ++e) { z[2 * e] = __uint_as_float(zv[e] << 16); z[2 * e + 1] = __uint_as_float(zv[e] & 0xFFFF0000u); }
                float ss = 0.f;
#pragma unroll
                for (int e = 0; e < 8; ++e) ss += z[e] * z[e];
                ss = wave_sum(ss); const float rstd = rsqrtf(ss * (1.0f / DLRU) + NORM_EPS);
                u32x4 o; o[0] = cvt_pk_bf16(z[0] * rstd * w0[0], z[1] * rstd * w0[1]); o[1] = cvt_pk_bf16(z[2] * rstd * w0[2], z[3] * rstd * w0[3]);
                o[2] = cvt_pk_bf16(z[4] * rstd * w1[0], z[5] * rstd * w1[1]); o[3] = cvt_pk_bf16(z[6] * rstd * w1[2], z[7] * rstd * w1[3]);
                *(u32x4*)(merged + (size_t)(row0 + t) * DM + F.lane * 8) = o; }
        }
        __syncthreads();
    }
}

typedef __bf16 bf16v8 __attribute__((ext_vector_type(8)));
typedef float f32x8 __attribute__((ext_vector_type(8)));
__device__ __forceinline__ bf16x8 pk8(float a0, float a1, float a2, float a3, float a4, float a5, float a6, float a7) {
    const f32x8 w = {a0, a1, a2, a3, a4, a5, a6, a7}; return __builtin_bit_cast(bf16x8, __builtin_convertvector(w, bf16v8)); }
#define PACK_STEP(x, s) pk8((x)[8 * (s)], (x)[8 * (s) + 1], (x)[8 * (s) + 2], (x)[8 * (s) + 3], (x)[8 * (s) + 4], (x)[8 * (s) + 5], (x)[8 * (s) + 6], (x)[8 * (s) + 7])
__device__ __forceinline__ int crow(int reg, int hh) { return (reg & 3) + 8 * (reg >> 2) + 4 * hh; }
template <int KIND> __device__ __forceinline__ bf16x8 mk_const(int ks, int hh, int r) {
    bf16x8 v;
#pragma unroll
    for (int j = 0; j < 8; ++j) { const int kn = 16 * ks + 8 * hh + j, kp = 16 * ks + 8 * (j >> 2) + 4 * hh + (j & 3);
        const bool on = KIND == 0 ? (kn <= r) : KIND == 1 ? (kn > r) : KIND == 2 ? (kn == r) : (kp == r);
        v[j] = on ? (short)0x3F80 : (short)0; }
    return v;
}
constexpr int HG_TASKS = NB * 8 * 2 * 32;
constexpr int HG_WLDS = 12288;
template <bool PASS2>
__device__ __forceinline__ void phase_hgrn(KParams p, const Ctx& F, int l) {
    const bf16_t* proj = (const bf16_t*)(p->ws + WS_R1);
    float* Usum = (float*)(p->ws + WS_R2); float* Dsum = Usum + (size_t)HG_TASKS * 4096;
    float* osc = (float*)(p->ws + WS_XA);
    int lz = F.lane; asm volatile("" : "+v"(lz));
    const int r = lz & 31, hh = lz >> 5;
    LAS unsigned char* wl = F.lds + F.wave * HG_WLDS;
    const LAS unsigned char* rdA = wl + (8 * hh) * 128 + r * 2;
    const LAS unsigned char* rdV = wl + 8192 + (4 * hh) * 128 + r * 2;
    for (int wg = blockIdx.x; wg < 256; wg += F.G) {
        const int b = wg >> 6, h = (wg >> 3) & 7, g = wg & 7;
        const int dir = F.wave & 1, tr = g * 4 + (F.wave >> 1);
        const int task = ((b * 8 + h) * 2 + dir) * 32 + tr;
        const int r0 = b * SEQ + tr * 128;
        const int fcol = (dir == 0 ? 1536 : 2048) + h * 64;
        const float lb0 = hgrn_lb(p, l, h * 64 + r), lb1 = hgrn_lb(p, l, h * 64 + 32 + r);
        f32x16 S[2][2];
#pragma unroll
        for (int a = 0; a < 2; ++a) {
#pragma unroll
            for (int e = 0; e < 16; ++e) { S[a][0][e] = 0.f; S[a][1][e] = 0.f; } }
        if (PASS2) {
#pragma unroll
            for (int a = 0; a < 2; ++a)
#pragma unroll
                for (int c = 0; c < 2; ++c)
#pragma unroll
                    for (int e = 0; e < 16; ++e) S[a][c][e] = *(const float*)((const char*)Usum + ((unsigned)(task * 4096 + lz) * 4u + (unsigned)(((a * 2 + c) * 16 + e) * 256)));
        }
#pragma unroll 1
        for (int ci = 0; ci < 4; ++ci) {
            const int rbase = dir == 0 ? r0 + 32 * ci : r0 + 127 - 32 * ci, sg = dir == 0 ? 1 : -1;
            {
                int lq = lz; asm volatile("" : "+v"(lq));
                const int lrow = lq >> 3, lcol = (lq & 7) * 8;
#pragma unroll
                for (int i = 0; i < 4; ++i) { const int tau = 8 * i + lrow; const char* pr = (const char*)proj + (unsigned)(((rbase + sg * tau) * PROJ + h * 64 + lcol) * 2);
                    const u32x4 vf = *(const u32x4*)(pr + (fcol - h * 64) * 2), vv = *(const u32x4*)(pr + 2560 * 2);
                    *(LAS u32x4*)(wl + tau * 128 + lcol * 2) = vf; *(LAS u32x4*)(wl + 8192 + tau * 128 + lcol * 2) = vv;
                    if (PASS2) { const u32x4 vq = *(const u32x4*)(pr + 1024 * 2); *(LAS u32x4*)(wl + 4096 + tau * 128 + lcol * 2) = vq; } }
            }
            __builtin_amdgcn_sched_barrier(0);
#define LOAD_VP(c, ks, dst) do { _Pragma("unroll") for (int j = 0; j < 8; ++j) (dst)[j] = (short)*(const LAS bf16_t*)(rdV + (16 * (ks) + 8 * (j >> 2) + (j & 3)) * 128 + 64 * (c)); } while (0)
            f32x16 O[2], sc;
            if (PASS2) {
#pragma unroll
                for (int e = 0; e < 16; ++e) { O[0][e] = 0.f; O[1][e] = 0.f; sc[e] = 0.f; } }
#pragma unroll
            for (int a = 0; a < 2; ++a) {
                const float lbv = a == 0 ? lb0 : lb1;
                bf16x8 Ahi[2], Alo[2];
                f32x16 kT, qT;
#pragma unroll
                for (int e = 0; e < 16; ++e) { kT[e] = 0.f; qT[e] = 0.f; }
#pragma unroll
                for (int ks = 0; ks < 2; ++ks) {
                    float lf[8], kk[8];
#pragma unroll
                    for (int j = 0; j < 8; ++j) { const float fl = bf2f(*(const LAS bf16_t*)(rdA + (16 * ks + j) * 128 + 64 * a));
                        const float f = lbv + (1.0f - lbv) * sigmoidf_(fl);
                        lf[j] = fmaxf(__logf(f), -80.0f); kk[j] = 1.0f - f; }
                    Ahi[ks] = pk8(lf[0], lf[1], lf[2], lf[3], lf[4], lf[5], lf[6], lf[7]);
                    float lo[8];
#pragma unroll
                    for (int j = 0; j < 8; ++j) lo[j] = lf[j] - bf2f((bf16_t)Ahi[ks][j]);
                    Alo[ks] = pk8(lo[0], lo[1], lo[2], lo[3], lo[4], lo[5], lo[6], lo[7]);
                    const bf16x8 Ak = pk8(kk[0], kk[1], kk[2], kk[3], kk[4], kk[5], kk[6], kk[7]);
                    const bf16x8 Id = mk_const<2>(ks, hh, r);
                    kT = MFMA32(Ak, Id, kT);
                    if (PASS2) { bf16x8 Aq;
#pragma unroll
                        for (int j = 0; j < 8; ++j) Aq[j] = (short)*(const LAS bf16_t*)(rdA + 4096 + (16 * ks + j) * 128 + 64 * a);
                        qT = MFMA32(Aq, Id, qT); }
                }
                __builtin_amdgcn_sched_barrier(0);
                if (PASS2) {
                    f32x16 bT;
#pragma unroll
                    for (int e = 0; e < 16; ++e) bT[e] = 0.f;
#pragma unroll
                    for (int ks = 0; ks < 2; ++ks) { const bf16x8 Mle = mk_const<0>(ks, hh, r); bT = MFMA32(Ahi[ks], Mle, bT); bT = MFMA32(Alo[ks], Mle, bT); }
#pragma unroll
                    for (int e = 0; e < 16; ++e) bT[e] = qT[e] * __expf(bT[e]);
#pragma unroll
                    for (int s2 = 0; s2 < 2; ++s2) { const bf16x8 Qtp = PACK_STEP(bT, s2);
#pragma unroll
                        for (int c = 0; c < 2; ++c) O[c] = MFMA32(Qtp, PACK_STEP(S[a][c], s2), O[c]); }
                    __builtin_amdgcn_sched_barrier(0);
                }
                bf16x8 Kh0, Kh1;
                {
                    f32x16 RT;
#pragma unroll
                    for (int e = 0; e < 16; ++e) RT[e] = 0.f;
#pragma unroll
                    for (int ks = 0; ks < 2; ++ks) { const bf16x8 Mgt = mk_const<1>(ks, hh, r); RT = MFMA32(Ahi[ks], Mgt, RT); RT = MFMA32(Alo[ks], Mgt, RT); }
#pragma unroll
                    for (int e = 0; e < 16; ++e) { kT[e] *= __expf(RT[e]); if (PASS2) qT[e] *= __expf(fminf(-RT[e], 80.0f)); }
                    Kh0 = PACK_STEP(kT, 0); Kh1 = PACK_STEP(kT, 1);
                    if (PASS2) { sc = MFMA32(Kh0, PACK_STEP(qT, 0), sc); sc = MFMA32(Kh1, PACK_STEP(qT, 1), sc); }
                    __builtin_amdgcn_sched_barrier(0);
                }
                {
                    f32x16 CT;
#pragma unroll
                    for (int e = 0; e < 16; ++e) CT[e] = 0.f;
#pragma unroll
                    for (int ks = 0; ks < 2; ++ks) { bf16x8 One;
#pragma unroll
                        for (int j = 0; j < 8; ++j) One[j] = (short)0x3F80;
                        CT = MFMA32(Ahi[ks], One, CT); CT = MFMA32(Alo[ks], One, CT); }
#pragma unroll
                    for (int e = 0; e < 16; ++e) { const float dd = __expf(CT[e]); S[a][0][e] *= dd; S[a][1][e] *= dd; if (!PASS2) CT[e] = dd; }
                    if (!PASS2 && r == 0) {
#pragma unroll
                        for (int e = 0; e < 16; ++e) Dsum[((size_t)task * 4 + ci) * 64 + 32 * a + crow(e, hh)] = CT[e]; }
                    __builtin_amdgcn_sched_barrier(0);
                }
                {
                    f32x16 Ks;
#pragma unroll
                    for (int e = 0; e < 16; ++e) Ks[e] = 0.f;
                    Ks = MFMA32(Kh0, mk_const<3>(0, hh, r), Ks); Ks = MFMA32(Kh1, mk_const<3>(1, hh, r), Ks);
#pragma unroll
                    for (int ks = 0; ks < 2; ++ks) { const bf16x8 Ksp = PACK_STEP(Ks, ks);
#pragma unroll
                        for (int c = 0; c < 2; ++c) { bf16x8 Vp; LOAD_VP(c, ks, Vp); S[a][c] = MFMA32(Ksp, Vp, S[a][c]); } }
                    __builtin_amdgcn_sched_barrier(0);
                }
            }
            if (PASS2) {
#pragma unroll
                for (int e = 0; e < 16; ++e) sc[e] = (crow(e, hh) <= r) ? sc[e] : 0.f;
#pragma unroll
                for (int ks = 0; ks < 2; ++ks) { const bf16x8 Pp = PACK_STEP(sc, ks);
#pragma unroll
                    for (int c = 0; c < 2; ++c) { bf16x8 Vp; LOAD_VP(c, ks, Vp); O[c] = MFMA32(Pp, Vp, O[c]); } }
                int lq2 = lz; asm volatile("" : "+v"(lq2));
                const int r2 = lq2 & 31, hh2 = lq2 >> 5;
#pragma unroll
                for (int c = 0; c < 2; ++c)
#pragma unroll
                    for (int e = 0; e < 16; ++e) *(float*)((char*)osc + (unsigned)((((dir * MTOK + rbase + sg * crow(e, hh2)) * DHG) + h * 64 + 32 * c + r2) * 4)) = O[c][e];
            }
#undef LOAD_VP
        }
        if (!PASS2) {
#pragma unroll
            for (int a = 0; a < 2; ++a)
#pragma unroll
                for (int c = 0; c < 2; ++c)
#pragma unroll
                    for (int e = 0; e < 16; ++e) *(float*)((char*)Usum + ((unsigned)(task * 4096 + lz) * 4u + (unsigned)(((a * 2 + c) * 16 + e) * 256))) = S[a][c][e];
        } else {
            asm volatile("s_waitcnt vmcnt(0)" ::: "memory");
            __syncthreads();
            bf16_t* merged = (bf16_t*)(p->ws + WS_R3);
            const int ch = h * 64 + F.lane; const float nw = p->norm_hgrn_w[l * DHG + ch];
#pragma unroll 4
            for (int i = 0; i < 64; ++i) { const int row = b * SEQ + g * 512 + F.wave * 64 + i;
                const float ot = *(const float*)((const char*)osc + (unsigned)((row * DHG + ch) * 4)) + *(const float*)((const char*)osc + (unsigned)(((MTOK + row) * DHG + ch) * 4));
                const float ms = wave_sum(ot * ot) * (1.0f / 64.0f);
                const float gv = bf2f(*(const bf16_t*)((const char*)proj + (unsigned)((row * PROJ + 3072 + ch) * 2)));
                *(bf16_t*)((char*)merged + (unsigned)((row * DM + DLRU + ch) * 2)) = f2bf(ot * rsqrtf(ms + NORM_EPS) * nw * siluf_(gv)); }
            __syncthreads();
        }
    }
}

__device__ __forceinline__ void phase_hgrn_prefix(KParams p, const Ctx& F) {
    float* Usum = (float*)(p->ws + WS_R2); const float* Dsum = Usum + (size_t)HG_TASKS * 4096;
    for (int gt = blockIdx.x * NTHREADS + F.tid; gt < 64 * 4096; gt += F.G * NTHREADS) {
        const int seq = gt >> 12, e = gt & 4095, dir = seq & 1;
        const int tile = e >> 10, reg = (e >> 6) & 15, ln = e & 63; const int d = 32 * (tile >> 1) + crow(reg, ln >> 5);
        float s = 0.f;
#pragma unroll 8
        for (int k = 0; k < 32; ++k) { const int trp = dir == 0 ? k : 31 - k; const size_t tp = (size_t)seq * 32 + trp;
            const float u = Usum[tp * 4096 + e], dd = Dsum[(tp * 4 + 0) * 64 + d] * Dsum[(tp * 4 + 1) * 64 + d] * Dsum[(tp * 4 + 2) * 64 + d] * Dsum[(tp * 4 + 3) * 64 + d];
            Usum[tp * 4096 + e] = s; s = dd * s + u; }
    }
}

__device__ __forceinline__ void phase_route(KParams p, const Ctx& F, int l) {
    const float* mod = (const float*)(p->ws + WS_MOD) + (size_t)l * NB * 6 * DM;
    const float* xa = (const float*)(p->ws + WS_XA); bf16_t* h2 = (bf16_t*)(p->ws + WS_R2);
    const float* nw = p->norm_ffn_w + l * DM;
    int* cnt = (int*)(p->ws + WS_CTL + CTL_CNT_OFF) + l * NEXP;
    int* tokinfo = (int*)(p->ws + WS_TOKINFO); float* tokw = (float*)(p->ws + WS_TOKW);
    LAS float* hrow = (LAS float*)(F.lds + F.wave * 4096);
    const float* rew = p->re_w + (size_t)l * DM * NEXP; const float* rgw = p->rg_w + (size_t)l * DM * NGRP;
    for (int row = F.gwave; row < MTOK; row += F.nwaves) {
        const int b = row >> 12; const float* xr = xa + (size_t)row * DM;
        f32x4 v[4]; float ss = 0.f;
#pragma unroll
        for (int i = 0; i < 4; ++i) { v[i] = *(const f32x4*)(xr + F.lane * 4 + 256 * i); ss += v[i][0] * v[i][0] + v[i][1] * v[i][1] + v[i][2] * v[i][2] + v[i][3] * v[i][3]; }
        ss = wave_sum(ss); const float rstd = rsqrtf(ss * (1.0f / DM) + NORM_EPS);
#pragma unroll
        for (int i = 0; i < 4; ++i) { const int col = F.lane * 4 + 256 * i;
            const f32x4 w4 = *(const f32x4*)(nw + col), sh = *(const f32x4*)(mod + (size_t)b * 6 * DM + 3 * DM + col), s1 = *(const f32x4*)(mod + (size_t)b * 6 * DM + 4 * DM + col);
            const f32x4 o = v[i] * rstd * w4 * (s1 + 1.0f) + sh;
            u32x2 pk; pk[0] = cvt_pk_bf16(o[0], o[1]); pk[1] = cvt_pk_bf16(o[2], o[3]);
            *(u32x2*)(h2 + (size_t)row * DM + col) = pk;
            *(LAS f32x4*)(hrow + col) = o; }
        const int ks = F.lane >> 3, o4 = F.lane & 7;
        f32x4 ae = (f32x4){0.f, 0.f, 0.f, 0.f};
#pragma unroll 8
        for (int i = 0; i < 128; ++i) { const int k = ks + 8 * i; const float hv = hrow[k]; const f32x4 wv = *(const f32x4*)(rew + (size_t)k * NEXP + o4 * 4); ae += wv * hv; }
#pragma unroll
        for (int m = 8; m <= 32; m <<= 1) { ae[0] += __shfl_xor(ae[0], m, 64); ae[1] += __shfl_xor(ae[1], m, 64); ae[2] += __shfl_xor(ae[2], m, 64); ae[3] += __shfl_xor(ae[3], m, 64); }
        f32x4 ag = (f32x4){0.f, 0.f, 0.f, 0.f};
#pragma unroll 4
        for (int i = 0; i < 16; ++i) { const int k = F.lane + 64 * i; const float hv = hrow[k]; const f32x4 wv = *(const f32x4*)(rgw + (size_t)k * NGRP); ag += wv * hv; }
        ag[0] = wave_sum(ag[0]); ag[1] = wave_sum(ag[1]); ag[2] = wave_sum(ag[2]); ag[3] = wave_sum(ag[3]);
        float gl[4];
#pragma unroll
        for (int j = 0; j < 4; ++j) gl[j] = ag[j] + p->rg_b[l * NGRP + j];
        int gi = 0; float gm = gl[0];
#pragma unroll
        for (int j = 1; j < 4; ++j) if (gl[j] > gm) { gm = gl[j]; gi = j; }
        float gs = 0.f;
#pragma unroll
        for (int j = 0; j < 4; ++j) gs += __expf(gl[j] - gm);
        const float pg = 1.0f / gs;
        gi = __builtin_amdgcn_readfirstlane(gi);
        float el[8];
#pragma unroll
        for (int j = 0; j < 4; ++j) { el[j] = __shfl(ae[j], 2 * gi, 64) + p->re_b[l * NEXP + gi * 8 + j]; el[4 + j] = __shfl(ae[j], 2 * gi + 1, 64) + p->re_b[l * NEXP + gi * 8 + 4 + j]; }
        int i0 = 0; float v0 = el[0];
#pragma unroll
        for (int j = 1; j < 8; ++j) if (el[j] > v0) { v0 = el[j]; i0 = j; }
        int i1 = -1; float v1 = -3.0e38f;
#pragma unroll
        for (int j = 0; j < 8; ++j) if (j != i0 && el[j] > v1) { v1 = el[j]; i1 = j; }
        const float ex = __expf(v1 - v0); const float w0 = pg / (1.0f + ex), w1 = pg * ex / (1.0f + ex);
        if (F.lane == 0) {
            const int e0 = gi * 8 + i0, e1 = gi * 8 + i1;
            const int p0 = atomicAdd(&cnt[e0], 1), p1 = atomicAdd(&cnt[e1], 1);
            *(int4*)(tokinfo + (size_t)row * 4) = make_int4(e0, p0, e1, p1);
            *(float2*)(tokw + (size_t)row * 2) = make_float2(w0, w1);
        }
    }
}

constexpr int MOE_MAX_UNITS = 8;
__device__ __forceinline__ void build_tile_table(KParams p, const Ctx& F, int l) {
    LAS int* tst = (LAS int*)(F.lds + LDS_MISC + 64);
    LAS int* ulist = (LAS int*)(F.lds + LDS_MISC + 256);
    const int* cnt = (const int*)(p->ws + WS_CTL + CTL_CNT_OFF) + l * NEXP;
    if (F.tid == 0) { int acc = 0; for (int e = 0; e < NEXP; ++e) { tst[e] = acc; acc += (__hip_atomic_load(cnt + e, __ATOMIC_RELAXED, __HIP_MEMORY_SCOPE_AGENT) + 255) >> 8; } tst[NEXP] = acc; }
    __syncthreads();
    if (F.tid <= MOE_MAX_UNITS) { const int L = F.tid * F.G + (int)blockIdx.x, tm = tst[NEXP]; int pm = -1, pn = 0;
        if (F.tid < MOE_MAX_UNITS && L < tm * 4) { const int mt = L >> 2; int e = 0; for (int k = 1; k < NEXP; ++k) e += (tst[k] <= mt) ? 1 : 0; pm = mt; pn = e * 4 + (L & 3); }
        ulist[2 * F.tid] = pm; ulist[2 * F.tid + 1] = pn; }
    __syncthreads();
}

__device__ __forceinline__ void phase_permute(KParams p, const Ctx& F, int l) {
    build_tile_table(p, F, l);
    const LAS int* tst = (const LAS int*)(F.lds + LDS_MISC + 64);
    const bf16_t* h2 = (const bf16_t*)(p->ws + WS_R2); bf16_t* xperm = (bf16_t*)(p->ws + WS_R1);
    const int* tokinfo = (const int*)(p->ws + WS_TOKINFO); const float* tokw = (const float*)(p->ws + WS_TOKW);
    int* rowtok = (int*)(p->ws + WS_ROWTOK); float* roww = (float*)(p->ws + WS_ROWW);
    const int* cnt = (const int*)(p->ws + WS_CTL + CTL_CNT_OFF) + l * NEXP;
    for (int row = F.gwave; row < MTOK; row += F.nwaves) {
        const int4 ti = *(const int4*)(tokinfo + (size_t)row * 4); const float2 tw = *(const float2*)(tokw + (size_t)row * 2);
        const int r0 = tst[ti.x] * 256 + ti.y, r1 = tst[ti.z] * 256 + ti.w;
        const u32x4 a = *(const u32x4*)(h2 + (size_t)row * DM + F.lane * 8), b2 = *(const u32x4*)(h2 + (size_t)row * DM + 512 + F.lane * 8);
        *(u32x4*)(xperm + (size_t)r0 * DM + F.lane * 8) = a; *(u32x4*)(xperm + (size_t)r0 * DM + 512 + F.lane * 8) = b2;
        *(u32x4*)(xperm + (size_t)r1 * DM + F.lane * 8) = a; *(u32x4*)(xperm + (size_t)r1 * DM + 512 + F.lane * 8) = b2;
        if (F.lane == 0) { rowtok[r0] = row * 2; rowtok[r1] = row * 2 + 1; roww[r0] = tw.x; roww[r1] = tw.y; }
    }
    if ((int)blockIdx.x < NEXP) { const int e = blockIdx.x; const int c = __hip_atomic_load(cnt + e, __ATOMIC_RELAXED, __HIP_MEMORY_SCOPE_AGENT);
        const int lo = tst[e] * 256 + c, hi = tst[e + 1] * 256;
        for (int r = lo + F.tid; r < hi; r += NTHREADS) { rowtok[r] = -1; roww[r] = 0.f; } }
}

template <bool FINAL>
__device__ __forceinline__ void phase_combine(KParams p, const Ctx& F, int l, float* xo) {
    const float* mod = (const float*)(p->ws + WS_MOD) + (size_t)l * NB * 6 * DM;
    const float* xa = (const float*)(p->ws + WS_XA); const bf16_t* y = (const bf16_t*)(p->ws + WS_R1);
    for (int row = F.gwave; row < MTOK; row += F.nwaves) {
        const int b = row >> 12; f32x4 v[4]; float ss = 0.f;
#pragma unroll
        for (int i = 0; i < 4; ++i) { const int col = F.lane * 4 + 256 * i;
            const f32x4 xv = *(const f32x4*)(xa + (size_t)row * DM + col), g = *(const f32x4*)(mod + (size_t)b * 6 * DM + 5 * DM + col);
            const u32x2 y0 = *(const u32x2*)(y + (size_t)(row * 2) * DM + col), y1 = *(const u32x2*)(y + (size_t)(row * 2 + 1) * DM + col);
            f32x4 ys; ys[0] = __uint_as_float(y0[0] << 16) + __uint_as_float(y1[0] << 16); ys[1] = __uint_as_float(y0[0] & 0xFFFF0000u) + __uint_as_float(y1[0] & 0xFFFF0000u);
            ys[2] = __uint_as_float(y0[1] << 16) + __uint_as_float(y1[1] << 16); ys[3] = __uint_as_float(y0[1] & 0xFFFF0000u) + __uint_as_float(y1[1] & 0xFFFF0000u);
            v[i] = xv + g * ys; ss += v[i][0] * v[i][0] + v[i][1] * v[i][1] + v[i][2] * v[i][2] + v[i][3] * v[i][3]; }
        if (FINAL) { ss = wave_sum(ss); const float rstd = rsqrtf(ss * (1.0f / DM) + NORM_EPS);
#pragma unroll
            for (int i = 0; i < 4; ++i) { const int col = F.lane * 4 + 256 * i; const f32x4 w4 = *(const f32x4*)(p->final_w + col); *(f32x4*)(p->out + (size_t)row * DM + col) = v[i] * rstd * w4; }
        } else {
#pragma unroll
            for (int i = 0; i < 4; ++i) *(f32x4*)(xo + (size_t)row * DM + F.lane * 4 + 256 * i) = v[i];
        }
    }
}


__device__ __forceinline__ Ctx make_ctx(LAS unsigned char* lds) {
    int tz = threadIdx.x; asm volatile("" : "+v"(tz));
    Ctx F; F.lds = lds; F.tid = tz; F.lane = tz & 63; F.wave = __builtin_amdgcn_readfirstlane(tz >> 6);
    F.G = gridDim.x; F.gwave = blockIdx.x * NWAVES + F.wave; F.nwaves = F.G * NWAVES; return F;
}

constexpr int PH_PER_LAYER = 11, N_PHASES = 1 + DEPTH * PH_PER_LAYER;
#ifndef DBG_MASK
#define DBG_MASK 0xFFFFFFFFu
#endif
#define IN(k) ((((DBG_MASK) >> ((k) == 0 ? 0 : (((k) - 1) % PH_PER_LAYER) + 1)) & 1u) && lo <= (k) && (k) < hi)
#define SEAM(k) do { if (IN(k) && IN((k) + 1)) xcd_barrier(bar); } while (0)
#define SITE KParams P = get_params(); const Ctx F = make_ctx(lds);

template <int l>
__device__ __forceinline__ void run_layer(LAS unsigned char* const lds, const int lo, const int hi, const XcdBarrier& bar) {
        const int base = 1 + l * PH_PER_LAYER;
        if (IN(base + 0)) { SITE phase_norm1(P, F, l, (l == 0) ? P->x : P->out); }
        SEAM(base + 0);
        if (IN(base + 1)) { SITE
            pg8::Gemm g{(const bf16_t*)(P->ws + WS_R2), (const bf16_t*)(P->ws + WS_WIN) + (size_t)l * PROJ * DM, MTOK, PROJ, DM};
            pg8::StaticOrder S; S.init(MTOK, PROJ, F.G, (int)blockIdx.x);
            pg8::EpiBf16 E{(bf16_t*)(P->ws + WS_R1), PROJ};
            pg8::gemm_phase(F.lds, g, S, E);
        }
        SEAM(base + 1);
        if (IN(base + 2)) { SITE phase_lru<false>(P, F, l); }
        if (IN(base + 2)) { SITE phase_hgrn<false>(P, F, l); }
        SEAM(base + 2);
        if (IN(base + 3)) { SITE phase_lru<true>(P, F, l); }
        if (IN(base + 3)) { SITE phase_hgrn_prefix(P, F); }
        SEAM(base + 3);
        if (IN(base + 4)) { SITE phase_hgrn<true>(P, F, l); }
        SEAM(base + 4);
        if (IN(base + 5)) { SITE
            pg8::Gemm g{(const bf16_t*)(P->ws + WS_R3), (const bf16_t*)(P->ws + WS_WOUT) + (size_t)l * DM * DM, MTOK, DM, DM};
            pg8::StaticOrder S; S.init(MTOK, DM, F.G, (int)blockIdx.x);
            pg8::EpiResid E{(l == 0) ? P->x : P->out, (float*)(P->ws + WS_XA), (const float*)(P->ws + WS_MOD) + (size_t)l * NB * 6 * DM + 2 * DM};
            pg8::gemm_phase(F.lds, g, S, E);
        }
        SEAM(base + 5);
        if (IN(base + 6)) { SITE phase_route(P, F, l); }
        SEAM(base + 6);
        if (IN(base + 7)) { SITE phase_permute(P, F, l); }
        SEAM(base + 7);
        if (IN(base + 8)) { SITE
            build_tile_table(P, F, l);
            pg8::Gemm g{(const bf16_t*)(P->ws + WS_R1), (const bf16_t*)(P->ws + WS_WGU) + (size_t)l * NEXP * 1024 * DM, MPAD, NEXP * 1024, DM};
            pg8::MoeOrder S{(const LAS int*)(F.lds + LDS_MISC + 256)};
            pg8::EpiGateUp E{(bf16_t*)(P->ws + WS_R2)};
            pg8::gemm_phase(F.lds, g, S, E);
        }
        SEAM(base + 8);
        if (IN(base + 9)) { SITE
            build_tile_table(P, F, l);
            pg8::Gemm g{(const bf16_t*)(P->ws + WS_R2), (const bf16_t*)(P->ws + WS_WD) + (size_t)l * NEXP * 1024 * DEXP, MPAD, NEXP * 1024, DEXP};
            pg8::MoeOrder S{(const LAS int*)(F.lds + LDS_MISC + 256)};
            pg8::EpiDown E{(bf16_t*)(P->ws + WS_R1), (const int*)(P->ws + WS_ROWTOK), (const float*)(P->ws + WS_ROWW)};
            pg8::gemm_phase(F.lds, g, S, E);
        }
        SEAM(base + 9);
        if (IN(base + 10)) { SITE if (l == DEPTH - 1) phase_combine<true>(P, F, l, nullptr); else phase_combine<false>(P, F, l, P->out); }
        SEAM(base + 10);
    }

__global__ void __launch_bounds__(NTHREADS, 2) mega(Params p_unused) {
    (void)p_unused;
    extern __shared__ __attribute__((aligned(16))) unsigned char lds_raw[];
    LAS unsigned char* const lds = (LAS unsigned char*)lds_raw;
    int lo, hi; XcdBarrier bar;
    { KParams P = get_params(); lo = (int)P->ph_lo; hi = (int)P->ph_hi;
      if (threadIdx.x < 4) ((LAS unsigned*)(lds + LDS_MISC))[threadIdx.x] = 0u;
      __syncthreads();
      bar.bar = (unsigned*)(P->ws + WS_CTL); bar.x = 0; bar.st = nullptr;
      if (hi - lo > 1) bar = xcd_barrier_post((unsigned*)(P->ws + WS_CTL), (volatile LAS unsigned*)(lds + LDS_MISC)); }

    if (IN(0)) { SITE phase_prologue(P, F); }
    SEAM(0);
    run_layer<0>(lds, lo, hi, bar);
    run_layer<1>(lds, lo, hi, bar);
#undef IN
#undef SEAM
#undef SITE
}

extern "C" void kernel_launch(void* const* d_in, const int* in_sizes, int n_in, void* d_out, int out_size, void* d_ws, size_t ws_size, hipStream_t stream) {
    static int grid = 0;
    if (grid == 0) {
        if (n_in != 26 || in_sizes[0] != MTOK * DM || out_size != MTOK * DM || ws_size < WS_END) {
            fprintf(stderr, "kernel_launch: unexpected shapes (n_in %d, in0 %d, out %d, ws %zu, need %zu); nothing launched\n", n_in, n_in > 0 ? in_sizes[0] : -1, out_size, ws_size, (size_t)WS_END); grid = -1; return; }
        int dev = 0, cus = 0, per_cu = 0;
        if (hipGetDevice(&dev) != hipSuccess || hipDeviceGetAttribute(&cus, hipDeviceAttributeMultiprocessorCount, dev) != hipSuccess) { fprintf(stderr, "kernel_launch: device query failed\n"); grid = -1; return; }
        if (hipFuncSetAttribute((const void*)mega, hipFuncAttributeMaxDynamicSharedMemorySize, LDS_BYTES) != hipSuccess) { fprintf(stderr, "kernel_launch: hipFuncSetAttribute failed\n"); grid = -1; return; }
        if (hipOccupancyMaxActiveBlocksPerMultiprocessor(&per_cu, (const void*)mega, NTHREADS, LDS_BYTES) != hipSuccess || per_cu < 1)
            fprintf(stderr, "kernel_launch: note: occupancy query reports %d workgroups per CU\n", per_cu);
        (void)hipGetLastError();
        grid = cus;
    }
    if (grid < 0) return;
    if (hipMemsetAsync((char*)d_ws + WS_CTL, 0, CTL_ZERO_BYTES, stream) != hipSuccess) { fprintf(stderr, "kernel_launch: memset failed\n"); return; }
    Params p{};
    const float** pf = (const float**)&p;
    for (int i = 0; i < 26; ++i) pf[i] = (const float*)d_in[i];
    p.out = (float*)d_out; p.ws = (unsigned char*)d_ws;
#if MK_PER_PHASE
    for (int ph = 0; ph < N_PHASES; ++ph) { p.ph_lo = ph; p.ph_hi = ph + 1;
        hipLaunchKernelGGL(mega, dim3(grid), dim3(NTHREADS), LDS_BYTES, stream, p);
        const hipError_t le = hipPeekAtLastError();
        if (le != hipSuccess) { fprintf(stderr, "kernel_launch: launch %d failed: %s\n", ph, hipGetErrorName(le)); break; } }
#else
    p.ph_lo = 0; p.ph_hi = N_PHASES;
    hipLaunchKernelGGL(mega, dim3(grid), dim3(NTHREADS), LDS_BYTES, stream, p);
    const hipError_t le = hipPeekAtLastError();
    if (le != hipSuccess) fprintf(stderr, "kernel_launch: launch failed: %s\n", hipGetErrorName(le));
#endif
}
```

```cpp
#include <hip/hip_runtime.h>
#include <stdint.h>
#include <stdio.h>

#ifndef MK_PER_PHASE
#define MK_PER_PHASE 0
#endif

#define LAS __attribute__((address_space(3)))
typedef unsigned short bf16_t;
typedef short bf16x8 __attribute__((ext_vector_type(8)));
typedef float f32x4 __attribute__((ext_vector_type(4)));
typedef float f32x2 __attribute__((ext_vector_type(2)));
typedef unsigned u32x4 __attribute__((ext_vector_type(4)));
typedef unsigned u32x2 __attribute__((ext_vector_type(2)));

constexpr int NB = 4, SEQ = 4096, DM = 1024, MTOK = NB * SEQ, DEPTH = 2;
constexpr int DLRU = 512, DHG = 512, PROJ = 3584, NEXP = 32, DEXP = 512, NGRP = 4, EPG = 8;
constexpr int MPAD = 40960;
constexpr float NORM_EPS = 1e-6f;
constexpr int NWAVES = 8, NTHREADS = 512;

constexpr size_t WS_CTL = 0;
constexpr size_t CTL_ZERO_BYTES = 32768;
constexpr size_t CTL_CNT_OFF = 16384;
constexpr size_t WS_MOD = 65536;
constexpr size_t WS_WIN = WS_MOD + 196608;
constexpr size_t WS_WOUT = WS_WIN + (size_t)DEPTH * PROJ * DM * 2;
constexpr size_t WS_WGU = WS_WOUT + (size_t)DEPTH * DM * DM * 2;
constexpr size_t WS_WD = WS_WGU + (size_t)DEPTH * NEXP * 1024 * 1024 * 2;
constexpr size_t WS_R1 = WS_WD + (size_t)DEPTH * NEXP * 1024 * 512 * 2;
constexpr size_t WS_R2 = WS_R1 + (size_t)MTOK * PROJ * 2;
constexpr size_t WS_R3 = WS_R2 + (size_t)MPAD * 512 * 2;
constexpr size_t WS_XA = WS_R3 + (size_t)MTOK * DM * 2;
constexpr size_t WS_TOKINFO = WS_XA + (size_t)MTOK * DM * 4;
constexpr size_t WS_TOKW = WS_TOKINFO + (size_t)MTOK * 16;
constexpr size_t WS_ROWTOK = WS_TOKW + (size_t)MTOK * 8;
constexpr size_t WS_ROWW = WS_ROWTOK + (size_t)MPAD * 4;
constexpr size_t WS_LRUW = WS_ROWW + (size_t)MPAD * 4;
constexpr size_t WS_SUMA = WS_LRUW + 524288;
constexpr size_t WS_SUMH = WS_SUMA + 1048576;
constexpr size_t WS_RWHI = WS_SUMH + 1048576;
constexpr size_t WS_RWLO = WS_RWHI + (size_t)DEPTH * 64 * DM * 2;
constexpr size_t WS_END = WS_RWLO + (size_t)DEPTH * 64 * DM * 2;

constexpr int LDS_STAGE = 139264;
constexpr int LDS_MISC = LDS_STAGE;
constexpr int LDS_BYTES = LDS_STAGE + 2048;

#define XB_TMO      128
#define XB_XCNT(j)  (256  + 64 * (j))
#define XB_XSUB(j)  (1280 + 64 * (j))
#define XB_XGEN(j)  (2304 + 64 * (j))
#define XB_TOP      3328
#define XB_TOPGEN   3392
#define XCD_BAR_WORDS 3456
#define XB_SPIN_CAP (1u << 22)

__device__ __forceinline__ unsigned xb_ld(unsigned* p)              { return __hip_atomic_load(p, __ATOMIC_RELAXED, __HIP_MEMORY_SCOPE_AGENT); }
__device__ __forceinline__ unsigned xb_add(unsigned* p, unsigned v) { return __hip_atomic_fetch_add(p, v, __ATOMIC_RELAXED, __HIP_MEMORY_SCOPE_AGENT); }
__device__ __forceinline__ unsigned xb_xcc_id() { return (unsigned)__builtin_amdgcn_s_getreg((3 << 11) | 20) & 0xFu; }
#define XB_SPIN(cond, bar) do { unsigned _sp = 0; while (cond) { __builtin_amdgcn_s_sleep(1); \
    if ((++_sp & 255u) == 0u) { if (xb_ld(&(bar)[XB_TMO])) break; if (_sp > XB_SPIN_CAP) { atomicAdd(&(bar)[XB_TMO], 1u); break; } } } } while (0)

struct XcdBarrier { unsigned* bar; unsigned x; volatile LAS unsigned* st; };

__device__ __forceinline__ XcdBarrier xcd_barrier_post(unsigned* bar, volatile LAS unsigned* st) {
    XcdBarrier b; b.bar = bar; b.x = xb_xcc_id(); b.st = st;
    if (threadIdx.x == 0) (void)xb_add(&bar[XB_XCNT(b.x)], 1u);
    return b;
}
__device__ __forceinline__ void xcd_barrier_complete(unsigned* bar, unsigned x, unsigned& nloc, unsigned& nx) {
    const unsigned G = gridDim.x * gridDim.y * gridDim.z;
    unsigned sum, cnt, mine, sp = 0u;
    for (;;) {
        sum = 0u; cnt = 0u; mine = 0u;
#pragma unroll
        for (unsigned j = 0; j < 16; ++j) { const unsigned c = xb_ld(&bar[XB_XCNT(j)]); sum += c; cnt += (c > 0u) ? 1u : 0u; mine = (j == x) ? c : mine; }
        if (sum == G) break;
        __builtin_amdgcn_s_sleep(1);
        if ((++sp & 255u) == 0u) { if (xb_ld(&bar[XB_TMO])) break; if (sp > XB_SPIN_CAP) { atomicAdd(&bar[XB_TMO], 1u); break; } }
    }
    nloc = mine > 0u ? mine : 1u; nx = cnt > 0u ? cnt : 1u;
}
__device__ __forceinline__ void xcd_barrier(const XcdBarrier& b) {
    asm volatile("s_waitcnt vmcnt(0)" ::: "memory");
    __syncthreads();
    if (threadIdx.x == 0) {
        unsigned* bar = b.bar;
        __builtin_amdgcn_s_waitcnt(0);
        unsigned nloc = b.st[0], nx = b.st[1];
        if (nloc == 0u) { xcd_barrier_complete(bar, b.x, nloc, nx); b.st[0] = nloc; b.st[1] = nx; }
        const unsigned old = xb_add(&bar[XB_XSUB(b.x)], 1u);
        const unsigned gen = old / nloc;
        if (old + 1u == (gen + 1u) * nloc) {
            __builtin_amdgcn_fence(__ATOMIC_RELEASE, "agent");
            asm volatile("s_waitcnt vmcnt(0)" ::: "memory");
            const unsigned og = xb_add(&bar[XB_TOP], 1u);
            const unsigned tg = og / nx;
            if (og + 1u == (tg + 1u) * nx) xb_add(&bar[XB_TOPGEN], 1u);
            else XB_SPIN(xb_ld(&bar[XB_TOPGEN]) == tg, bar);
            __builtin_amdgcn_fence(__ATOMIC_ACQUIRE, "agent");
            xb_add(&bar[XB_XGEN(b.x)], 1u);
            asm volatile("s_waitcnt vmcnt(0)" ::: "memory");
        } else {
            XB_SPIN(xb_ld(&bar[XB_XGEN(b.x)]) == gen, bar);
            __builtin_amdgcn_fence(__ATOMIC_ACQUIRE, "agent");
            asm volatile("s_waitcnt vmcnt(0)" ::: "memory");
        }
    }
    __syncthreads();
}

__device__ __forceinline__ float bf2f(bf16_t b) { return __uint_as_float(((unsigned)b) << 16); }
__device__ __forceinline__ bf16_t f2bf(float f) { unsigned u = __float_as_uint(f); u += 0x7FFFu + ((u >> 16) & 1u); return (bf16_t)(u >> 16); }
__device__ __forceinline__ unsigned cvt_pk_bf16(float lo, float hi) { unsigned r; asm volatile("v_cvt_pk_bf16_f32 %0, %1, %2" : "=v"(r) : "v"(lo), "v"(hi)); return r; }
__device__ __forceinline__ float wave_sum(float v) {
#pragma unroll
    for (int m = 32; m >= 1; m >>= 1) v += __shfl_xor(v, m, 64);
    return v;
}
__device__ __forceinline__ float sigmoidf_(float x) { return __builtin_amdgcn_rcpf(1.0f + __expf(-x)); }
__device__ __forceinline__ float siluf_(float x) { return x * sigmoidf_(x); }
__device__ __forceinline__ float gelu_tanh(float x) {
    const float u = 0.7978845608028654f * (x + 0.044715f * x * x * x);
    const float t = 1.0f - 2.0f / (__expf(2.0f * u) + 1.0f);
    return 0.5f * x * (1.0f + t);
}
__device__ __forceinline__ float rdlane(float v, int l) { return __int_as_float(__builtin_amdgcn_readlane(__float_as_int(v), l)); }

namespace pg8 {
constexpr int BM = 256, BK = 64, HALF = 128, HTB = HALF * BK * 2, STAGE_BYTES = 8 * HTB, NXCD = 8, WGM = 8;
__host__ __device__ __forceinline__ int lds_byte(int r, int c) { const int st = (r >> 4) * 2 + (c >> 5), rr = r & 15, cc = c & 31, ob = rr * 64 + cc * 2; return st * 1024 + (ob ^ (((ob >> 9) & 1) << 5)); }
__host__ __device__ __forceinline__ void stage_rc(int b, int& R, int& C) { const int st = b / 1024, sb = b % 1024, swz = sb ^ (((sb >> 9) & 1) << 5); R = (st >> 1) * 16 + swz / 64; C = (st & 1) * 32 + (swz % 64) / 2; }
__host__ __device__ __forceinline__ int perm32(int rho) { const int n = rho >> 4, i = rho & 15; return 8 * (i >> 2) + 4 * n + (i & 3); }

struct Unit { int pm, pn; };
struct Gemm { const bf16_t* A; const bf16_t* Bt; int M, N, K; };

struct StaticOrder {
    int nM, nN, nwg, G, c;
    __host__ __device__ void init(int M, int N, int G_, int c_) { nM = M / BM; nN = N / BM; nwg = nM * nN; G = G_; c = c_; }
    __host__ __device__ bool next(int i, Unit& u) const {
        const long L = (long)i * G + c; if (L >= nwg) return false;
        int wgid = (int)L; { const int q = nwg / NXCD, r = nwg % NXCD, xcd = wgid % NXCD, off = wgid / NXCD; wgid = (xcd < r ? xcd * (q + 1) : r * (q + 1) + (xcd - r) * q) + off; }
        const int nig = WGM * nN, gid = wgid / nig, fm = gid * WGM, gsz = (nM - fm) < WGM ? (nM - fm) : WGM;
        u.pm = fm + ((wgid % nig) % gsz); u.pn = (wgid % nig) / gsz; return true;
    }
    __device__ __forceinline__ void a_ready(const Unit&) const {}
    __device__ __forceinline__ void done(const Unit&) const {}
};

struct MoeOrder {
    const LAS int* ulist;
    __device__ __forceinline__ bool next(int i, Unit& u) const {
        const int pm = __builtin_amdgcn_readfirstlane(ulist[2 * i]); if (pm < 0) return false;
        u.pm = pm; u.pn = __builtin_amdgcn_readfirstlane(ulist[2 * i + 1]); return true;
    }
    __device__ __forceinline__ void a_ready(const Unit&) const {}
    __device__ __forceinline__ void done(const Unit&) const {}
};

struct EpiBf16 {
    static constexpr bool PERM = true;
    bf16_t* O; int ldc;
    __device__ __forceinline__ void operator()(const f32x4 (&acc)[2][2][4][2], const Unit& u, int wr, int wc, int fr, int fq) const {
        const int row0 = u.pm * BM + wr * 64 + fr, col0 = u.pn * BM + wc * 32 + 8 * fq;
#pragma unroll
        for (int ai = 0; ai < 2; ++ai)
#pragma unroll
            for (int m = 0; m < 4; ++m) { bf16_t* rowp = O + (size_t)(row0 + ai * HALF + m * 16) * ldc + col0;
#pragma unroll
                for (int bj = 0; bj < 2; ++bj) { const f32x4 v0 = acc[ai][bj][m][0], v1 = acc[ai][bj][m][1];
                    u32x4 o; o[0] = cvt_pk_bf16(v0[0], v0[1]); o[1] = cvt_pk_bf16(v0[2], v0[3]); o[2] = cvt_pk_bf16(v1[0], v1[1]); o[3] = cvt_pk_bf16(v1[2], v1[3]);
                    *(u32x4*)(rowp + bj * HALF) = o; } }
    }
};
struct EpiResid {
    static constexpr bool PERM = false;
    const float* XI; float* XO; const float* gate;
    __device__ __forceinline__ void operator()(const f32x4 (&acc)[2][2][4][2], const Unit& u, int wr, int wc, int fr, int fq) const {
        const int row0 = u.pm * BM + wr * 64 + fr, col0 = u.pn * BM + wc * 32 + 4 * fq;
        const int b = (u.pm * BM) / SEQ;
        f32x4 gv[2][2];
#pragma unroll
        for (int bj = 0; bj < 2; ++bj)
#pragma unroll
            for (int n = 0; n < 2; ++n) gv[bj][n] = *(const f32x4*)(gate + (size_t)b * 6 * DM + col0 + bj * HALF + n * 16);
#pragma unroll
        for (int ai = 0; ai < 2; ++ai)
#pragma unroll
            for (int m = 0; m < 4; ++m) { const size_t ro = (size_t)(row0 + ai * HALF + m * 16) * DM + col0;
#pragma unroll
                for (int bj = 0; bj < 2; ++bj)
#pragma unroll
                    for (int n = 0; n < 2; ++n) { const f32x4 xi = *(const f32x4*)(XI + ro + bj * HALF + n * 16);
                        *(f32x4*)(XO + ro + bj * HALF + n * 16) = xi + gv[bj][n] * acc[ai][bj][m][n]; } }
    }
};
struct EpiGateUp {
    static constexpr bool PERM = true;
    bf16_t* H;
    __device__ __forceinline__ void operator()(const f32x4 (&acc)[2][2][4][2], const Unit& u, int wr, int wc, int fr, int fq) const {
        const int row0 = u.pm * BM + wr * 64 + fr, col0 = (u.pn & 3) * 128 + wc * 32 + 8 * fq;
#pragma unroll
        for (int ai = 0; ai < 2; ++ai)
#pragma unroll
            for (int m = 0; m < 4; ++m) { bf16_t* rowp = H + (size_t)(row0 + ai * HALF + m * 16) * DEXP + col0;
                float h[8];
#pragma unroll
                for (int n = 0; n < 2; ++n)
#pragma unroll
                    for (int q = 0; q < 4; ++q) { const float g = acc[ai][0][m][n][q], up = acc[ai][1][m][n][q]; h[n * 4 + q] = g / (1.0f + __expf(-g)) * up; }
                u32x4 o; o[0] = cvt_pk_bf16(h[0], h[1]); o[1] = cvt_pk_bf16(h[2], h[3]); o[2] = cvt_pk_bf16(h[4], h[5]); o[3] = cvt_pk_bf16(h[6], h[7]);
                *(u32x4*)rowp = o; }
    }
};
struct EpiDown {
    static constexpr bool PERM = true;
    bf16_t* Y; const int* rowtok; const float* roww;
    __device__ __forceinline__ void operator()(const f32x4 (&acc)[2][2][4][2], const Unit& u, int wr, int wc, int fr, int fq) const {
        const int row0 = u.pm * BM + wr * 64 + fr, col0 = (u.pn & 3) * BM + wc * 32 + 8 * fq;
#pragma unroll
        for (int ai = 0; ai < 2; ++ai)
#pragma unroll
            for (int m = 0; m < 4; ++m) { const int row = row0 + ai * HALF + m * 16; const int rt = rowtok[row];
                if (rt >= 0) { const float w = roww[row]; bf16_t* rowp = Y + (size_t)rt * DM + col0;
#pragma unroll
                    for (int bj = 0; bj < 2; ++bj) { const f32x4 v0 = acc[ai][bj][m][0] * w, v1 = acc[ai][bj][m][1] * w;
                        u32x4 o; o[0] = cvt_pk_bf16(v0[0], v0[1]); o[1] = cvt_pk_bf16(v0[2], v0[3]); o[2] = cvt_pk_bf16(v1[0], v1[1]); o[3] = cvt_pk_bf16(v1[2], v1[3]);
                        *(u32x4*)(rowp + bj * HALF) = o; } } }
    }
};

template <class Epi, class Sched>
__device__ __forceinline__ void gemm_phase(LAS unsigned char* lds, const Gemm g, const Sched& S, const Epi& E) {
    const int tid = threadIdx.x, wid = __builtin_amdgcn_readfirstlane(tid >> 6), lane = tid & 63, wr = wid >> 2, wc = wid & 3, fr = lane & 15, fq = lane >> 4;
    const int K = g.K, nt = K / BK;
    unsigned voffA[2], voffB[2];
#pragma unroll
    for (int i = 0; i < 2; ++i) { int R, C; stage_rc(tid * 16 + i * 8192, R, C); const int Rb = Epi::PERM ? ((R & ~31) + perm32(R & 31)) : R;
        voffA[i] = (unsigned)(R * K + C) * 2u; voffB[i] = (unsigned)(Rb * K + C) * 2u; }
    const size_t kstep = (size_t)(BK * 2);
    const size_t hstep = (size_t)HALF * K * 2;
    const size_t tstep = 2 * hstep;
    const unsigned ldsw = (unsigned)wid * 1024u;
    const int aoff = lds_byte(wr * 64 + fr, fq * 8), boff = lds_byte(wc * 32 + fr, fq * 8);
#define PG8_SA(b, h) (((b) * 2 + (h)) * HTB)
#define PG8_SB(b, h) ((4 + (b) * 2 + (h)) * HTB)
#define PG8_STAGE(bufoff, gbase, voff) do { _Pragma("unroll") for (int _i = 0; _i < 2; ++_i) \
        __builtin_amdgcn_global_load_lds((const unsigned*)((const char*)(gbase) + (voff)[_i]), (LAS unsigned*)(lds + (bufoff) + ldsw + _i * 8192), 16, 0, 0); } while (0)
#define PG8_LDA(dst, b, h) do { _Pragma("unroll") for (int m = 0; m < 4; ++m) _Pragma("unroll") for (int k = 0; k < 2; ++k) dst[m][k] = *(const LAS bf16x8*)(lds + PG8_SA(b, h) + aoff + m * 2048 + k * 1024); } while (0)
#define PG8_LDB(dst, b, h) do { _Pragma("unroll") for (int n = 0; n < 2; ++n) _Pragma("unroll") for (int k = 0; k < 2; ++k) dst[n][k] = *(const LAS bf16x8*)(lds + PG8_SB(b, h) + boff + n * 2048 + k * 1024); } while (0)
#define PG8_MMA(ai, bj, At, Bt) do { __builtin_amdgcn_s_setprio(1); _Pragma("unroll") for (int m = 0; m < 4; ++m) _Pragma("unroll") for (int n = 0; n < 2; ++n) _Pragma("unroll") for (int k = 0; k < 2; ++k) \
        acc[ai][bj][m][n] = __builtin_amdgcn_mfma_f32_16x16x32_bf16(Bt[n][k], At[m][k], acc[ai][bj][m][n], 0, 0, 0); __builtin_amdgcn_s_setprio(0); } while (0)
#define PG8_WAIT_V(n) asm volatile("s_waitcnt vmcnt(" #n ")" ::: "memory")
#define PG8_WAIT_L(n) asm volatile("s_waitcnt lgkmcnt(" #n ")" ::: "memory")
#define PG8_BAR __builtin_amdgcn_s_barrier()
#define PG8_SCHED __builtin_amdgcn_sched_barrier(0)
    Unit cur, nxt; int ui = 0;
    if (!S.next(0, cur)) return;
    f32x4 acc[2][2][4][2];
#pragma unroll
    for (int a = 0; a < 2; ++a)
#pragma unroll
        for (int b = 0; b < 2; ++b)
#pragma unroll
            for (int m = 0; m < 4; ++m)
#pragma unroll
                for (int n = 0; n < 2; ++n) acc[a][b][m][n] = (f32x4){0.f, 0.f, 0.f, 0.f};
    bf16x8 At[4][2], B0[2][2], B1[2][2];
    const char* cA = (const char*)g.A + (size_t)cur.pm * tstep; const char* cB = (const char*)g.Bt + (size_t)cur.pn * tstep;
    S.a_ready(cur);
    PG8_STAGE(PG8_SB(0, 0), cB, voffB); PG8_STAGE(PG8_SA(0, 0), cA, voffA); PG8_STAGE(PG8_SB(0, 1), cB + hstep, voffB); PG8_STAGE(PG8_SA(0, 1), cA + hstep, voffA);
    if (wr == 1) PG8_BAR;
    PG8_WAIT_V(4); PG8_BAR;
    PG8_STAGE(PG8_SB(1, 0), cB + kstep, voffB); PG8_STAGE(PG8_SA(1, 0), cA + kstep, voffA); PG8_STAGE(PG8_SB(1, 1), cB + hstep + kstep, voffB);
    PG8_WAIT_V(6); PG8_BAR;
    for (;;) {
        const bool has_next = S.next(ui + 1, nxt);
        const char* nA = has_next ? (const char*)g.A + (size_t)nxt.pm * tstep : cA; const char* nB = has_next ? (const char*)g.Bt + (size_t)nxt.pn * tstep : cB;
        for (int t = 0; t < nt; t += 2) {
            const bool last = (t == nt - 2);
            const char* a1 = cA + (size_t)(t + 1) * kstep;
            const char* a2 = last ? nA : cA + (size_t)(t + 2) * kstep; const char* b2 = last ? nB : cB + (size_t)(t + 2) * kstep;
            const char* a3 = a2 + kstep; const char* b3 = b2 + kstep;
            if (last && has_next) S.a_ready(nxt);
            PG8_LDB(B0, 0, 0); PG8_SCHED; PG8_LDA(At, 0, 0); PG8_STAGE(PG8_SA(1, 1), a1 + hstep, voffA);
            PG8_WAIT_L(8); PG8_BAR; PG8_WAIT_L(0); PG8_MMA(0, 0, At, B0); PG8_BAR; PG8_SCHED;
            PG8_LDB(B1, 0, 1); PG8_STAGE(PG8_SB(0, 0), b2, voffB);
            PG8_BAR; PG8_WAIT_L(0); PG8_MMA(0, 1, At, B1); PG8_BAR;
            PG8_LDA(At, 0, 1); PG8_STAGE(PG8_SA(0, 0), a2, voffA);
            PG8_BAR; PG8_WAIT_L(0); PG8_MMA(1, 0, At, B0); PG8_BAR; PG8_SCHED;
            PG8_STAGE(PG8_SB(0, 1), b2 + hstep, voffB);
            PG8_WAIT_V(6); PG8_BAR; PG8_MMA(1, 1, At, B1); PG8_BAR;
            PG8_LDB(B0, 1, 0); PG8_SCHED; PG8_LDA(At, 1, 0); PG8_STAGE(PG8_SA(0, 1), a2 + hstep, voffA);
            PG8_WAIT_L(8); PG8_BAR; PG8_WAIT_L(0); PG8_MMA(0, 0, At, B0); PG8_BAR; PG8_SCHED;
            PG8_LDB(B1, 1, 1); PG8_STAGE(PG8_SB(1, 0), b3, voffB);
            PG8_BAR; PG8_WAIT_L(0); PG8_MMA(0, 1, At, B1); PG8_BAR;
            PG8_LDA(At, 1, 1); PG8_STAGE(PG8_SA(1, 0), a3, voffA);
            PG8_BAR; PG8_WAIT_L(0); PG8_MMA(1, 0, At, B0); PG8_BAR; PG8_SCHED;
            PG8_STAGE(PG8_SB(1, 1), b3 + hstep, voffB);
            PG8_WAIT_V(6); PG8_BAR; PG8_MMA(1, 1, At, B1); PG8_BAR;
        }
        E(acc, cur, wr, wc, fr, fq); S.done(cur);
        if (!has_next) break;
#pragma unroll
        for (int a = 0; a < 2; ++a)
#pragma unroll
            for (int b = 0; b < 2; ++b)
#pragma unroll
                for (int m = 0; m < 4; ++m)
#pragma unroll
                    for (int n = 0; n < 2; ++n) acc[a][b][m][n] = (f32x4){0.f, 0.f, 0.f, 0.f};
        cur = nxt; cA = nA; cB = nB; ++ui;
    }
    PG8_WAIT_V(0);
    if (wr == 0) PG8_BAR;
    PG8_BAR;
#undef PG8_SA
#undef PG8_SB
#undef PG8_STAGE
#undef PG8_LDA
#undef PG8_LDB
#undef PG8_MMA
#undef PG8_WAIT_V
#undef PG8_WAIT_L
#undef PG8_BAR
#undef PG8_SCHED
}
}

struct Params {
    const float* x; const float* c; const float* ada_w; const float* ada_b; const float* norm_mix_w; const float* w_in; const float* conv_w; const float* conv_b;
    const float* lru_wa; const float* lru_ba; const float* lru_wx; const float* lru_bx; const float* lru_lambda; const float* norm_lru_w; const float* hgrn_lb;
    const float* norm_hgrn_w; const float* w_out; const float* norm_ffn_w; const float* rg_w; const float* rg_b; const float* re_w; const float* re_b;
    const float* e_gate; const float* e_up; const float* e_down; const float* final_w;
    float* out; unsigned char* ws;
    long long ph_lo, ph_hi;
};

typedef const __attribute__((address_space(4))) Params* KParams;
__device__ __forceinline__ KParams get_params() { KParams q = (KParams)__builtin_amdgcn_kernarg_segment_ptr(); asm volatile("" : "+s"(q)); return q; }

struct Ctx {
    LAS unsigned char* lds; int tid, lane, wave, G, gwave, nwaves;
};

__device__ __forceinline__ void cvt_tile(const Ctx& F, const float* src, int ldn, bf16_t* dst, int ldd) {
    LAS unsigned char* slab = F.lds + F.wave * 8704;
    const int q = F.lane >> 4, n4 = (F.lane & 15) * 4;
    f32x4 v[16];
#pragma unroll
    for (int i = 0; i < 16; ++i) { const int k = 8 * (i >> 1) + 2 * q + (i & 1); v[i] = *(const f32x4*)(src + (size_t)k * ldn + n4); }
#pragma unroll
    for (int p = 0; p < 8; ++p) { const int k0 = 8 * p + 2 * q;
#pragma unroll
        for (int j = 0; j < 4; ++j) *(LAS unsigned*)(slab + (n4 + j) * 136 + k0 * 2) = cvt_pk_bf16(v[2 * p][j], v[2 * p + 1][j]); }
#pragma unroll
    for (int i = 0; i < 16; ++i) { const int n = 4 * i + q, ch = F.lane & 15;
        const u32x2 w = *(const LAS u32x2*)(slab + n * 136 + ch * 8);
        *(u32x2*)(dst + (size_t)n * ldd + ch * 4) = w; }
}

__device__ __forceinline__ void phase_prologue(KParams p, const Ctx& F) {
    bf16_t* WinT = (bf16_t*)(p->ws + WS_WIN); bf16_t* WoutT = (bf16_t*)(p->ws + WS_WOUT); bf16_t* WguT = (bf16_t*)(p->ws + WS_WGU); bf16_t* WdT = (bf16_t*)(p->ws + WS_WD);
    constexpr int T_IN = 16 * 56, T_OUT = 16 * 16, T_E = NEXP * 128, T_L = T_IN + T_OUT + 3 * T_E;
    for (int task = F.gwave; task < DEPTH * T_L; task += F.nwaves) {
        const int l = task / T_L; int r = task % T_L;
        if (r < T_IN) { const int kt = r / 56, nt = r % 56;
            cvt_tile(F, p->w_in + (size_t)l * DM * PROJ + (size_t)kt * 64 * PROJ + nt * 64, PROJ, WinT + ((size_t)l * PROJ + nt * 64) * DM + kt * 64, DM);
        } else if (r < T_IN + T_OUT) { r -= T_IN; const int kt = r / 16, nt = r % 16;
            cvt_tile(F, p->w_out + (size_t)l * DM * DM + (size_t)kt * 64 * DM + nt * 64, DM, WoutT + ((size_t)l * DM + nt * 64) * DM + kt * 64, DM);
        } else if (r < T_IN + T_OUT + 2 * T_E) { r -= T_IN + T_OUT; const int up = r / T_E; r %= T_E; const int e = r / 128, rr = r % 128, kt = rr / 8, nt = rr % 8, n0 = nt * 64;
            const float* src = (up ? p->e_up : p->e_gate) + ((size_t)(l * NEXP + e) * DM + kt * 64) * DEXP + n0;
            const size_t drow = (size_t)(l * NEXP + e) * 1024 + 256 * (n0 >> 7) + 128 * up + (n0 & 127);
            cvt_tile(F, src, DEXP, WguT + drow * DM + kt * 64, DM);
        } else { r -= T_IN + T_OUT + 2 * T_E; const int e = r / 128, rr = r % 128, kt = rr / 16, nt = rr % 16;
            const float* src = p->e_down + ((size_t)(l * NEXP + e) * DEXP + kt * 64) * DM + nt * 64;
            cvt_tile(F, src, DM, WdT + ((size_t)(l * NEXP + e) * 1024 + nt * 64) * DEXP + kt * 64, DEXP);
        }
    }
    {
        bf16_t* wf = (bf16_t*)(p->ws + WS_LRUW);
        for (int it = blockIdx.x * NTHREADS + F.tid; it < 32768; it += F.G * NTHREADS) {
            const int ln = it & 63, ks = (it >> 6) & 3, ct = (it >> 8) & 1, h = (it >> 9) & 7, m = (it >> 12) & 1, ld = it >> 13;
            const float* src = (m ? p->lru_wx : p->lru_wa) + ((size_t)ld * 8 + h) * 4096 + (size_t)(ks * 16 + 8 * (ln >> 5)) * 64 + ct * 32 + (ln & 31);
            u32x4 o; o[0] = cvt_pk_bf16(src[0], src[64]); o[1] = cvt_pk_bf16(src[128], src[192]); o[2] = cvt_pk_bf16(src[256], src[320]); o[3] = cvt_pk_bf16(src[384], src[448]);
            *(u32x4*)(wf + (size_t)it * 8) = o; }
    }
    {
        bf16_t* rwh = (bf16_t*)(p->ws + WS_RWHI); bf16_t* rwl = (bf16_t*)(p->ws + WS_RWLO);
        for (int it = blockIdx.x * NTHREADS + F.tid; it < DEPTH * 64 * DM; it += F.G * NTHREADS) {
            const int k = it & (DM - 1), n = (it >> 10) & 63, l = it >> 16;
            const float w = n < NEXP ? p->re_w[((size_t)l * DM + k) * NEXP + n] : (n < NEXP + NGRP ? p->rg_w[((size_t)l * DM + k) * NGRP + (n - NEXP)] : 0.f);
            const bf16_t hi = f2bf(w); rwh[it] = hi; rwl[it] = f2bf(w - bf2f(hi)); }
    }
    __syncthreads();
    LAS float* sc = (LAS float*)F.lds;
    LAS float* red = (LAS float*)(F.lds + 16384);
    for (int i = F.tid; i < NB * DM; i += NTHREADS) sc[i] = siluf_(p->c[i]);
    __syncthreads();
    float* mod = (float*)(p->ws + WS_MOD);
    for (int t = blockIdx.x; t < DEPTH * 96; t += F.G) {
        const int l = t / 96, n0 = (t % 96) * 64;
        const float* w = p->ada_w + (size_t)l * DM * 6 * DM + n0 + F.lane;
        float a0 = 0.f, a1 = 0.f, a2 = 0.f, a3 = 0.f;
        const int k0 = F.wave * 128;
#pragma unroll 8
        for (int k = k0; k < k0 + 128; ++k) { const float wv = w[(size_t)k * 6 * DM]; a0 += sc[k] * wv; a1 += sc[DM + k] * wv; a2 += sc[2 * DM + k] * wv; a3 += sc[3 * DM + k] * wv; }
        red[(F.wave * 4 + 0) * 64 + F.lane] = a0; red[(F.wave * 4 + 1) * 64 + F.lane] = a1; red[(F.wave * 4 + 2) * 64 + F.lane] = a2; red[(F.wave * 4 + 3) * 64 + F.lane] = a3;
        __syncthreads();
        if (F.tid < 256) { const int b = F.tid >> 6, ln = F.tid & 63; float s = p->ada_b[l * 6 * DM + n0 + ln];
#pragma unroll
            for (int w8 = 0; w8 < 8; ++w8) s += red[(w8 * 4 + b) * 64 + ln];
            mod[((size_t)l * NB + b) * 6 * DM + n0 + ln] = s; }
        __syncthreads();
    }
}

__device__ __forceinline__ void phase_norm1(KParams p, const Ctx& F, int l, const float* xin) {
    const float* mod = (const float*)(p->ws + WS_MOD) + (size_t)l * NB * 6 * DM;
    bf16_t* h = (bf16_t*)(p->ws + WS_R2);
    const float* nw = p->norm_mix_w + l * DM;
    for (int row = F.gwave; row < MTOK; row += F.nwaves) {
        const int b = row >> 12; const float* xr = xin + (size_t)row * DM;
        f32x4 v[4]; float ss = 0.f;
#pragma unroll
        for (int i = 0; i < 4; ++i) { v[i] = *(const f32x4*)(xr + F.lane * 4 + 256 * i); ss += v[i][0] * v[i][0] + v[i][1] * v[i][1] + v[i][2] * v[i][2] + v[i][3] * v[i][3]; }
        ss = wave_sum(ss); const float rstd = rsqrtf(ss * (1.0f / DM) + NORM_EPS);
#pragma unroll
        for (int i = 0; i < 4; ++i) { const int col = F.lane * 4 + 256 * i;
            const f32x4 w4 = *(const f32x4*)(nw + col), sh = *(const f32x4*)(mod + (size_t)b * 6 * DM + col), s1 = *(const f32x4*)(mod + (size_t)b * 6 * DM + DM + col);
            f32x4 o = v[i] * rstd * w4 * (s1 + 1.0f) + sh;
            u32x2 pk; pk[0] = cvt_pk_bf16(o[0], o[1]); pk[1] = cvt_pk_bf16(o[2], o[3]);
            *(u32x2*)(h + (size_t)row * DM + col) = pk; }
    }
}

__device__ __forceinline__ void phase_conv(KParams p, const Ctx& F, int l) {
    const bf16_t* proj = (const bf16_t*)(p->ws + WS_R1); float* xc = (float*)(p->ws + WS_XA);
    const float* cw = p->conv_w + l * 4 * DLRU; const float* cb = p->conv_b + l * DLRU;
    for (int it = blockIdx.x * NTHREADS + F.tid; it < MTOK * (DLRU / 4); it += F.G * NTHREADS) {
        const int row = it >> 7, c4 = (it & 127) * 4, t = row & (SEQ - 1);
        f32x4 acc = *(const f32x4*)(cb + c4);
#pragma unroll
        for (int k = 0; k < 4; ++k) { const int tt = t + k - 2;
            if (tt >= 0 && tt < SEQ) { const u32x2 pv = *(const u32x2*)(proj + (size_t)(row + k - 2) * PROJ + c4); const f32x4 w4 = *(const f32x4*)(cw + k * DLRU + c4);
                acc[0] += w4[0] * __uint_as_float(pv[0] << 16); acc[1] += w4[1] * __uint_as_float(pv[0] & 0xFFFF0000u);
                acc[2] += w4[2] * __uint_as_float(pv[1] << 16); acc[3] += w4[3] * __uint_as_float(pv[1] & 0xFFFF0000u); } }
        *(f32x4*)(xc + (size_t)row * DLRU + c4) = acc;
    }
}

__device__ __forceinline__ void lru_seq(KParams p, const Ctx& F, int l, int b, int h) {
    const bf16_t* proj = (const bf16_t*)(p->ws + WS_R1); const float* xc = (const float*)(p->ws + WS_XA); float* tmpz = (float*)(p->ws + WS_XA) + (size_t)MTOK * DLRU;
    const int c = h * 64 + F.lane;
    for (int d = 0; d < 2; ++d) {
        float wa_r[64], wx_r[64];
        const float* wa = p->lru_wa + ((size_t)(l * 2 + d) * 8 + h) * 4096 + F.lane; const float* wx = p->lru_wx + ((size_t)(l * 2 + d) * 8 + h) * 4096 + F.lane;
#pragma unroll
        for (int i = 0; i < 64; ++i) { wa_r[i] = wa[i * 64]; wx_r[i] = wx[i * 64]; }
        const float ba = p->lru_ba[(l * 2 + d) * DLRU + c], bx = p->lru_bx[(l * 2 + d) * DLRU + c], lam = p->lru_lambda[(l * 2 + d) * DLRU + c];
        const float cc = -8.0f * log1pf(expf(-lam));
        float hst = 0.f;
        for (int step = 0; step < SEQ; ++step) {
            const int t = d == 0 ? step : SEQ - 1 - step; const size_t row = (size_t)b * SEQ + t;
            const float xv = xc[row * DLRU + c];
            float ra = ba, rx = bx;
#pragma unroll
            for (int i = 0; i < 64; ++i) { const float xi = rdlane(xv, i); ra += xi * wa_r[i]; rx += xi * wx_r[i]; }
            const float r = sigmoidf_(ra), ig = sigmoidf_(rx), la = cc * r, a = expf(la);
            const float u = sqrtf(fmaxf(-expm1f(2.0f * la), 0.f)) * (ig * xv);
            hst = a * hst + u;
            if (d == 0) tmpz[row * DLRU + c] = hst;
            else { const float yv = bf2f(proj[row * PROJ + DLRU + c]); tmpz[row * DLRU + c] = (tmpz[row * DLRU + c] + hst) * gelu_tanh(yv); }
        }
    }
}

__device__ __forceinline__ float hgrn_lb(KParams p, int l, int ch) {
    if (l == 0) return 0.f;
    const float a = p->hgrn_lb[ch], b = p->hgrn_lb[DHG + ch]; const float m = fmaxf(a, b); const float ea = expf(a - m), eb = expf(b - m);
    return eb / (ea + eb);
}

__device__ __forceinline__ void hgrn_seq(KParams p, const Ctx& F, int l, int b, int h) {
    const bf16_t* proj = (const bf16_t*)(p->ws + WS_R1); float* tmpo = (float*)(p->ws + WS_R2); bf16_t* merged = (bf16_t*)(p->ws + WS_R3);
    const int ch = h * 64 + F.lane;
    const float lbv = hgrn_lb(p, l, ch), nw = p->norm_hgrn_w[l * DHG + ch];
    for (int d = 0; d < 2; ++d) {
        float S[64];
#pragma unroll
        for (int i = 0; i < 64; ++i) S[i] = 0.f;
        const int fcol = (d == 0 ? 1536 : 2048) + ch;
        for (int step = 0; step < SEQ; ++step) {
            const int t = d == 0 ? step : SEQ - 1 - step; const size_t row = (size_t)b * SEQ + t; const bf16_t* pr = proj + row * PROJ;
            const float fl = bf2f(pr[fcol]), qv = bf2f(pr[1024 + ch]), vv = bf2f(pr[2560 + ch]);
            const float f = lbv + (1.0f - lbv) * sigmoidf_(fl), k = 1.0f - f;
            float o = 0.f;
#pragma unroll
            for (int i = 0; i < 64; ++i) { const float fd = rdlane(f, i), kd = rdlane(k, i), qd = rdlane(qv, i); S[i] = fd * S[i] + kd * vv; o += qd * S[i]; }
            if (d == 0) tmpo[row * DHG + ch] = o;
            else { const float ot = tmpo[row * DHG + ch] + o; const float ms = wave_sum(ot * ot) * (1.0f / 64.0f);
                const float gv = bf2f(pr[3072 + ch]); const float y = ot * rsqrtf(ms + NORM_EPS) * nw * siluf_(gv);
                merged[row * DM + DLRU + ch] = f2bf(y); }
        }
    }
}

__device__ __forceinline__ void phase_mixer_seq(KParams p, const Ctx& F, int l) {
#ifdef USE_LRU_SEQ
    if (F.wave == 0 && (int)blockIdx.x < 64) {
        const int id = blockIdx.x;
        if (id < 32) lru_seq(p, F, l, id >> 3, id & 7); else hgrn_seq(p, F, l, (id - 32) >> 3, (id - 32) & 7);
    }
#else
    if (F.wave == 0 && (int)blockIdx.x < 32) hgrn_seq(p, F, l, (int)blockIdx.x >> 3, (int)blockIdx.x & 7);
#endif
}

__device__ __forceinline__ void phase_lru_norm(KParams p, const Ctx& F, int l) {
    const float* tmpz = (const float*)(p->ws + WS_XA) + (size_t)MTOK * DLRU; bf16_t* merged = (bf16_t*)(p->ws + WS_R3); const float* nw = p->norm_lru_w + l * DLRU;
    for (int row = F.gwave; row < MTOK; row += F.nwaves) {
        f32x4 v[2]; float ss = 0.f;
#pragma unroll
        for (int i = 0; i < 2; ++i) { v[i] = *(const f32x4*)(tmpz + (size_t)row * DLRU + F.lane * 4 + 256 * i); ss += v[i][0] * v[i][0] + v[i][1] * v[i][1] + v[i][2] * v[i][2] + v[i][3] * v[i][3]; }
        ss = wave_sum(ss); const float rstd = rsqrtf(ss * (1.0f / DLRU) + NORM_EPS);
#pragma unroll
        for (int i = 0; i < 2; ++i) { const int col = F.lane * 4 + 256 * i; const f32x4 w4 = *(const f32x4*)(nw + col); const f32x4 o = v[i] * rstd * w4;
            u32x2 pk; pk[0] = cvt_pk_bf16(o[0], o[1]); pk[1] = cvt_pk_bf16(o[2], o[3]); *(u32x2*)(merged + (size_t)row * DM + col) = pk; }
    }
}

typedef float f32x16 __attribute__((ext_vector_type(16)));
#define MFMA32(a, b, c) __builtin_amdgcn_mfma_f32_32x32x16_bf16((a), (b), (c), 0, 0, 0)
constexpr int XCP = 1040;
template <bool PASS2>
__device__ __forceinline__ void phase_lru(KParams p, const Ctx& F, int l) {
    const bf16_t* proj = (const bf16_t*)(p->ws + WS_R1);
    float* sumA = (float*)(p->ws + WS_SUMA); float* sumH = (float*)(p->ws + WS_SUMH);
    const bf16x8* wf = (const bf16x8*)(p->ws + WS_LRUW);
    LAS unsigned char* xcb = F.lds; LAS unsigned char* zb = F.lds + 64 * XCP; LAS float* cin = (LAS float*)(F.lds + 128 * XCP);
    const float* cw = p->conv_w + l * 4 * DLRU; const float* cb = p->conv_b + l * DLRU;
    for (int task = blockIdx.x; task < NB * 64; task += F.G) {
        const int b = task >> 6, j = task & 63; const int row0 = b * SEQ + j * 64;
        for (int it = F.tid; it < 64 * 64; it += NTHREADS) {
            const int t = it >> 6, c8 = (it & 63) * 8, tg = j * 64 + t;
            f32x4 a0 = *(const f32x4*)(cb + c8), a1 = *(const f32x4*)(cb + c8 + 4);
#pragma unroll
            for (int k = 0; k < 4; ++k) { const int tt = tg + k - 2;
                if (tt >= 0 && tt < SEQ) { const u32x4 pv = *(const u32x4*)(proj + (size_t)(b * SEQ + tt) * PROJ + c8);
                    const f32x4 w0 = *(const f32x4*)(cw + k * DLRU + c8), w1 = *(const f32x4*)(cw + k * DLRU + c8 + 4);
                    a0[0] += w0[0] * __uint_as_float(pv[0] << 16); a0[1] += w0[1] * __uint_as_float(pv[0] & 0xFFFF0000u);
                    a0[2] += w0[2] * __uint_as_float(pv[1] << 16); a0[3] += w0[3] * __uint_as_float(pv[1] & 0xFFFF0000u);
                    a1[0] += w1[0] * __uint_as_float(pv[2] << 16); a1[1] += w1[1] * __uint_as_float(pv[2] & 0xFFFF0000u);
                    a1[2] += w1[2] * __uint_as_float(pv[3] << 16); a1[3] += w1[3] * __uint_as_float(pv[3] & 0xFFFF0000u); } }
            u32x4 o; o[0] = cvt_pk_bf16(a0[0], a0[1]); o[1] = cvt_pk_bf16(a0[2], a0[3]); o[2] = cvt_pk_bf16(a1[0], a1[1]); o[3] = cvt_pk_bf16(a1[2], a1[3]);
            *(LAS u32x4*)(xcb + t * XCP + c8 * 2) = o;
            if (PASS2) *(LAS u32x4*)(zb + t * XCP + c8 * 2) = *(const u32x4*)(proj + (size_t)(row0 + t) * PROJ + DLRU + c8);
        }
        if (PASS2) {
            const int c = F.tid; float s = 0.f;
            for (int k = 0; k < j; ++k) { const size_t idx = ((size_t)(0 * NB + b) * 64 + k) * DLRU + c; s = sumA[idx] * s + sumH[idx]; }
            cin[c] = s; s = 0.f;
            for (int k = 63; k > j; --k) { const size_t idx = ((size_t)(1 * NB + b) * 64 + k) * DLRU + c; s = sumA[idx] * s + sumH[idx]; }
            cin[DLRU + c] = s;
        }
        __syncthreads();
        {
            const int h = F.wave, r = F.lane & 31, hh = F.lane >> 5;
            const LAS unsigned char* abase = xcb + (32 * ((r >> 2) & 1) + 4 * (r >> 3) + (r & 3)) * XCP + (h * 64 + 8 * hh) * 2;
#pragma unroll 1
            for (int ct = 0; ct < 2; ++ct) {
                const int c = h * 64 + ct * 32 + r;
                float hf[32];
#pragma unroll
                for (int d = 0; d < 2; ++d) {
                    const bf16x8* wba = wf + ((((size_t)(l * 2 + d) * 2 + 0) * 8 + h) * 2 + ct) * 4 * 64 + F.lane;
                    const bf16x8* wbx = wf + ((((size_t)(l * 2 + d) * 2 + 1) * 8 + h) * 2 + ct) * 4 * 64 + F.lane;
                    bf16x8 Ba[4], Bx[4];
#pragma unroll
                    for (int ks = 0; ks < 4; ++ks) { Ba[ks] = wba[ks * 64]; Bx[ks] = wbx[ks * 64]; }
                    const float ba = p->lru_ba[(l * 2 + d) * DLRU + c], bx = p->lru_bx[(l * 2 + d) * DLRU + c];
                    const float cc = -8.0f * log1pf(__expf(-p->lru_lambda[(l * 2 + d) * DLRU + c]));
                    float av[32], uv[32];
#pragma unroll
                    for (int rt = 0; rt < 2; ++rt) {
                        f32x16 za, zx;
#pragma unroll
                        for (int e = 0; e < 16; ++e) { za[e] = 0.f; zx[e] = 0.f; }
#pragma unroll
                        for (int ks = 0; ks < 4; ++ks) { const bf16x8 Af = *(const LAS bf16x8*)(abase + 16 * rt * XCP + ks * 32);
                            za = MFMA32(Af, Ba[ks], za); zx = MFMA32(Af, Bx[ks], zx); }
#pragma unroll
                        for (int reg = 0; reg < 16; ++reg) { const int i = 16 * rt + reg;
                            const float xcv = bf2f(*(const LAS bf16_t*)(xcb + (32 * hh + i) * XCP + c * 2));
                            const float rg = sigmoidf_(za[reg] + ba), ig = sigmoidf_(zx[reg] + bx), la = cc * rg;
                            av[i] = __expf(la); uv[i] = sqrtf(fmaxf(1.0f - __expf(2.0f * la), 0.f)) * (ig * xcv); }
                    }
                    if (d == 0) {
#pragma unroll
                        for (int i = 1; i < 32; ++i) { uv[i] = av[i] * uv[i - 1] + uv[i]; av[i] = av[i] * av[i - 1]; }
                    } else {
#pragma unroll
                        for (int i = 30; i >= 0; --i) { uv[i] = av[i] * uv[i + 1] + uv[i]; av[i] = av[i] * av[i + 1]; }
                    }
                    const float myP = (d == 0) ? av[31] : av[0], myH = (d == 0) ? uv[31] : uv[0];
                    const float oP = __shfl_xor(myP, 32, 64), oH = __shfl_xor(myH, 32, 64);
                    if (!PASS2) {
                        if (hh == 0) { const size_t idx = ((size_t)(d * NB + b) * 64 + j) * DLRU + c;
                            sumA[idx] = myP * oP;
                            sumH[idx] = (d == 0) ? (oH + oP * myH) : (myH + myP * oH); }
                    } else {
                        const float cinv = cin[d * DLRU + c];
                        const bool first = (d == 0) ? (hh == 0) : (hh == 1);
                        const float cy = first ? cinv : (oH + oP * cinv);
                        if (d == 0) {
#pragma unroll
                            for (int i = 0; i < 32; ++i) hf[i] = uv[i] + av[i] * cy;
                        } else {
#pragma unroll
                            for (int i = 0; i < 32; ++i) { const float hs = hf[i] + uv[i] + av[i] * cy;
                                LAS bf16_t* zp = (LAS bf16_t*)(zb + (32 * hh + i) * XCP + c * 2);
                                *zp = f2bf(hs * gelu_tanh(bf2f(*zp))); }
                        }
                    }
                }
            }
        }
        if (PASS2) {
            __syncthreads();
            bf16_t* merged = (bf16_t*)(p->ws + WS_R3); const float* nw = p->norm_lru_w + l * DLRU;
            const f32x4 w0 = *(const f32x4*)(nw + F.lane * 8), w1 = *(const f32x4*)(nw + F.lane * 8 + 4);
#pragma unroll
            for (int q = 0; q < 8; ++q) { const int t = F.wave * 8 + q;
                const u32x4 zv = *(const LAS u32x4*)(zb + t * XCP + F.lane * 16);
                float z[8];
#pragma unroll
                for (int e = 0; e < 4; ++e) { z[2 * e] = __uint_as_float(zv[e] << 16); z[2 * e + 1] = __uint_as_float(zv[e] & 0xFFFF0000u); }
                float ss = 0.f;
#pragma unroll
                for (int e = 0; e < 8; ++e) ss += z[e] * z[e];
                ss = wave_sum(ss); const float rstd = rsqrtf(ss * (1.0f / DLRU) + NORM_EPS);
                u32x4 o; o[0] = cvt_pk_bf16(z[0] * rstd * w0[0], z[1] * rstd * w0[1]); o[1] = cvt_pk_bf16(z[2] * rstd * w0[2], z[3] * rstd * w0[3]);
                o[2] = cvt_pk_bf16(z[4] * rstd * w1[0], z[5] * rstd * w1[1]); o[3] = cvt_pk_bf16(z[6] * rstd * w1[2], z[7] * rstd * w1[3]);
                *(u32x4*)(merged + (size_t)(row0 + t) * DM + F.lane * 8) = o; }
        }
        __syncthreads();
    }
}

typedef __bf16 bf16v8 __attribute__((ext_vector_type(8)));
typedef float f32x8 __attribute__((ext_vector_type(8)));
__device__ __forceinline__ bf16x8 pk8(float a0, float a1, float a2, float a3, float a4, float a5, float a6, float a7) {
    const f32x8 w = {a0, a1, a2, a3, a4, a5, a6, a7}; return __builtin_bit_cast(bf16x8, __builtin_convertvector(w, bf16v8)); }
#define PACK_STEP(x, s) pk8((x)[8 * (s)], (x)[8 * (s) + 1], (x)[8 * (s) + 2], (x)[8 * (s) + 3], (x)[8 * (s) + 4], (x)[8 * (s) + 5], (x)[8 * (s) + 6], (x)[8 * (s) + 7])
__device__ __forceinline__ int crow(int reg, int hh) { return (reg & 3) + 8 * (reg >> 2) + 4 * hh; }
template <int KIND> __device__ __forceinline__ bf16x8 mk_const(int ks, int hh, int r) {
    bf16x8 v;
#pragma unroll
    for (int j = 0; j < 8; ++j) { const int kn = 16 * ks + 8 * hh + j, kp = 16 * ks + 8 * (j >> 2) + 4 * hh + (j & 3);
        const bool on = KIND == 0 ? (kn <= r) : KIND == 1 ? (kn > r) : KIND == 2 ? (kn == r) : (kp == r);
        v[j] = on ? (short)0x3F80 : (short)0; }
    return v;
}
constexpr int HG_TASKS = NB * 8 * 2 * 32;
constexpr int HG_WLDS = 12288;
template <bool PASS2>
__device__ __forceinline__ void phase_hgrn(KParams p, const Ctx& F, int l) {
    const bf16_t* proj = (const bf16_t*)(p->ws + WS_R1);
    float* Usum = (float*)(p->ws + WS_R2); float* Dsum = Usum + (size_t)HG_TASKS * 4096;
    float* osc = (float*)(p->ws + WS_XA);
    int lz = F.lane; asm volatile("" : "+v"(lz));
    const int r = lz & 31, hh = lz >> 5;
    LAS unsigned char* wl = F.lds + F.wave * HG_WLDS;
    const LAS unsigned char* rdA = wl + (8 * hh) * 128 + r * 2;
    const LAS unsigned char* rdV = wl + 8192 + (4 * hh) * 128 + r * 2;
    for (int wg = blockIdx.x; wg < 256; wg += F.G) {
        const int b = wg >> 6, h = (wg >> 3) & 7, g = wg & 7;
        const int dir = F.wave & 1, tr = g * 4 + (F.wave >> 1);
        const int task = ((b * 8 + h) * 2 + dir) * 32 + tr;
        const int r0 = b * SEQ + tr * 128;
        const int fcol = (dir == 0 ? 1536 : 2048) + h * 64;
        const float lb0 = hgrn_lb(p, l, h * 64 + r), lb1 = hgrn_lb(p, l, h * 64 + 32 + r);
        f32x16 S[2][2];
#pragma unroll
        for (int a = 0; a < 2; ++a) {
#pragma unroll
            for (int e = 0; e < 16; ++e) { S[a][0][e] = 0.f; S[a][1][e] = 0.f; } }
        if (PASS2) {
#pragma unroll
            for (int a = 0; a < 2; ++a)
#pragma unroll
                for (int c = 0; c < 2; ++c)
#pragma unroll
                    for (int e = 0; e < 16; ++e) S[a][c][e] = *(const float*)((const char*)Usum + ((unsigned)(task * 4096 + lz) * 4u + (unsigned)(((a * 2 + c) * 16 + e) * 256)));
        }
#pragma unroll 1
        for (int ci = 0; ci < 4; ++ci) {
            const int rbase = dir == 0 ? r0 + 32 * ci : r0 + 127 - 32 * ci, sg = dir == 0 ? 1 : -1;
            {
                int lq = lz; asm volatile("" : "+v"(lq));
                const int lrow = lq >> 3, lcol = (lq & 7) * 8;
#pragma unroll
                for (int i = 0; i < 4; ++i) { const int tau = 8 * i + lrow; const char* pr = (const char*)proj + (unsigned)(((rbase + sg * tau) * PROJ + h * 64 + lcol) * 2);
                    const u32x4 vf = *(const u32x4*)(pr + (fcol - h * 64) * 2), vv = *(const u32x4*)(pr + 2560 * 2);
                    *(LAS u32x4*)(wl + tau * 128 + lcol * 2) = vf; *(LAS u32x4*)(wl + 8192 + tau * 128 + lcol * 2) = vv;
                    if (PASS2) { const u32x4 vq = *(const u32x4*)(pr + 1024 * 2); *(LAS u32x4*)(wl + 4096 + tau * 128 + lcol * 2) = vq; } }
            }
            __builtin_amdgcn_sched_barrier(0);
#define LOAD_VP(c, ks, dst) do { _Pragma("unroll") for (int j = 0; j < 8; ++j) (dst)[j] = (short)*(const LAS bf16_t*)(rdV + (16 * (ks) + 8 * (j >> 2) + (j & 3)) * 128 + 64 * (c)); } while (0)
            f32x16 O[2], sc;
            if (PASS2) {
#pragma unroll
                for (int e = 0; e < 16; ++e) { O[0][e] = 0.f; O[1][e] = 0.f; sc[e] = 0.f; } }
#pragma unroll
            for (int a = 0; a < 2; ++a) {
                const float lbv = a == 0 ? lb0 : lb1;
                bf16x8 Ahi[2], Alo[2];
                f32x16 kT, qT;
#pragma unroll
                for (int e = 0; e < 16; ++e) { kT[e] = 0.f; qT[e] = 0.f; }
#pragma unroll
                for (int ks = 0; ks < 2; ++ks) {
                    float lf[8], kk[8];
#pragma unroll
                    for (int j = 0; j < 8; ++j) { const float fl = bf2f(*(const LAS bf16_t*)(rdA + (16 * ks + j) * 128 + 64 * a));
                        const float f = lbv + (1.0f - lbv) * sigmoidf_(fl);
                        lf[j] = fmaxf(__logf(f), -80.0f); kk[j] = 1.0f - f; }
                    Ahi[ks] = pk8(lf[0], lf[1], lf[2], lf[3], lf[4], lf[5], lf[6], lf[7]);
                    float lo[8];
#pragma unroll
                    for (int j = 0; j < 8; ++j) lo[j] = lf[j] - bf2f((bf16_t)Ahi[ks][j]);
                    Alo[ks] = pk8(lo[0], lo[1], lo[2], lo[3], lo[4], lo[5], lo[6], lo[7]);
                    const bf16x8 Ak = pk8(kk[0], kk[1], kk[2], kk[3], kk[4], kk[5], kk[6], kk[7]);
                    const bf16x8 Id = mk_const<2>(ks, hh, r);
                    kT = MFMA32(Ak, Id, kT);
                    if (PASS2) { bf16x8 Aq;
#pragma unroll
                        for (int j = 0; j < 8; ++j) Aq[j] = (short)*(const LAS bf16_t*)(rdA + 4096 + (16 * ks + j) * 128 + 64 * a);
                        qT = MFMA32(Aq, Id, qT); }
                }
                __builtin_amdgcn_sched_barrier(0);
                if (PASS2) {
                    f32x16 bT;
#pragma unroll
                    for (int e = 0; e < 16; ++e) bT[e] = 0.f;
#pragma unroll
                    for (int ks = 0; ks < 2; ++ks) { const bf16x8 Mle = mk_const<0>(ks, hh, r); bT = MFMA32(Ahi[ks], Mle, bT); bT = MFMA32(Alo[ks], Mle, bT); }
#pragma unroll
                    for (int e = 0; e < 16; ++e) bT[e] = qT[e] * __expf(bT[e]);
#pragma unroll
                    for (int s2 = 0; s2 < 2; ++s2) { const bf16x8 Qtp = PACK_STEP(bT, s2);
#pragma unroll
                        for (int c = 0; c < 2; ++c) O[c] = MFMA32(Qtp, PACK_STEP(S[a][c], s2), O[c]); }
                    __builtin_amdgcn_sched_barrier(0);
                }
                bf16x8 Kh0, Kh1;
                {
                    f32x16 RT;
#pragma unroll
                    for (int e = 0; e < 16; ++e) RT[e] = 0.f;
#pragma unroll
                    for (int ks = 0; ks < 2; ++ks) { const bf16x8 Mgt = mk_const<1>(ks, hh, r); RT = MFMA32(Ahi[ks], Mgt, RT); RT = MFMA32(Alo[ks], Mgt, RT); }
#pragma unroll
                    for (int e = 0; e < 16; ++e) { kT[e] *= __expf(RT[e]); if (PASS2) qT[e] *= __expf(fminf(-RT[e], 80.0f)); }
                    Kh0 = PACK_STEP(kT, 0); Kh1 = PACK_STEP(kT, 1);
                    if (PASS2) { sc = MFMA32(Kh0, PACK_STEP(qT, 0), sc); sc = MFMA32(Kh1, PACK_STEP(qT, 1), sc); }
                    __builtin_amdgcn_sched_barrier(0);
                }
                {
                    f32x16 CT;
#pragma unroll
                    for (int e = 0; e < 16; ++e) CT[e] = 0.f;
#pragma unroll
                    for (int ks = 0; ks < 2; ++ks) { bf16x8 One;
#pragma unroll
                        for (int j = 0; j < 8; ++j) One[j] = (short)0x3F80;
                        CT = MFMA32(Ahi[ks], One, CT); CT = MFMA32(Alo[ks], One, CT); }
#pragma unroll
                    for (int e = 0; e < 16; ++e) { const float dd = __expf(CT[e]); S[a][0][e] *= dd; S[a][1][e] *= dd; if (!PASS2) CT[e] = dd; }
                    if (!PASS2 && r == 0) {
#pragma unroll
                        for (int e = 0; e < 16; ++e) Dsum[((size_t)task * 4 + ci) * 64 + 32 * a + crow(e, hh)] = CT[e]; }
                    __builtin_amdgcn_sched_barrier(0);
                }
                {
                    f32x16 Ks;
#pragma unroll
                    for (int e = 0; e < 16; ++e) Ks[e] = 0.f;
                    Ks = MFMA32(Kh0, mk_const<3>(0, hh, r), Ks); Ks = MFMA32(Kh1, mk_const<3>(1, hh, r), Ks);
#pragma unroll
                    for (int ks = 0; ks < 2; ++ks) { const bf16x8 Ksp = PACK_STEP(Ks, ks);
#pragma unroll
                        for (int c = 0; c < 2; ++c) { bf16x8 Vp; LOAD_VP(c, ks, Vp); S[a][c] = MFMA32(Ksp, Vp, S[a][c]); } }
                    __builtin_amdgcn_sched_barrier(0);
                }
            }
            if (PASS2) {
#pragma unroll
                for (int e = 0; e < 16; ++e) sc[e] = (crow(e, hh) <= r) ? sc[e] : 0.f;
#pragma unroll
                for (int ks = 0; ks < 2; ++ks) { const bf16x8 Pp = PACK_STEP(sc, ks);
#pragma unroll
                    for (int c = 0; c < 2; ++c) { bf16x8 Vp; LOAD_VP(c, ks, Vp); O[c] = MFMA32(Pp, Vp, O[c]); } }
                int lq2 = lz; asm volatile("" : "+v"(lq2));
                const int r2 = lq2 & 31, hh2 = lq2 >> 5;
#pragma unroll
                for (int c = 0; c < 2; ++c)
#pragma unroll
                    for (int e = 0; e < 16; ++e) *(float*)((char*)osc + (unsigned)((((dir * MTOK + rbase + sg * crow(e, hh2)) * DHG) + h * 64 + 32 * c + r2) * 4)) = O[c][e];
            }
#undef LOAD_VP
        }
        if (!PASS2) {
#pragma unroll
            for (int a = 0; a < 2; ++a)
#pragma unroll
                for (int c = 0; c < 2; ++c)
#pragma unroll
                    for (int e = 0; e < 16; ++e) *(float*)((char*)Usum + ((unsigned)(task * 4096 + lz) * 4u + (unsigned)(((a * 2 + c) * 16 + e) * 256))) = S[a][c][e];
        } else {
            asm volatile("s_waitcnt vmcnt(0)" ::: "memory");
            __syncthreads();
            bf16_t* merged = (bf16_t*)(p->ws + WS_R3);
            const int ch = h * 64 + F.lane; const float nw = p->norm_hgrn_w[l * DHG + ch];
#pragma unroll 4
            for (int i = 0; i < 64; ++i) { const int row = b * SEQ + g * 512 + F.wave * 64 + i;
                const float ot = *(const float*)((const char*)osc + (unsigned)((row * DHG + ch) * 4)) + *(const float*)((const char*)osc + (unsigned)(((MTOK + row) * DHG + ch) * 4));
                const float ms = wave_sum(ot * ot) * (1.0f / 64.0f);
                const float gv = bf2f(*(const bf16_t*)((const char*)proj + (unsigned)((row * PROJ + 3072 + ch) * 2)));
                *(bf16_t*)((char*)merged + (unsigned)((row * DM + DLRU + ch) * 2)) = f2bf(ot * rsqrtf(ms + NORM_EPS) * nw * siluf_(gv)); }
            __syncthreads();
        }
    }
}

__device__ __forceinline__ void phase_hgrn_prefix(KParams p, const Ctx& F) {
    float* Usum = (float*)(p->ws + WS_R2); const float* Dsum = Usum + (size_t)HG_TASKS * 4096;
    for (int gt = blockIdx.x * NTHREADS + F.tid; gt < 64 * 4096; gt += F.G * NTHREADS) {
        const int seq = gt >> 12, e = gt & 4095, dir = seq & 1;
        const int tile = e >> 10, reg = (e >> 6) & 15, ln = e & 63; const int d = 32 * (tile >> 1) + crow(reg, ln >> 5);
        float s = 0.f;
#pragma unroll 8
        for (int k = 0; k < 32; ++k) { const int trp = dir == 0 ? k : 31 - k; const size_t tp = (size_t)seq * 32 + trp;
            const float u = Usum[tp * 4096 + e], dd = Dsum[(tp * 4 + 0) * 64 + d] * Dsum[(tp * 4 + 1) * 64 + d] * Dsum[(tp * 4 + 2) * 64 + d] * Dsum[(tp * 4 + 3) * 64 + d];
            Usum[tp * 4096 + e] = s; s = dd * s + u; }
    }
}

constexpr int RT_PITCH = 2064;
__device__ __forceinline__ void phase_route(KParams p, const Ctx& F, int l) {
    const float* mod = (const float*)(p->ws + WS_MOD) + (size_t)l * NB * 6 * DM;
    const float* xa = (const float*)(p->ws + WS_XA); bf16_t* h2 = (bf16_t*)(p->ws + WS_R2);
    const float* nw = p->norm_ffn_w + l * DM;
    int* cnt = (int*)(p->ws + WS_CTL + CTL_CNT_OFF) + l * NEXP;
    int* tokinfo = (int*)(p->ws + WS_TOKINFO); float* tokw = (float*)(p->ws + WS_TOKW);
    const bf16_t* rwh = (const bf16_t*)(p->ws + WS_RWHI) + (size_t)l * 64 * DM; const bf16_t* rwl = (const bf16_t*)(p->ws + WS_RWLO) + (size_t)l * 64 * DM;
    LAS unsigned char* Ah = F.lds; LAS unsigned char* Al = F.lds + 32 * RT_PITCH; LAS float* part = (LAS float*)F.lds;
    const int r = F.lane & 31, hh = F.lane >> 5;
    for (int tile = blockIdx.x; tile < MTOK / 32; tile += F.G) {
        const int row0 = tile * 32;
#pragma unroll 1
        for (int i = 0; i < 4; ++i) {
            const int rl = F.wave * 4 + i, row = row0 + rl, b = row >> 12; const float* xr = xa + (size_t)row * DM;
            f32x4 v[4]; float ss = 0.f;
#pragma unroll
            for (int q = 0; q < 4; ++q) { v[q] = *(const f32x4*)(xr + F.lane * 4 + 256 * q); ss += v[q][0] * v[q][0] + v[q][1] * v[q][1] + v[q][2] * v[q][2] + v[q][3] * v[q][3]; }
            ss = wave_sum(ss); const float rstd = rsqrtf(ss * (1.0f / DM) + NORM_EPS);
#pragma unroll
            for (int q = 0; q < 4; ++q) { const int col = F.lane * 4 + 256 * q;
                const f32x4 w4 = *(const f32x4*)(nw + col), sh = *(const f32x4*)(mod + (size_t)b * 6 * DM + 3 * DM + col), s1 = *(const f32x4*)(mod + (size_t)b * 6 * DM + 4 * DM + col);
                const f32x4 o = v[q] * rstd * w4 * (s1 + 1.0f) + sh;
                u32x2 pk; pk[0] = cvt_pk_bf16(o[0], o[1]); pk[1] = cvt_pk_bf16(o[2], o[3]);
                *(u32x2*)(h2 + (size_t)row * DM + col) = pk;
                *(LAS u32x2*)(Ah + rl * RT_PITCH + col * 2) = pk;
                u32x2 lo; lo[0] = cvt_pk_bf16(o[0] - __uint_as_float(pk[0] << 16), o[1] - __uint_as_float(pk[0] & 0xFFFF0000u));
                lo[1] = cvt_pk_bf16(o[2] - __uint_as_float(pk[1] << 16), o[3] - __uint_as_float(pk[1] & 0xFFFF0000u));
                *(LAS u32x2*)(Al + rl * RT_PITCH + col * 2) = lo; }
        }
        __syncthreads();
        f32x16 acc[2];
#pragma unroll
        for (int e = 0; e < 16; ++e) { acc[0][e] = 0.f; acc[1][e] = 0.f; }
#pragma unroll 2
        for (int ks = 0; ks < 8; ++ks) { const int k0 = F.wave * 128 + ks * 16 + 8 * hh;
            const bf16x8 ah = *(const LAS bf16x8*)(Ah + r * RT_PITCH + k0 * 2), al = *(const LAS bf16x8*)(Al + r * RT_PITCH + k0 * 2);
#pragma unroll
            for (int nt = 0; nt < 2; ++nt) { const bf16x8 bh = *(const bf16x8*)(rwh + (size_t)(nt * 32 + r) * DM + k0), bl = *(const bf16x8*)(rwl + (size_t)(nt * 32 + r) * DM + k0);
                acc[nt] = MFMA32(ah, bh, acc[nt]); acc[nt] = MFMA32(al, bh, acc[nt]); acc[nt] = MFMA32(ah, bl, acc[nt]); } }
        __syncthreads();
#pragma unroll
        for (int nt = 0; nt < 2; ++nt)
#pragma unroll
            for (int e = 0; e < 16; ++e) part[(F.wave * 32 + crow(e, hh)) * 64 + nt * 32 + r] = acc[nt][e];
        __syncthreads();
        if (F.tid < 32) {
            const int row = row0 + F.tid;
            float lg[36];
#pragma unroll
            for (int n = 0; n < 36; ++n) { float s = 0.f;
#pragma unroll
                for (int w = 0; w < 8; ++w) s += part[(w * 32 + F.tid) * 64 + n];
                lg[n] = s; }
            float gl[4];
#pragma unroll
            for (int j = 0; j < 4; ++j) gl[j] = lg[32 + j] + p->rg_b[l * NGRP + j];
            int gi = 0; float gm = gl[0];
#pragma unroll
            for (int j = 1; j < 4; ++j) if (gl[j] > gm) { gm = gl[j]; gi = j; }
            float gs = 0.f;
#pragma unroll
            for (int j = 0; j < 4; ++j) gs += __expf(gl[j] - gm);
            const float pg = 1.0f / gs;
            float el[8];
#pragma unroll
            for (int j = 0; j < 8; ++j) { float v = lg[j];
#pragma unroll
                for (int q = 1; q < 4; ++q) v = (gi == q) ? lg[q * 8 + j] : v;
                el[j] = v + p->re_b[l * NEXP + gi * 8 + j]; }
            int i0 = 0; float v0 = el[0];
#pragma unroll
            for (int j = 1; j < 8; ++j) if (el[j] > v0) { v0 = el[j]; i0 = j; }
            int i1 = -1; float v1 = -3.0e38f;
#pragma unroll
            for (int j = 0; j < 8; ++j) if (j != i0 && el[j] > v1) { v1 = el[j]; i1 = j; }
            const float ex = __expf(v1 - v0); const float w0 = pg / (1.0f + ex), w1 = pg * ex / (1.0f + ex);
            const int e0 = gi * 8 + i0, e1 = gi * 8 + i1;
            const int p0 = atomicAdd(&cnt[e0], 1), p1 = atomicAdd(&cnt[e1], 1);
            *(int4*)(tokinfo + (size_t)row * 4) = make_int4(e0, p0, e1, p1);
            *(float2*)(tokw + (size_t)row * 2) = make_float2(w0, w1);
        }
        __syncthreads();
    }
}

constexpr int MOE_MAX_UNITS = 8;
__device__ __forceinline__ void build_tile_table(KParams p, const Ctx& F, int l) {
    LAS int* tst = (LAS int*)(F.lds + LDS_MISC + 64);
    LAS int* ulist = (LAS int*)(F.lds + LDS_MISC + 256);
    const int* cnt = (const int*)(p->ws + WS_CTL + CTL_CNT_OFF) + l * NEXP;
    if (F.tid == 0) { int acc = 0; for (int e = 0; e < NEXP; ++e) { tst[e] = acc; acc += (__hip_atomic_load(cnt + e, __ATOMIC_RELAXED, __HIP_MEMORY_SCOPE_AGENT) + 255) >> 8; } tst[NEXP] = acc; }
    __syncthreads();
    if (F.tid <= MOE_MAX_UNITS) { const int L = F.tid * F.G + (int)blockIdx.x, tm = tst[NEXP]; int pm = -1, pn = 0;
        if (F.tid < MOE_MAX_UNITS && L < tm * 4) { const int mt = L >> 2; int e = 0; for (int k = 1; k < NEXP; ++k) e += (tst[k] <= mt) ? 1 : 0; pm = mt; pn = e * 4 + (L & 3); }
        ulist[2 * F.tid] = pm; ulist[2 * F.tid + 1] = pn; }
    __syncthreads();
}

__device__ __forceinline__ void phase_permute(KParams p, const Ctx& F, int l) {
    build_tile_table(p, F, l);
    const LAS int* tst = (const LAS int*)(F.lds + LDS_MISC + 64);
    const bf16_t* h2 = (const bf16_t*)(p->ws + WS_R2); bf16_t* xperm = (bf16_t*)(p->ws + WS_R1);
    const int* tokinfo = (const int*)(p->ws + WS_TOKINFO); const float* tokw = (const float*)(p->ws + WS_TOKW);
    int* rowtok = (int*)(p->ws + WS_ROWTOK); float* roww = (float*)(p->ws + WS_ROWW);
    const int* cnt = (const int*)(p->ws + WS_CTL + CTL_CNT_OFF) + l * NEXP;
    for (int row = F.gwave; row < MTOK; row += F.nwaves) {
        const int4 ti = *(const int4*)(tokinfo + (size_t)row * 4); const float2 tw = *(const float2*)(tokw + (size_t)row * 2);
        const int r0 = tst[ti.x] * 256 + ti.y, r1 = tst[ti.z] * 256 + ti.w;
        const u32x4 a = *(const u32x4*)(h2 + (size_t)row * DM + F.lane * 8), b2 = *(const u32x4*)(h2 + (size_t)row * DM + 512 + F.lane * 8);
        *(u32x4*)(xperm + (size_t)r0 * DM + F.lane * 8) = a; *(u32x4*)(xperm + (size_t)r0 * DM + 512 + F.lane * 8) = b2;
        *(u32x4*)(xperm + (size_t)r1 * DM + F.lane * 8) = a; *(u32x4*)(xperm + (size_t)r1 * DM + 512 + F.lane * 8) = b2;
        if (F.lane == 0) { rowtok[r0] = row * 2; rowtok[r1] = row * 2 + 1; roww[r0] = tw.x; roww[r1] = tw.y; }
    }
    if ((int)blockIdx.x < NEXP) { const int e = blockIdx.x; const int c = __hip_atomic_load(cnt + e, __ATOMIC_RELAXED, __HIP_MEMORY_SCOPE_AGENT);
        const int lo = tst[e] * 256 + c, hi = tst[e + 1] * 256;
        for (int r = lo + F.tid; r < hi; r += NTHREADS) { rowtok[r] = -1; roww[r] = 0.f; } }
}

template <bool FINAL>
__device__ __forceinline__ void phase_combine(KParams p, const Ctx& F, int l, float* xo) {
    const float* mod = (const float*)(p->ws + WS_MOD) + (size_t)l * NB * 6 * DM;
    const float* xa = (const float*)(p->ws + WS_XA); const bf16_t* y = (const bf16_t*)(p->ws + WS_R1);
    for (int row = F.gwave; row < MTOK; row += F.nwaves) {
        const int b = row >> 12; f32x4 v[4]; float ss = 0.f;
#pragma unroll
        for (int i = 0; i < 4; ++i) { const int col = F.lane * 4 + 256 * i;
            const f32x4 xv = *(const f32x4*)(xa + (size_t)row * DM + col), g = *(const f32x4*)(mod + (size_t)b * 6 * DM + 5 * DM + col);
            const u32x2 y0 = *(const u32x2*)(y + (size_t)(row * 2) * DM + col), y1 = *(const u32x2*)(y + (size_t)(row * 2 + 1) * DM + col);
            f32x4 ys; ys[0] = __uint_as_float(y0[0] << 16) + __uint_as_float(y1[0] << 16); ys[1] = __uint_as_float(y0[0] & 0xFFFF0000u) + __uint_as_float(y1[0] & 0xFFFF0000u);
            ys[2] = __uint_as_float(y0[1] << 16) + __uint_as_float(y1[1] << 16); ys[3] = __uint_as_float(y0[1] & 0xFFFF0000u) + __uint_as_float(y1[1] & 0xFFFF0000u);
            v[i] = xv + g * ys; ss += v[i][0] * v[i][0] + v[i][1] * v[i][1] + v[i][2] * v[i][2] + v[i][3] * v[i][3]; }
        if (FINAL) { ss = wave_sum(ss); const float rstd = rsqrtf(ss * (1.0f / DM) + NORM_EPS);
#pragma unroll
            for (int i = 0; i < 4; ++i) { const int col = F.lane * 4 + 256 * i; const f32x4 w4 = *(const f32x4*)(p->final_w + col); *(f32x4*)(p->out + (size_t)row * DM + col) = v[i] * rstd * w4; }
        } else {
#pragma unroll
            for (int i = 0; i < 4; ++i) *(f32x4*)(xo + (size_t)row * DM + F.lane * 4 + 256 * i) = v[i];
        }
    }
}


__device__ __forceinline__ Ctx make_ctx(LAS unsigned char* lds) {
    int tz = threadIdx.x; asm volatile("" : "+v"(tz));
    Ctx F; F.lds = lds; F.tid = tz; F.lane = tz & 63; F.wave = __builtin_amdgcn_readfirstlane(tz >> 6);
    F.G = gridDim.x; F.gwave = blockIdx.x * NWAVES + F.wave; F.nwaves = F.G * NWAVES; return F;
}

constexpr int PH_PER_LAYER = 11, N_PHASES = 1 + DEPTH * PH_PER_LAYER;
#ifndef DBG_MASK
#define DBG_MASK 0xFFFFFFFFu
#endif
#define IN(k) ((((DBG_MASK) >> ((k) == 0 ? 0 : (((k) - 1) % PH_PER_LAYER) + 1)) & 1u) && lo <= (k) && (k) < hi)
#define SEAM(k) do { if (IN(k) && IN((k) + 1)) xcd_barrier(bar); } while (0)
#define SITE KParams P = get_params(); const Ctx F = make_ctx(lds);
#ifndef DBG_REPEAT
#define DBG_REPEAT 0u
#endif
#define NREP(k) (1 + (int)(((DBG_REPEAT) >> ((k) == 0 ? 0 : (((k) - 1) % PH_PER_LAYER) + 1)) & 1u))
#define PHASE(k, ...) { if (IN(k)) { __VA_ARGS__ } if constexpr (NREP(k) == 2) { if (IN(k)) { xcd_barrier(bar); __VA_ARGS__ } } }

template <int l>
__device__ __forceinline__ void run_layer(LAS unsigned char* const lds, const int lo, const int hi, const XcdBarrier& bar) {
        const int base = 1 + l * PH_PER_LAYER;
        PHASE(base + 0, SITE phase_norm1(P, F, l, (l == 0) ? P->x : P->out);)
        SEAM(base + 0);
        PHASE(base + 1, SITE
            pg8::Gemm g{(const bf16_t*)(P->ws + WS_R2), (const bf16_t*)(P->ws + WS_WIN) + (size_t)l * PROJ * DM, MTOK, PROJ, DM};
            pg8::StaticOrder S; S.init(MTOK, PROJ, F.G, (int)blockIdx.x);
            pg8::EpiBf16 E{(bf16_t*)(P->ws + WS_R1), PROJ};
            pg8::gemm_phase(F.lds, g, S, E);)
        SEAM(base + 1);
        PHASE(base + 2, SITE phase_lru<false>(P, F, l);)
        PHASE(base + 2, SITE phase_hgrn<false>(P, F, l);)
        SEAM(base + 2);
        PHASE(base + 3, SITE phase_lru<true>(P, F, l);)
        if (IN(base + 3)) { SITE phase_hgrn_prefix(P, F); }
        SEAM(base + 3);
        PHASE(base + 4, SITE phase_hgrn<true>(P, F, l);)
        SEAM(base + 4);
        PHASE(base + 5, SITE
            pg8::Gemm g{(const bf16_t*)(P->ws + WS_R3), (const bf16_t*)(P->ws + WS_WOUT) + (size_t)l * DM * DM, MTOK, DM, DM};
            pg8::StaticOrder S; S.init(MTOK, DM, F.G, (int)blockIdx.x);
            pg8::EpiResid E{(l == 0) ? P->x : P->out, (float*)(P->ws + WS_XA), (const float*)(P->ws + WS_MOD) + (size_t)l * NB * 6 * DM + 2 * DM};
            pg8::gemm_phase(F.lds, g, S, E);)
        SEAM(base + 5);
        PHASE(base + 6, SITE phase_route(P, F, l);)
        SEAM(base + 6);
        PHASE(base + 7, SITE phase_permute(P, F, l);)
        SEAM(base + 7);
        PHASE(base + 8, SITE
            build_tile_table(P, F, l);
            pg8::Gemm g{(const bf16_t*)(P->ws + WS_R1), (const bf16_t*)(P->ws + WS_WGU) + (size_t)l * NEXP * 1024 * DM, MPAD, NEXP * 1024, DM};
            pg8::MoeOrder S{(const LAS int*)(F.lds + LDS_MISC + 256)};
            pg8::EpiGateUp E{(bf16_t*)(P->ws + WS_R2)};
            pg8::gemm_phase(F.lds, g, S, E);)
        SEAM(base + 8);
        PHASE(base + 9, SITE
            build_tile_table(P, F, l);
            pg8::Gemm g{(const bf16_t*)(P->ws + WS_R2), (const bf16_t*)(P->ws + WS_WD) + (size_t)l * NEXP * 1024 * DEXP, MPAD, NEXP * 1024, DEXP};
            pg8::MoeOrder S{(const LAS int*)(F.lds + LDS_MISC + 256)};
            pg8::EpiDown E{(bf16_t*)(P->ws + WS_R1), (const int*)(P->ws + WS_ROWTOK), (const float*)(P->ws + WS_ROWW)};
            pg8::gemm_phase(F.lds, g, S, E);)
        SEAM(base + 9);
        PHASE(base + 10, SITE if (l == DEPTH - 1) phase_combine<true>(P, F, l, nullptr); else phase_combine<false>(P, F, l, P->out);)
        SEAM(base + 10);
    }

__global__ void __launch_bounds__(NTHREADS, 2) mega(Params p_unused) {
    (void)p_unused;
    extern __shared__ __attribute__((aligned(16))) unsigned char lds_raw[];
    LAS unsigned char* const lds = (LAS unsigned char*)lds_raw;
    int lo, hi; XcdBarrier bar;
    { KParams P = get_params(); lo = (int)P->ph_lo; hi = (int)P->ph_hi;
      if (threadIdx.x < 4) ((LAS unsigned*)(lds + LDS_MISC))[threadIdx.x] = 0u;
      __syncthreads();
      bar.bar = (unsigned*)(P->ws + WS_CTL); bar.x = 0; bar.st = nullptr;
      if (hi - lo > 1) bar = xcd_barrier_post((unsigned*)(P->ws + WS_CTL), (volatile LAS unsigned*)(lds + LDS_MISC)); }

    PHASE(0, SITE phase_prologue(P, F);)
    SEAM(0);
    run_layer<0>(lds, lo, hi, bar);
    run_layer<1>(lds, lo, hi, bar);
#undef IN
#undef SEAM
#undef SITE
}

extern "C" void kernel_launch(void* const* d_in, const int* in_sizes, int n_in, void* d_out, int out_size, void* d_ws, size_t ws_size, hipStream_t stream) {
    static int grid = 0;
    if (grid == 0) {
        if (n_in != 26 || in_sizes[0] != MTOK * DM || out_size != MTOK * DM || ws_size < WS_END) {
            fprintf(stderr, "kernel_launch: unexpected shapes (n_in %d, in0 %d, out %d, ws %zu, need %zu); nothing launched\n", n_in, n_in > 0 ? in_sizes[0] : -1, out_size, ws_size, (size_t)WS_END); grid = -1; return; }
        int dev = 0, cus = 0, per_cu = 0;
        if (hipGetDevice(&dev) != hipSuccess || hipDeviceGetAttribute(&cus, hipDeviceAttributeMultiprocessorCount, dev) != hipSuccess) { fprintf(stderr, "kernel_launch: device query failed\n"); grid = -1; return; }
        if (hipFuncSetAttribute((const void*)mega, hipFuncAttributeMaxDynamicSharedMemorySize, LDS_BYTES) != hipSuccess) { fprintf(stderr, "kernel_launch: hipFuncSetAttribute failed\n"); grid = -1; return; }
        if (hipOccupancyMaxActiveBlocksPerMultiprocessor(&per_cu, (const void*)mega, NTHREADS, LDS_BYTES) != hipSuccess || per_cu < 1)
            fprintf(stderr, "kernel_launch: note: occupancy query reports %d workgroups per CU\n", per_cu);
        (void)hipGetLastError();
        grid = cus;
    }
    if (grid < 0) return;
    if (hipMemsetAsync((char*)d_ws + WS_CTL, 0, CTL_ZERO_BYTES, stream) != hipSuccess) { fprintf(stderr, "kernel_launch: memset failed\n"); return; }
    Params p{};
    const float** pf = (const float**)&p;
    for (int i = 0; i < 26; ++i) pf[i] = (const float*)d_in[i];
    p.out = (float*)d_out; p.ws = (unsigned char*)d_ws;
#if MK_PER_PHASE
    for (int ph = 0; ph < N_PHASES; ++ph) { p.ph_lo = ph; p.ph_hi = ph + 1;
        hipLaunchKernelGGL(mega, dim3(grid), dim3(NTHREADS), LDS_BYTES, stream, p);
        const hipError_t le = hipPeekAtLastError();
        if (le != hipSuccess) { fprintf(stderr, "kernel_launch: launch %d failed: %s\n", ph, hipGetErrorName(le)); break; } }
#else
    p.ph_lo = 0; p.ph_hi = N_PHASES;
    hipLaunchKernelGGL(mega, dim3(grid), dim3(NTHREADS), LDS_BYTES, stream, p);
    const hipError_t le = hipPeekAtLastError();
    if (le != hipSuccess) fprintf(stderr, "kernel_launch: launch failed: %s\n", hipGetErrorName(le));
#endif
}
```

```cpp
#include <hip/hip_runtime.h>
#include <stdint.h>
#include <stdio.h>

#ifndef MK_PER_PHASE
#define MK_PER_PHASE 0
#endif

#define LAS __attribute__((address_space(3)))
typedef unsigned short bf16_t;
typedef short bf16x8 __attribute__((ext_vector_type(8)));
typedef float f32x4 __attribute__((ext_vector_type(4)));
typedef float f32x2 __attribute__((ext_vector_type(2)));
typedef unsigned u32x4 __attribute__((ext_vector_type(4)));
typedef unsigned u32x2 __attribute__((ext_vector_type(2)));

constexpr int NB = 4, SEQ = 4096, DM = 1024, MTOK = NB * SEQ, DEPTH = 2;
constexpr int DLRU = 512, DHG = 512, PROJ = 3584, NEXP = 32, DEXP = 512, NGRP = 4, EPG = 8;
constexpr int MPAD = 40960;
constexpr float NORM_EPS = 1e-6f;
constexpr int NWAVES = 8, NTHREADS = 512;

constexpr size_t WS_CTL = 0;
constexpr size_t CTL_ZERO_BYTES = 32768;
constexpr size_t CTL_CNT_OFF = 16384;
constexpr size_t WS_MOD = 65536;
constexpr size_t WS_WIN = WS_MOD + 196608;
constexpr size_t WS_WOUT = WS_WIN + (size_t)DEPTH * PROJ * DM * 2;
constexpr size_t WS_WGU = WS_WOUT + (size_t)DEPTH * DM * DM * 2;
constexpr size_t WS_WD = WS_WGU + (size_t)DEPTH * NEXP * 1024 * 1024 * 2;
constexpr size_t WS_R1 = WS_WD + (size_t)DEPTH * NEXP * 1024 * 512 * 2;
constexpr size_t WS_R2 = WS_R1 + (size_t)MTOK * PROJ * 2;
constexpr size_t WS_R3 = WS_R2 + (size_t)MPAD * 512 * 2;
constexpr size_t WS_XA = WS_R3 + (size_t)MTOK * DM * 2;
constexpr size_t WS_TOKINFO = WS_XA + (size_t)MTOK * DM * 4;
constexpr size_t WS_TOKW = WS_TOKINFO + (size_t)MTOK * 16;
constexpr size_t WS_ROWTOK = WS_TOKW + (size_t)MTOK * 8;
constexpr size_t WS_ROWW = WS_ROWTOK + (size_t)MPAD * 4;
constexpr size_t WS_LRUW = WS_ROWW + (size_t)MPAD * 4;
constexpr size_t WS_SUMA = WS_LRUW + 524288;
constexpr size_t WS_SUMH = WS_SUMA + 1048576;
constexpr size_t WS_RWHI = WS_SUMH + 1048576;
constexpr size_t WS_RWLO = WS_RWHI + (size_t)DEPTH * 64 * DM * 2;
constexpr size_t WS_END = WS_RWLO + (size_t)DEPTH * 64 * DM * 2;

constexpr int LDS_STAGE = 139264;
constexpr int LDS_MISC = LDS_STAGE;
constexpr int LDS_BYTES = LDS_STAGE + 2048;

#define XB_TMO      128
#define XB_XCNT(j)  (256  + 64 * (j))
#define XB_XSUB(j)  (1280 + 64 * (j))
#define XB_XGEN(j)  (2304 + 64 * (j))
#define XB_TOP      3328
#define XB_TOPGEN   3392
#define XCD_BAR_WORDS 3456
#define XB_SPIN_CAP (1u << 22)

__device__ __forceinline__ unsigned xb_ld(unsigned* p)              { return __hip_atomic_load(p, __ATOMIC_RELAXED, __HIP_MEMORY_SCOPE_AGENT); }
__device__ __forceinline__ unsigned xb_add(unsigned* p, unsigned v) { return __hip_atomic_fetch_add(p, v, __ATOMIC_RELAXED, __HIP_MEMORY_SCOPE_AGENT); }
__device__ __forceinline__ unsigned xb_xcc_id() { return (unsigned)__builtin_amdgcn_s_getreg((3 << 11) | 20) & 0xFu; }
#define XB_SPIN(cond, bar) do { unsigned _sp = 0; while (cond) { __builtin_amdgcn_s_sleep(1); \
    if ((++_sp & 255u) == 0u) { if (xb_ld(&(bar)[XB_TMO])) break; if (_sp > XB_SPIN_CAP) { atomicAdd(&(bar)[XB_TMO], 1u); break; } } } } while (0)

struct XcdBarrier { unsigned* bar; unsigned x; volatile LAS unsigned* st; };

__device__ __forceinline__ XcdBarrier xcd_barrier_post(unsigned* bar, volatile LAS unsigned* st) {
    XcdBarrier b; b.bar = bar; b.x = xb_xcc_id(); b.st = st;
    if (threadIdx.x == 0) (void)xb_add(&bar[XB_XCNT(b.x)], 1u);
    return b;
}
__device__ __forceinline__ void xcd_barrier_complete(unsigned* bar, unsigned x, unsigned& nloc, unsigned& nx) {
    const unsigned G = gridDim.x * gridDim.y * gridDim.z;
    unsigned sum, cnt, mine, sp = 0u;
    for (;;) {
        sum = 0u; cnt = 0u; mine = 0u;
#pragma unroll
        for (unsigned j = 0; j < 16; ++j) { const unsigned c = xb_ld(&bar[XB_XCNT(j)]); sum += c; cnt += (c > 0u) ? 1u : 0u; mine = (j == x) ? c : mine; }
        if (sum == G) break;
        __builtin_amdgcn_s_sleep(1);
        if ((++sp & 255u) == 0u) { if (xb_ld(&bar[XB_TMO])) break; if (sp > XB_SPIN_CAP) { atomicAdd(&bar[XB_TMO], 1u); break; } }
    }
    nloc = mine > 0u ? mine : 1u; nx = cnt > 0u ? cnt : 1u;
}
__device__ __forceinline__ void xcd_barrier(const XcdBarrier& b) {
    asm volatile("s_waitcnt vmcnt(0)" ::: "memory");
    __syncthreads();
    if (threadIdx.x == 0) {
        unsigned* bar = b.bar;
        __builtin_amdgcn_s_waitcnt(0);
        unsigned nloc = b.st[0], nx = b.st[1];
        if (nloc == 0u) { xcd_barrier_complete(bar, b.x, nloc, nx); b.st[0] = nloc; b.st[1] = nx; }
        const unsigned old = xb_add(&bar[XB_XSUB(b.x)], 1u);
        const unsigned gen = old / nloc;
        if (old + 1u == (gen + 1u) * nloc) {
            __builtin_amdgcn_fence(__ATOMIC_RELEASE, "agent");
            asm volatile("s_waitcnt vmcnt(0)" ::: "memory");
            const unsigned og = xb_add(&bar[XB_TOP], 1u);
            const unsigned tg = og / nx;
            if (og + 1u == (tg + 1u) * nx) xb_add(&bar[XB_TOPGEN], 1u);
            else XB_SPIN(xb_ld(&bar[XB_TOPGEN]) == tg, bar);
            __builtin_amdgcn_fence(__ATOMIC_ACQUIRE, "agent");
            xb_add(&bar[XB_XGEN(b.x)], 1u);
            asm volatile("s_waitcnt vmcnt(0)" ::: "memory");
        } else {
            XB_SPIN(xb_ld(&bar[XB_XGEN(b.x)]) == gen, bar);
            __builtin_amdgcn_fence(__ATOMIC_ACQUIRE, "agent");
            asm volatile("s_waitcnt vmcnt(0)" ::: "memory");
        }
    }
    __syncthreads();
}

__device__ __forceinline__ float bf2f(bf16_t b) { return __uint_as_float(((unsigned)b) << 16); }
__device__ __forceinline__ bf16_t f2bf(float f) { unsigned u = __float_as_uint(f); u += 0x7FFFu + ((u >> 16) & 1u); return (bf16_t)(u >> 16); }
__device__ __forceinline__ unsigned cvt_pk_bf16(float lo, float hi) { unsigned r; asm volatile("v_cvt_pk_bf16_f32 %0, %1, %2" : "=v"(r) : "v"(lo), "v"(hi)); return r; }
__device__ __forceinline__ float wave_sum(float v) {
#pragma unroll
    for (int m = 32; m >= 1; m >>= 1) v += __shfl_xor(v, m, 64);
    return v;
}
__device__ __forceinline__ float sigmoidf_(float x) { return __builtin_amdgcn_rcpf(1.0f + __expf(-x)); }
__device__ __forceinline__ float siluf_(float x) { return x * sigmoidf_(x); }
__device__ __forceinline__ float gelu_tanh(float x) {
    const float u = 0.7978845608028654f * (x + 0.044715f * x * x * x);
    const float t = 1.0f - 2.0f / (__expf(2.0f * u) + 1.0f);
    return 0.5f * x * (1.0f + t);
}
__device__ __forceinline__ float rdlane(float v, int l) { return __int_as_float(__builtin_amdgcn_readlane(__float_as_int(v), l)); }

namespace pg8 {
constexpr int BM = 256, BK = 64, HALF = 128, HTB = HALF * BK * 2, STAGE_BYTES = 8 * HTB, NXCD = 8, WGM = 8;
__host__ __device__ __forceinline__ int lds_byte(int r, int c) { const int st = (r >> 4) * 2 + (c >> 5), rr = r & 15, cc = c & 31, ob = rr * 64 + cc * 2; return st * 1024 + (ob ^ (((ob >> 9) & 1) << 5)); }
__host__ __device__ __forceinline__ void stage_rc(int b, int& R, int& C) { const int st = b / 1024, sb = b % 1024, swz = sb ^ (((sb >> 9) & 1) << 5); R = (st >> 1) * 16 + swz / 64; C = (st & 1) * 32 + (swz % 64) / 2; }
__host__ __device__ __forceinline__ int perm32(int rho) { const int n = rho >> 4, i = rho & 15; return 8 * (i >> 2) + 4 * n + (i & 3); }

struct Unit { int pm, pn; };
struct Gemm { const bf16_t* A; const bf16_t* Bt; int M, N, K; };

struct StaticOrder {
    int nM, nN, nwg, G, c;
    __host__ __device__ void init(int M, int N, int G_, int c_) { nM = M / BM; nN = N / BM; nwg = nM * nN; G = G_; c = c_; }
    __host__ __device__ bool next(int i, Unit& u) const {
        const long L = (long)i * G + c; if (L >= nwg) return false;
        int wgid = (int)L; { const int q = nwg / NXCD, r = nwg % NXCD, xcd = wgid % NXCD, off = wgid / NXCD; wgid = (xcd < r ? xcd * (q + 1) : r * (q + 1) + (xcd - r) * q) + off; }
        const int nig = WGM * nN, gid = wgid / nig, fm = gid * WGM, gsz = (nM - fm) < WGM ? (nM - fm) : WGM;
        u.pm = fm + ((wgid % nig) % gsz); u.pn = (wgid % nig) / gsz; return true;
    }
    __device__ __forceinline__ void a_ready(const Unit&) const {}
    __device__ __forceinline__ void done(const Unit&) const {}
};

struct MoeOrder {
    const LAS int* ulist;
    __device__ __forceinline__ bool next(int i, Unit& u) const {
        const int pm = __builtin_amdgcn_readfirstlane(ulist[2 * i]); if (pm < 0) return false;
        u.pm = pm; u.pn = __builtin_amdgcn_readfirstlane(ulist[2 * i + 1]); return true;
    }
    __device__ __forceinline__ void a_ready(const Unit&) const {}
    __device__ __forceinline__ void done(const Unit&) const {}
};

struct EpiBf16 {
    static constexpr bool PERM = true;
    bf16_t* O; int ldc;
    __device__ __forceinline__ void operator()(const f32x4 (&acc)[2][2][4][2], const Unit& u, int wr, int wc, int fr, int fq) const {
        const int row0 = u.pm * BM + wr * 64 + fr, col0 = u.pn * BM + wc * 32 + 8 * fq;
#pragma unroll
        for (int ai = 0; ai < 2; ++ai)
#pragma unroll
            for (int m = 0; m < 4; ++m) { bf16_t* rowp = O + (size_t)(row0 + ai * HALF + m * 16) * ldc + col0;
#pragma unroll
                for (int bj = 0; bj < 2; ++bj) { const f32x4 v0 = acc[ai][bj][m][0], v1 = acc[ai][bj][m][1];
                    u32x4 o; o[0] = cvt_pk_bf16(v0[0], v0[1]); o[1] = cvt_pk_bf16(v0[2], v0[3]); o[2] = cvt_pk_bf16(v1[0], v1[1]); o[3] = cvt_pk_bf16(v1[2], v1[3]);
                    *(u32x4*)(rowp + bj * HALF) = o; } }
    }
};
struct EpiResid {
    static constexpr bool PERM = false;
    const float* XI; float* XO; const float* gate;
    __device__ __forceinline__ void operator()(const f32x4 (&acc)[2][2][4][2], const Unit& u, int wr, int wc, int fr, int fq) const {
        const int row0 = u.pm * BM + wr * 64 + fr, col0 = u.pn * BM + wc * 32 + 4 * fq;
        const int b = (u.pm * BM) / SEQ;
        f32x4 gv[2][2];
#pragma unroll
        for (int bj = 0; bj < 2; ++bj)
#pragma unroll
            for (int n = 0; n < 2; ++n) gv[bj][n] = *(const f32x4*)(gate + (size_t)b * 6 * DM + col0 + bj * HALF + n * 16);
#pragma unroll
        for (int ai = 0; ai < 2; ++ai)
#pragma unroll
            for (int m = 0; m < 4; ++m) { const size_t ro = (size_t)(row0 + ai * HALF + m * 16) * DM + col0;
#pragma unroll
                for (int bj = 0; bj < 2; ++bj)
#pragma unroll
                    for (int n = 0; n < 2; ++n) { const f32x4 xi = *(const f32x4*)(XI + ro + bj * HALF + n * 16);
                        *(f32x4*)(XO + ro + bj * HALF + n * 16) = xi + gv[bj][n] * acc[ai][bj][m][n]; } }
    }
};
struct EpiGateUp {
    static constexpr bool PERM = true;
    bf16_t* H;
    __device__ __forceinline__ void operator()(const f32x4 (&acc)[2][2][4][2], const Unit& u, int wr, int wc, int fr, int fq) const {
        const int row0 = u.pm * BM + wr * 64 + fr, col0 = (u.pn & 3) * 128 + wc * 32 + 8 * fq;
#pragma unroll
        for (int ai = 0; ai < 2; ++ai)
#pragma unroll
            for (int m = 0; m < 4; ++m) { bf16_t* rowp = H + (size_t)(row0 + ai * HALF + m * 16) * DEXP + col0;
                float h[8];
#pragma unroll
                for (int n = 0; n < 2; ++n)
#pragma unroll
                    for (int q = 0; q < 4; ++q) { const float g = acc[ai][0][m][n][q], up = acc[ai][1][m][n][q]; h[n * 4 + q] = g / (1.0f + __expf(-g)) * up; }
                u32x4 o; o[0] = cvt_pk_bf16(h[0], h[1]); o[1] = cvt_pk_bf16(h[2], h[3]); o[2] = cvt_pk_bf16(h[4], h[5]); o[3] = cvt_pk_bf16(h[6], h[7]);
                *(u32x4*)rowp = o; }
    }
};
struct EpiDown {
    static constexpr bool PERM = true;
    bf16_t* Y; const int* rowtok; const float* roww;
    __device__ __forceinline__ void operator()(const f32x4 (&acc)[2][2][4][2], const Unit& u, int wr, int wc, int fr, int fq) const {
        const int row0 = u.pm * BM + wr * 64 + fr, col0 = (u.pn & 3) * BM + wc * 32 + 8 * fq;
#pragma unroll
        for (int ai = 0; ai < 2; ++ai)
#pragma unroll
            for (int m = 0; m < 4; ++m) { const int row = row0 + ai * HALF + m * 16; const int rt = rowtok[row];
                if (rt >= 0) { const float w = roww[row]; bf16_t* rowp = Y + (size_t)rt * DM + col0;
#pragma unroll
                    for (int bj = 0; bj < 2; ++bj) { const f32x4 v0 = acc[ai][bj][m][0] * w, v1 = acc[ai][bj][m][1] * w;
                        u32x4 o; o[0] = cvt_pk_bf16(v0[0], v0[1]); o[1] = cvt_pk_bf16(v0[2], v0[3]); o[2] = cvt_pk_bf16(v1[0], v1[1]); o[3] = cvt_pk_bf16(v1[2], v1[3]);
                        *(u32x4*)(rowp + bj * HALF) = o; } } }
    }
};

template <class Epi, class Sched>
__device__ __forceinline__ void gemm_phase(LAS unsigned char* lds, const Gemm g, const Sched& S, const Epi& E) {
    const int tid = threadIdx.x, wid = __builtin_amdgcn_readfirstlane(tid >> 6), lane = tid & 63, wr = wid >> 2, wc = wid & 3, fr = lane & 15, fq = lane >> 4;
    const int K = g.K, nt = K / BK;
    unsigned voffA[2], voffB[2];
#pragma unroll
    for (int i = 0; i < 2; ++i) { int R, C; stage_rc(tid * 16 + i * 8192, R, C); const int Rb = Epi::PERM ? ((R & ~31) + perm32(R & 31)) : R;
        voffA[i] = (unsigned)(R * K + C) * 2u; voffB[i] = (unsigned)(Rb * K + C) * 2u; }
    const size_t kstep = (size_t)(BK * 2);
    const size_t hstep = (size_t)HALF * K * 2;
    const size_t tstep = 2 * hstep;
    const unsigned ldsw = (unsigned)wid * 1024u;
    const int aoff = lds_byte(wr * 64 + fr, fq * 8), boff = lds_byte(wc * 32 + fr, fq * 8);
#define PG8_SA(b, h) (((b) * 2 + (h)) * HTB)
#define PG8_SB(b, h) ((4 + (b) * 2 + (h)) * HTB)
#define PG8_STAGE(bufoff, gbase, voff) do { _Pragma("unroll") for (int _i = 0; _i < 2; ++_i) \
        __builtin_amdgcn_global_load_lds((const unsigned*)((const char*)(gbase) + (voff)[_i]), (LAS unsigned*)(lds + (bufoff) + ldsw + _i * 8192), 16, 0, 0); } while (0)
#define PG8_LDA(dst, b, h) do { _Pragma("unroll") for (int m = 0; m < 4; ++m) _Pragma("unroll") for (int k = 0; k < 2; ++k) dst[m][k] = *(const LAS bf16x8*)(lds + PG8_SA(b, h) + aoff + m * 2048 + k * 1024); } while (0)
#define PG8_LDB(dst, b, h) do { _Pragma("unroll") for (int n = 0; n < 2; ++n) _Pragma("unroll") for (int k = 0; k < 2; ++k) dst[n][k] = *(const LAS bf16x8*)(lds + PG8_SB(b, h) + boff + n * 2048 + k * 1024); } while (0)
#define PG8_MMA(ai, bj, At, Bt) do { __builtin_amdgcn_s_setprio(1); _Pragma("unroll") for (int m = 0; m < 4; ++m) _Pragma("unroll") for (int n = 0; n < 2; ++n) _Pragma("unroll") for (int k = 0; k < 2; ++k) \
        acc[ai][bj][m][n] = __builtin_amdgcn_mfma_f32_16x16x32_bf16(Bt[n][k], At[m][k], acc[ai][bj][m][n], 0, 0, 0); __builtin_amdgcn_s_setprio(0); } while (0)
#define PG8_WAIT_V(n) asm volatile("s_waitcnt vmcnt(" #n ")" ::: "memory")
#define PG8_WAIT_L(n) asm volatile("s_waitcnt lgkmcnt(" #n ")" ::: "memory")
#define PG8_BAR __builtin_amdgcn_s_barrier()
#define PG8_SCHED __builtin_amdgcn_sched_barrier(0)
    Unit cur, nxt; int ui = 0;
    if (!S.next(0, cur)) return;
    f32x4 acc[2][2][4][2];
#pragma unroll
    for (int a = 0; a < 2; ++a)
#pragma unroll
        for (int b = 0; b < 2; ++b)
#pragma unroll
            for (int m = 0; m < 4; ++m)
#pragma unroll
                for (int n = 0; n < 2; ++n) acc[a][b][m][n] = (f32x4){0.f, 0.f, 0.f, 0.f};
    bf16x8 At[4][2], B0[2][2], B1[2][2];
    const char* cA = (const char*)g.A + (size_t)cur.pm * tstep; const char* cB = (const char*)g.Bt + (size_t)cur.pn * tstep;
    S.a_ready(cur);
    PG8_STAGE(PG8_SB(0, 0), cB, voffB); PG8_STAGE(PG8_SA(0, 0), cA, voffA); PG8_STAGE(PG8_SB(0, 1), cB + hstep, voffB); PG8_STAGE(PG8_SA(0, 1), cA + hstep, voffA);
    if (wr == 1) PG8_BAR;
    PG8_WAIT_V(4); PG8_BAR;
    PG8_STAGE(PG8_SB(1, 0), cB + kstep, voffB); PG8_STAGE(PG8_SA(1, 0), cA + kstep, voffA); PG8_STAGE(PG8_SB(1, 1), cB + hstep + kstep, voffB);
    PG8_WAIT_V(6); PG8_BAR;
    for (;;) {
        const bool has_next = S.next(ui + 1, nxt);
        const char* nA = has_next ? (const char*)g.A + (size_t)nxt.pm * tstep : cA; const char* nB = has_next ? (const char*)g.Bt + (size_t)nxt.pn * tstep : cB;
        for (int t = 0; t < nt; t += 2) {
            const bool last = (t == nt - 2);
            const char* a1 = cA + (size_t)(t + 1) * kstep;
            const char* a2 = last ? nA : cA + (size_t)(t + 2) * kstep; const char* b2 = last ? nB : cB + (size_t)(t + 2) * kstep;
            const char* a3 = a2 + kstep; const char* b3 = b2 + kstep;
            if (last && has_next) S.a_ready(nxt);
            PG8_LDB(B0, 0, 0); PG8_SCHED; PG8_LDA(At, 0, 0); PG8_STAGE(PG8_SA(1, 1), a1 + hstep, voffA);
            PG8_WAIT_L(8); PG8_BAR; PG8_WAIT_L(0); PG8_MMA(0, 0, At, B0); PG8_BAR; PG8_SCHED;
            PG8_LDB(B1, 0, 1); PG8_STAGE(PG8_SB(0, 0), b2, voffB);
            PG8_BAR; PG8_WAIT_L(0); PG8_MMA(0, 1, At, B1); PG8_BAR;
            PG8_LDA(At, 0, 1); PG8_STAGE(PG8_SA(0, 0), a2, voffA);
            PG8_BAR; PG8_WAIT_L(0); PG8_MMA(1, 0, At, B0); PG8_BAR; PG8_SCHED;
            PG8_STAGE(PG8_SB(0, 1), b2 + hstep, voffB);
            PG8_WAIT_V(6); PG8_BAR; PG8_MMA(1, 1, At, B1); PG8_BAR;
            PG8_LDB(B0, 1, 0); PG8_SCHED; PG8_LDA(At, 1, 0); PG8_STAGE(PG8_SA(0, 1), a2 + hstep, voffA);
            PG8_WAIT_L(8); PG8_BAR; PG8_WAIT_L(0); PG8_MMA(0, 0, At, B0); PG8_BAR; PG8_SCHED;
            PG8_LDB(B1, 1, 1); PG8_STAGE(PG8_SB(1, 0), b3, voffB);
            PG8_BAR; PG8_WAIT_L(0); PG8_MMA(0, 1, At, B1); PG8_BAR;
            PG8_LDA(At, 1, 1); PG8_STAGE(PG8_SA(1, 0), a3, voffA);
            PG8_BAR; PG8_WAIT_L(0); PG8_MMA(1, 0, At, B0); PG8_BAR; PG8_SCHED;
            PG8_STAGE(PG8_SB(1, 1), b3 + hstep, voffB);
            PG8_WAIT_V(6); PG8_BAR; PG8_MMA(1, 1, At, B1); PG8_BAR;
        }
        E(acc, cur, wr, wc, fr, fq); S.done(cur);
        if (!has_next) break;
#pragma unroll
        for (int a = 0; a < 2; ++a)
#pragma unroll
            for (int b = 0; b < 2; ++b)
#pragma unroll
                for (int m = 0; m < 4; ++m)
#pragma unroll
                    for (int n = 0; n < 2; ++n) acc[a][b][m][n] = (f32x4){0.f, 0.f, 0.f, 0.f};
        cur = nxt; cA = nA; cB = nB; ++ui;
    }
    PG8_WAIT_V(0);
    if (wr == 0) PG8_BAR;
    PG8_BAR;
#undef PG8_SA
#undef PG8_SB
#undef PG8_STAGE
#undef PG8_LDA
#undef PG8_LDB
#undef PG8_MMA
#undef PG8_WAIT_V
#undef PG8_WAIT_L
#undef PG8_BAR
#undef PG8_SCHED
}
}

struct Params {
    const float* x; const float* c; const float* ada_w; const float* ada_b; const float* norm_mix_w; const float* w_in; const float* conv_w; const float* conv_b;
    const float* lru_wa; const float* lru_ba; const float* lru_wx; const float* lru_bx; const float* lru_lambda; const float* norm_lru_w; const float* hgrn_lb;
    const float* norm_hgrn_w; const float* w_out; const float* norm_ffn_w; const float* rg_w; const float* rg_b; const float* re_w; const float* re_b;
    const float* e_gate; const float* e_up; const float* e_down; const float* final_w;
    float* out; unsigned char* ws;
    long long ph_lo, ph_hi;
};

typedef const __attribute__((address_space(4))) Params* KParams;
__device__ __forceinline__ KParams get_params() { KParams q = (KParams)__builtin_amdgcn_kernarg_segment_ptr(); asm volatile("" : "+s"(q)); return q; }

struct Ctx {
    LAS unsigned char* lds; int tid, lane, wave, G, gwave, nwaves;
};

__device__ __forceinline__ void cvt_tile(const Ctx& F, const float* src, int ldn, bf16_t* dst, int ldd) {
    LAS unsigned char* slab = F.lds + F.wave * 8704;
    const int q = F.lane >> 4, n4 = (F.lane & 15) * 4;
    f32x4 v[16];
#pragma unroll
    for (int i = 0; i < 16; ++i) { const int k = 8 * (i >> 1) + 2 * q + (i & 1); v[i] = *(const f32x4*)(src + (size_t)k * ldn + n4); }
#pragma unroll
    for (int p = 0; p < 8; ++p) { const int k0 = 8 * p + 2 * q;
#pragma unroll
        for (int j = 0; j < 4; ++j) *(LAS unsigned*)(slab + (n4 + j) * 136 + k0 * 2) = cvt_pk_bf16(v[2 * p][j], v[2 * p + 1][j]); }
#pragma unroll
    for (int i = 0; i < 16; ++i) { const int n = 4 * i + q, ch = F.lane & 15;
        const u32x2 w = *(const LAS u32x2*)(slab + n * 136 + ch * 8);
        *(u32x2*)(dst + (size_t)n * ldd + ch * 4) = w; }
}

__device__ __forceinline__ void phase_prologue(KParams p, const Ctx& F) {
    bf16_t* WinT = (bf16_t*)(p->ws + WS_WIN); bf16_t* WoutT = (bf16_t*)(p->ws + WS_WOUT); bf16_t* WguT = (bf16_t*)(p->ws + WS_WGU); bf16_t* WdT = (bf16_t*)(p->ws + WS_WD);
    constexpr int T_IN = 16 * 56, T_OUT = 16 * 16, T_E = NEXP * 128, T_L = T_IN + T_OUT + 3 * T_E;
    for (int task = F.gwave; task < DEPTH * T_L; task += F.nwaves) {
        const int l = task / T_L; int r = task % T_L;
        if (r < T_IN) { const int kt = r / 56, nt = r % 56;
            cvt_tile(F, p->w_in + (size_t)l * DM * PROJ + (size_t)kt * 64 * PROJ + nt * 64, PROJ, WinT + ((size_t)l * PROJ + nt * 64) * DM + kt * 64, DM);
        } else if (r < T_IN + T_OUT) { r -= T_IN; const int kt = r / 16, nt = r % 16;
            cvt_tile(F, p->w_out + (size_t)l * DM * DM + (size_t)kt * 64 * DM + nt * 64, DM, WoutT + ((size_t)l * DM + nt * 64) * DM + kt * 64, DM);
        } else if (r < T_IN + T_OUT + 2 * T_E) { r -= T_IN + T_OUT; const int up = r / T_E; r %= T_E; const int e = r / 128, rr = r % 128, kt = rr / 8, nt = rr % 8, n0 = nt * 64;
            const float* src = (up ? p->e_up : p->e_gate) + ((size_t)(l * NEXP + e) * DM + kt * 64) * DEXP + n0;
            const size_t drow = (size_t)(l * NEXP + e) * 1024 + 256 * (n0 >> 7) + 128 * up + (n0 & 127);
            cvt_tile(F, src, DEXP, WguT + drow * DM + kt * 64, DM);
        } else { r -= T_IN + T_OUT + 2 * T_E; const int e = r / 128, rr = r % 128, kt = rr / 16, nt = rr % 16;
            const float* src = p->e_down + ((size_t)(l * NEXP + e) * DEXP + kt * 64) * DM + nt * 64;
            cvt_tile(F, src, DM, WdT + ((size_t)(l * NEXP + e) * 1024 + nt * 64) * DEXP + kt * 64, DEXP);
        }
    }
    {
        bf16_t* wf = (bf16_t*)(p->ws + WS_LRUW);
        for (int it = blockIdx.x * NTHREADS + F.tid; it < 32768; it += F.G * NTHREADS) {
            const int ln = it & 63, ks = (it >> 6) & 3, ct = (it >> 8) & 1, h = (it >> 9) & 7, m = (it >> 12) & 1, ld = it >> 13;
            const float* src = (m ? p->lru_wx : p->lru_wa) + ((size_t)ld * 8 + h) * 4096 + (size_t)(ks * 16 + 8 * (ln >> 5)) * 64 + ct * 32 + (ln & 31);
            u32x4 o; o[0] = cvt_pk_bf16(src[0], src[64]); o[1] = cvt_pk_bf16(src[128], src[192]); o[2] = cvt_pk_bf16(src[256], src[320]); o[3] = cvt_pk_bf16(src[384], src[448]);
            *(u32x4*)(wf + (size_t)it * 8) = o; }
    }
    {
        bf16_t* rwh = (bf16_t*)(p->ws + WS_RWHI); bf16_t* rwl = (bf16_t*)(p->ws + WS_RWLO);
        for (int it = blockIdx.x * NTHREADS + F.tid; it < DEPTH * 64 * DM; it += F.G * NTHREADS) {
            const int k = it & (DM - 1), n = (it >> 10) & 63, l = it >> 16;
            const float w = n < NEXP ? p->re_w[((size_t)l * DM + k) * NEXP + n] : (n < NEXP + NGRP ? p->rg_w[((size_t)l * DM + k) * NGRP + (n - NEXP)] : 0.f);
            const bf16_t hi = f2bf(w); rwh[it] = hi; rwl[it] = f2bf(w - bf2f(hi)); }
    }
    __syncthreads();
    LAS float* sc = (LAS float*)F.lds;
    LAS float* red = (LAS float*)(F.lds + 16384);
    for (int i = F.tid; i < NB * DM; i += NTHREADS) sc[i] = siluf_(p->c[i]);
    __syncthreads();
    float* mod = (float*)(p->ws + WS_MOD);
    for (int t = blockIdx.x; t < DEPTH * 96; t += F.G) {
        const int l = t / 96, n0 = (t % 96) * 64;
        const float* w = p->ada_w + (size_t)l * DM * 6 * DM + n0 + F.lane;
        float a0 = 0.f, a1 = 0.f, a2 = 0.f, a3 = 0.f;
        const int k0 = F.wave * 128;
#pragma unroll 8
        for (int k = k0; k < k0 + 128; ++k) { const float wv = w[(size_t)k * 6 * DM]; a0 += sc[k] * wv; a1 += sc[DM + k] * wv; a2 += sc[2 * DM + k] * wv; a3 += sc[3 * DM + k] * wv; }
        red[(F.wave * 4 + 0) * 64 + F.lane] = a0; red[(F.wave * 4 + 1) * 64 + F.lane] = a1; red[(F.wave * 4 + 2) * 64 + F.lane] = a2; red[(F.wave * 4 + 3) * 64 + F.lane] = a3;
        __syncthreads();
        if (F.tid < 256) { const int b = F.tid >> 6, ln = F.tid & 63; float s = p->ada_b[l * 6 * DM + n0 + ln];
#pragma unroll
            for (int w8 = 0; w8 < 8; ++w8) s += red[(w8 * 4 + b) * 64 + ln];
            mod[((size_t)l * NB + b) * 6 * DM + n0 + ln] = s; }
        __syncthreads();
    }
}

__device__ __forceinline__ void phase_norm1(KParams p, const Ctx& F, int l, const float* xin) {
    const float* mod = (const float*)(p->ws + WS_MOD) + (size_t)l * NB * 6 * DM;
    bf16_t* h = (bf16_t*)(p->ws + WS_R2);
    const float* nw = p->norm_mix_w + l * DM;
    for (int row = F.gwave; row < MTOK; row += F.nwaves) {
        const int b = row >> 12; const float* xr = xin + (size_t)row * DM;
        f32x4 v[4]; float ss = 0.f;
#pragma unroll
        for (int i = 0; i < 4; ++i) { v[i] = *(const f32x4*)(xr + F.lane * 4 + 256 * i); ss += v[i][0] * v[i][0] + v[i][1] * v[i][1] + v[i][2] * v[i][2] + v[i][3] * v[i][3]; }
        ss = wave_sum(ss); const float rstd = rsqrtf(ss * (1.0f / DM) + NORM_EPS);
#pragma unroll
        for (int i = 0; i < 4; ++i) { const int col = F.lane * 4 + 256 * i;
            const f32x4 w4 = *(const f32x4*)(nw + col), sh = *(const f32x4*)(mod + (size_t)b * 6 * DM + col), s1 = *(const f32x4*)(mod + (size_t)b * 6 * DM + DM + col);
            f32x4 o = v[i] * rstd * w4 * (s1 + 1.0f) + sh;
            u32x2 pk; pk[0] = cvt_pk_bf16(o[0], o[1]); pk[1] = cvt_pk_bf16(o[2], o[3]);
            *(u32x2*)(h + (size_t)row * DM + col) = pk; }
    }
}

__device__ __forceinline__ void phase_conv(KParams p, const Ctx& F, int l) {
    const bf16_t* proj = (const bf16_t*)(p->ws + WS_R1); float* xc = (float*)(p->ws + WS_XA);
    const float* cw = p->conv_w + l * 4 * DLRU; const float* cb = p->conv_b + l * DLRU;
    for (int it = blockIdx.x * NTHREADS + F.tid; it < MTOK * (DLRU / 4); it += F.G * NTHREADS) {
        const int row = it >> 7, c4 = (it & 127) * 4, t = row & (SEQ - 1);
        f32x4 acc = *(const f32x4*)(cb + c4);
#pragma unroll
        for (int k = 0; k < 4; ++k) { const int tt = t + k - 2;
            if (tt >= 0 && tt < SEQ) { const u32x2 pv = *(const u32x2*)(proj + (size_t)(row + k - 2) * PROJ + c4); const f32x4 w4 = *(const f32x4*)(cw + k * DLRU + c4);
                acc[0] += w4[0] * __uint_as_float(pv[0] << 16); acc[1] += w4[1] * __uint_as_float(pv[0] & 0xFFFF0000u);
                acc[2] += w4[2] * __uint_as_float(pv[1] << 16); acc[3] += w4[3] * __uint_as_float(pv[1] & 0xFFFF0000u); } }
        *(f32x4*)(xc + (size_t)row * DLRU + c4) = acc;
    }
}

__device__ __forceinline__ void lru_seq(KParams p, const Ctx& F, int l, int b, int h) {
    const bf16_t* proj = (const bf16_t*)(p->ws + WS_R1); const float* xc = (const float*)(p->ws + WS_XA); float* tmpz = (float*)(p->ws + WS_XA) + (size_t)MTOK * DLRU;
    const int c = h * 64 + F.lane;
    for (int d = 0; d < 2; ++d) {
        float wa_r[64], wx_r[64];
        const float* wa = p->lru_wa + ((size_t)(l * 2 + d) * 8 + h) * 4096 + F.lane; const float* wx = p->lru_wx + ((size_t)(l * 2 + d) * 8 + h) * 4096 + F.lane;
#pragma unroll
        for (int i = 0; i < 64; ++i) { wa_r[i] = wa[i * 64]; wx_r[i] = wx[i * 64]; }
        const float ba = p->lru_ba[(l * 2 + d) * DLRU + c], bx = p->lru_bx[(l * 2 + d) * DLRU + c], lam = p->lru_lambda[(l * 2 + d) * DLRU + c];
        const float cc = -8.0f * log1pf(expf(-lam));
        float hst = 0.f;
        for (int step = 0; step < SEQ; ++step) {
            const int t = d == 0 ? step : SEQ - 1 - step; const size_t row = (size_t)b * SEQ + t;
            const float xv = xc[row * DLRU + c];
            float ra = ba, rx = bx;
#pragma unroll
            for (int i = 0; i < 64; ++i) { const float xi = rdlane(xv, i); ra += xi * wa_r[i]; rx += xi * wx_r[i]; }
            const float r = sigmoidf_(ra), ig = sigmoidf_(rx), la = cc * r, a = expf(la);
            const float u = sqrtf(fmaxf(-expm1f(2.0f * la), 0.f)) * (ig * xv);
            hst = a * hst + u;
            if (d == 0) tmpz[row * DLRU + c] = hst;
            else { const float yv = bf2f(proj[row * PROJ + DLRU + c]); tmpz[row * DLRU + c] = (tmpz[row * DLRU + c] + hst) * gelu_tanh(yv); }
        }
    }
}

__device__ __forceinline__ float hgrn_lb(KParams p, int l, int ch) {
    if (l == 0) return 0.f;
    const float a = p->hgrn_lb[ch], b = p->hgrn_lb[DHG + ch]; const float m = fmaxf(a, b); const float ea = expf(a - m), eb = expf(b - m);
    return eb / (ea + eb);
}

__device__ __forceinline__ void hgrn_seq(KParams p, const Ctx& F, int l, int b, int h) {
    const bf16_t* proj = (const bf16_t*)(p->ws + WS_R1); float* tmpo = (float*)(p->ws + WS_R2); bf16_t* merged = (bf16_t*)(p->ws + WS_R3);
    const int ch = h * 64 + F.lane;
    const float lbv = hgrn_lb(p, l, ch), nw = p->norm_hgrn_w[l * DHG + ch];
    for (int d = 0; d < 2; ++d) {
        float S[64];
#pragma unroll
        for (int i = 0; i < 64; ++i) S[i] = 0.f;
        const int fcol = (d == 0 ? 1536 : 2048) + ch;
        for (int step = 0; step < SEQ; ++step) {
            const int t = d == 0 ? step : SEQ - 1 - step; const size_t row = (size_t)b * SEQ + t; const bf16_t* pr = proj + row * PROJ;
            const float fl = bf2f(pr[fcol]), qv = bf2f(pr[1024 + ch]), vv = bf2f(pr[2560 + ch]);
            const float f = lbv + (1.0f - lbv) * sigmoidf_(fl), k = 1.0f - f;
            float o = 0.f;
#pragma unroll
            for (int i = 0; i < 64; ++i) { const float fd = rdlane(f, i), kd = rdlane(k, i), qd = rdlane(qv, i); S[i] = fd * S[i] + kd * vv; o += qd * S[i]; }
            if (d == 0) tmpo[row * DHG + ch] = o;
            else { const float ot = tmpo[row * DHG + ch] + o; const float ms = wave_sum(ot * ot) * (1.0f / 64.0f);
                const float gv = bf2f(pr[3072 + ch]); const float y = ot * rsqrtf(ms + NORM_EPS) * nw * siluf_(gv);
                merged[row * DM + DLRU + ch] = f2bf(y); }
        }
    }
}

__device__ __forceinline__ void phase_mixer_seq(KParams p, const Ctx& F, int l) {
#ifdef USE_LRU_SEQ
    if (F.wave == 0 && (int)blockIdx.x < 64) {
        const int id = blockIdx.x;
        if (id < 32) lru_seq(p, F, l, id >> 3, id & 7); else hgrn_seq(p, F, l, (id - 32) >> 3, (id - 32) & 7);
    }
#else
    if (F.wave == 0 && (int)blockIdx.x < 32) hgrn_seq(p, F, l, (int)blockIdx.x >> 3, (int)blockIdx.x & 7);
#endif
}

__device__ __forceinline__ void phase_lru_norm(KParams p, const Ctx& F, int l) {
    const float* tmpz = (const float*)(p->ws + WS_XA) + (size_t)MTOK * DLRU; bf16_t* merged = (bf16_t*)(p->ws + WS_R3); const float* nw = p->norm_lru_w + l * DLRU;
    for (int row = F.gwave; row < MTOK; row += F.nwaves) {
        f32x4 v[2]; float ss = 0.f;
#pragma unroll
        for (int i = 0; i < 2; ++i) { v[i] = *(const f32x4*)(tmpz + (size_t)row * DLRU + F.lane * 4 + 256 * i); ss += v[i][0] * v[i][0] + v[i][1] * v[i][1] + v[i][2] * v[i][2] + v[i][3] * v[i][3]; }
        ss = wave_sum(ss); const float rstd = rsqrtf(ss * (1.0f / DLRU) + NORM_EPS);
#pragma unroll
        for (int i = 0; i < 2; ++i) { const int col = F.lane * 4 + 256 * i; const f32x4 w4 = *(const f32x4*)(nw + col); const f32x4 o = v[i] * rstd * w4;
            u32x2 pk; pk[0] = cvt_pk_bf16(o[0], o[1]); pk[1] = cvt_pk_bf16(o[2], o[3]); *(u32x2*)(merged + (size_t)row * DM + col) = pk; }
    }
}

typedef float f32x16 __attribute__((ext_vector_type(16)));
#define MFMA32(a, b, c) __builtin_amdgcn_mfma_f32_32x32x16_bf16((a), (b), (c), 0, 0, 0)
constexpr int XCP = 1040;
template <bool PASS2>
__device__ __forceinline__ void phase_lru(KParams p, const Ctx& F, int l) {
    const bf16_t* proj = (const bf16_t*)(p->ws + WS_R1);
    float* sumA = (float*)(p->ws + WS_SUMA); float* sumH = (float*)(p->ws + WS_SUMH);
    const bf16x8* wf = (const bf16x8*)(p->ws + WS_LRUW);
    LAS unsigned char* xcb = F.lds; LAS unsigned char* zb = F.lds + 64 * XCP; LAS float* cin = (LAS float*)(F.lds + 128 * XCP);
    const float* cw = p->conv_w + l * 4 * DLRU; const float* cb = p->conv_b + l * DLRU;
    for (int task = blockIdx.x; task < NB * 64; task += F.G) {
        const int b = task >> 6, j = task & 63; const int row0 = b * SEQ + j * 64;
        for (int it = F.tid; it < 64 * 64; it += NTHREADS) {
            const int t = it >> 6, c8 = (it & 63) * 8, tg = j * 64 + t;
            f32x4 a0 = *(const f32x4*)(cb + c8), a1 = *(const f32x4*)(cb + c8 + 4);
#pragma unroll
            for (int k = 0; k < 4; ++k) { const int tt = tg + k - 2;
                if (tt >= 0 && tt < SEQ) { const u32x4 pv = *(const u32x4*)(proj + (size_t)(b * SEQ + tt) * PROJ + c8);
                    const f32x4 w0 = *(const f32x4*)(cw + k * DLRU + c8), w1 = *(const f32x4*)(cw + k * DLRU + c8 + 4);
                    a0[0] += w0[0] * __uint_as_float(pv[0] << 16); a0[1] += w0[1] * __uint_as_float(pv[0] & 0xFFFF0000u);
                    a0[2] += w0[2] * __uint_as_float(pv[1] << 16); a0[3] += w0[3] * __uint_as_float(pv[1] & 0xFFFF0000u);
                    a1[0] += w1[0] * __uint_as_float(pv[2] << 16); a1[1] += w1[1] * __uint_as_float(pv[2] & 0xFFFF0000u);
                    a1[2] += w1[2] * __uint_as_float(pv[3] << 16); a1[3] += w1[3] * __uint_as_float(pv[3] & 0xFFFF0000u); } }
            u32x4 o; o[0] = cvt_pk_bf16(a0[0], a0[1]); o[1] = cvt_pk_bf16(a0[2], a0[3]); o[2] = cvt_pk_bf16(a1[0], a1[1]); o[3] = cvt_pk_bf16(a1[2], a1[3]);
            *(LAS u32x4*)(xcb + t * XCP + c8 * 2) = o;
            if (PASS2) *(LAS u32x4*)(zb + t * XCP + c8 * 2) = *(const u32x4*)(proj + (size_t)(row0 + t) * PROJ + DLRU + c8);
        }
        if (PASS2) {
            const int c = F.tid;
            const float* fa = sumA + (size_t)(0 * NB + b) * 64 * DLRU + c; const float* fh = sumH + (size_t)(0 * NB + b) * 64 * DLRU + c;
            const float* ra = sumA + (size_t)(1 * NB + b) * 64 * DLRU + c; const float* rh = sumH + (size_t)(1 * NB + b) * 64 * DLRU + c;
            float s = 0.f;
#pragma unroll 1
            for (int kb = 0; kb < 64; kb += 16) {
                float a16[16], h16[16];
#pragma unroll
                for (int q = 0; q < 16; ++q) { const int k = kb + q; const bool on = k < j; a16[q] = on ? fa[k * DLRU] : 1.f; h16[q] = on ? fh[k * DLRU] : 0.f; }
#pragma unroll
                for (int q = 0; q < 16; ++q) s = a16[q] * s + h16[q];
            }
            cin[c] = s; s = 0.f;
#pragma unroll 1
            for (int kb = 0; kb < 64; kb += 16) {
                float a16[16], h16[16];
#pragma unroll
                for (int q = 0; q < 16; ++q) { const int k = 63 - kb - q; const bool on = k > j; a16[q] = on ? ra[k * DLRU] : 1.f; h16[q] = on ? rh[k * DLRU] : 0.f; }
#pragma unroll
                for (int q = 0; q < 16; ++q) s = a16[q] * s + h16[q];
            }
            cin[DLRU + c] = s;
        }
        __syncthreads();
        {
            const int h = F.wave, r = F.lane & 31, hh = F.lane >> 5;
            const LAS unsigned char* abase = xcb + (32 * ((r >> 2) & 1) + 4 * (r >> 3) + (r & 3)) * XCP + (h * 64 + 8 * hh) * 2;
#pragma unroll 1
            for (int ct = 0; ct < 2; ++ct) {
                const int c = h * 64 + ct * 32 + r;
                float hf[32];
#pragma unroll
                for (int d = 0; d < 2; ++d) {
                    const bf16x8* wba = wf + ((((size_t)(l * 2 + d) * 2 + 0) * 8 + h) * 2 + ct) * 4 * 64 + F.lane;
                    const bf16x8* wbx = wf + ((((size_t)(l * 2 + d) * 2 + 1) * 8 + h) * 2 + ct) * 4 * 64 + F.lane;
                    bf16x8 Ba[4], Bx[4];
#pragma unroll
                    for (int ks = 0; ks < 4; ++ks) { Ba[ks] = wba[ks * 64]; Bx[ks] = wbx[ks * 64]; }
                    const float ba = p->lru_ba[(l * 2 + d) * DLRU + c], bx = p->lru_bx[(l * 2 + d) * DLRU + c];
                    const float cc = -8.0f * log1pf(__expf(-p->lru_lambda[(l * 2 + d) * DLRU + c]));
                    float av[32], uv[32];
#pragma unroll
                    for (int rt = 0; rt < 2; ++rt) {
                        f32x16 za, zx;
#pragma unroll
                        for (int e = 0; e < 16; ++e) { za[e] = 0.f; zx[e] = 0.f; }
#pragma unroll
                        for (int ks = 0; ks < 4; ++ks) { const bf16x8 Af = *(const LAS bf16x8*)(abase + 16 * rt * XCP + ks * 32);
                            za = MFMA32(Af, Ba[ks], za); zx = MFMA32(Af, Bx[ks], zx); }
#pragma unroll
                        for (int reg = 0; reg < 16; ++reg) { const int i = 16 * rt + reg;
                            const float xcv = bf2f(*(const LAS bf16_t*)(xcb + (32 * hh + i) * XCP + c * 2));
                            const float rg = sigmoidf_(za[reg] + ba), ig = sigmoidf_(zx[reg] + bx), la = cc * rg;
                            av[i] = __expf(la); uv[i] = sqrtf(fmaxf(1.0f - __expf(2.0f * la), 0.f)) * (ig * xcv); }
                    }
                    if (d == 0) {
#pragma unroll
                        for (int i = 1; i < 32; ++i) { uv[i] = av[i] * uv[i - 1] + uv[i]; av[i] = av[i] * av[i - 1]; }
                    } else {
#pragma unroll
                        for (int i = 30; i >= 0; --i) { uv[i] = av[i] * uv[i + 1] + uv[i]; av[i] = av[i] * av[i + 1]; }
                    }
                    const float myP = (d == 0) ? av[31] : av[0], myH = (d == 0) ? uv[31] : uv[0];
                    const float oP = __shfl_xor(myP, 32, 64), oH = __shfl_xor(myH, 32, 64);
                    if (!PASS2) {
                        if (hh == 0) { const size_t idx = ((size_t)(d * NB + b) * 64 + j) * DLRU + c;
                            sumA[idx] = myP * oP;
                            sumH[idx] = (d == 0) ? (oH + oP * myH) : (myH + myP * oH); }
                    } else {
                        const float cinv = cin[d * DLRU + c];
                        const bool first = (d == 0) ? (hh == 0) : (hh == 1);
                        const float cy = first ? cinv : (oH + oP * cinv);
                        if (d == 0) {
#pragma unroll
                            for (int i = 0; i < 32; ++i) hf[i] = uv[i] + av[i] * cy;
                        } else {
#pragma unroll
                            for (int i = 0; i < 32; ++i) { const float hs = hf[i] + uv[i] + av[i] * cy;
                                LAS bf16_t* zp = (LAS bf16_t*)(zb + (32 * hh + i) * XCP + c * 2);
                                *zp = f2bf(hs * gelu_tanh(bf2f(*zp))); }
                        }
                    }
                }
            }
        }
        if (PASS2) {
            __syncthreads();
            bf16_t* merged = (bf16_t*)(p->ws + WS_R3); const float* nw = p->norm_lru_w + l * DLRU;
            const f32x4 w0 = *(const f32x4*)(nw + F.lane * 8), w1 = *(const f32x4*)(nw + F.lane * 8 + 4);
#pragma unroll
            for (int q = 0; q < 8; ++q) { const int t = F.wave * 8 + q;
                const u32x4 zv = *(const LAS u32x4*)(zb + t * XCP + F.lane * 16);
                float z[8];
#pragma unroll
                for (int e = 0; e < 4; ++e) { z[2 * e] = __uint_as_float(zv[e] << 16); z[2 * e + 1] = __uint_as_float(zv[e] & 0xFFFF0000u); }
                float ss = 0.f;
#pragma unroll
                for (int e = 0; e < 8; ++e) ss += z[e] * z[e];
                ss = wave_sum(ss); const float rstd = rsqrtf(ss * (1.0f / DLRU) + NORM_EPS);
                u32x4 o; o[0] = cvt_pk_bf16(z[0] * rstd * w0[0], z[1] * rstd * w0[1]); o[1] = cvt_pk_bf16(z[2] * rstd * w0[2], z[3] * rstd * w0[3]);
                o[2] = cvt_pk_bf16(z[4] * rstd * w1[0], z[5] * rstd * w1[1]); o[3] = cvt_pk_bf16(z[6] * rstd * w1[2], z[7] * rstd * w1[3]);
                *(u32x4*)(merged + (size_t)(row0 + t) * DM + F.lane * 8) = o; }
        }
        __syncthreads();
    }
}

typedef __bf16 bf16v8 __attribute__((ext_vector_type(8)));
typedef float f32x8 __attribute__((ext_vector_type(8)));
__device__ __forceinline__ bf16x8 pk8(float a0, float a1, float a2, float a3, float a4, float a5, float a6, float a7) {
    const f32x8 w = {a0, a1, a2, a3, a4, a5, a6, a7}; return __builtin_bit_cast(bf16x8, __builtin_convertvector(w, bf16v8)); }
#define PACK_STEP(x, s) pk8((x)[8 * (s)], (x)[8 * (s) + 1], (x)[8 * (s) + 2], (x)[8 * (s) + 3], (x)[8 * (s) + 4], (x)[8 * (s) + 5], (x)[8 * (s) + 6], (x)[8 * (s) + 7])
__device__ __forceinline__ int crow(int reg, int hh) { return (reg & 3) + 8 * (reg >> 2) + 4 * hh; }
template <int KIND> __device__ __forceinline__ bf16x8 mk_const(int ks, int hh, int r) {
    bf16x8 v;
#pragma unroll
    for (int j = 0; j < 8; ++j) { const int kn = 16 * ks + 8 * hh + j, kp = 16 * ks + 8 * (j >> 2) + 4 * hh + (j & 3);
        const bool on = KIND == 0 ? (kn <= r) : KIND == 1 ? (kn > r) : KIND == 2 ? (kn == r) : (kp == r);
        v[j] = on ? (short)0x3F80 : (short)0; }
    return v;
}
constexpr int HG_TASKS = NB * 8 * 2 * 32;
constexpr int HG_WLDS = 12288;
template <bool PASS2>
__device__ __forceinline__ void phase_hgrn(KParams p, const Ctx& F, int l) {
    const bf16_t* proj = (const bf16_t*)(p->ws + WS_R1);
    float* Usum = (float*)(p->ws + WS_R2); float* Dsum = Usum + (size_t)HG_TASKS * 4096;
    float* osc = (float*)(p->ws + WS_XA);
    int lz = F.lane; asm volatile("" : "+v"(lz));
    const int r = lz & 31, hh = lz >> 5;
    LAS unsigned char* wl = F.lds + F.wave * HG_WLDS;
    const LAS unsigned char* rdA = wl + (8 * hh) * 128 + r * 2;
    const LAS unsigned char* rdV = wl + 8192 + (4 * hh) * 128 + r * 2;
    for (int wg = blockIdx.x; wg < 256; wg += F.G) {
        const int b = wg >> 6, h = (wg >> 3) & 7, g = wg & 7;
        const int dir = F.wave & 1, tr = g * 4 + (F.wave >> 1);
        const int task = ((b * 8 + h) * 2 + dir) * 32 + tr;
        const int r0 = b * SEQ + tr * 128;
        const int fcol = (dir == 0 ? 1536 : 2048) + h * 64;
        const float lb0 = hgrn_lb(p, l, h * 64 + r), lb1 = hgrn_lb(p, l, h * 64 + 32 + r);
        f32x16 S[2][2];
#pragma unroll
        for (int a = 0; a < 2; ++a) {
#pragma unroll
            for (int e = 0; e < 16; ++e) { S[a][0][e] = 0.f; S[a][1][e] = 0.f; } }
        if (PASS2) {
#pragma unroll
            for (int a = 0; a < 2; ++a)
#pragma unroll
                for (int c = 0; c < 2; ++c)
#pragma unroll
                    for (int e = 0; e < 16; ++e) S[a][c][e] = *(const float*)((const char*)Usum + ((unsigned)(task * 4096 + lz) * 4u + (unsigned)(((a * 2 + c) * 16 + e) * 256)));
        }
#pragma unroll 1
        for (int ci = 0; ci < 4; ++ci) {
            const int rbase = dir == 0 ? r0 + 32 * ci : r0 + 127 - 32 * ci, sg = dir == 0 ? 1 : -1;
            {
                int lq = lz; asm volatile("" : "+v"(lq));
                const int lrow = lq >> 3, lcol = (lq & 7) * 8;
#pragma unroll
                for (int i = 0; i < 4; ++i) { const int tau = 8 * i + lrow; const char* pr = (const char*)proj + (unsigned)(((rbase + sg * tau) * PROJ + h * 64 + lcol) * 2);
                    const u32x4 vf = *(const u32x4*)(pr + (fcol - h * 64) * 2), vv = *(const u32x4*)(pr + 2560 * 2);
                    *(LAS u32x4*)(wl + tau * 128 + lcol * 2) = vf; *(LAS u32x4*)(wl + 8192 + tau * 128 + lcol * 2) = vv;
                    if (PASS2) { const u32x4 vq = *(const u32x4*)(pr + 1024 * 2); *(LAS u32x4*)(wl + 4096 + tau * 128 + lcol * 2) = vq; } }
            }
            __builtin_amdgcn_sched_barrier(0);
#define LOAD_VP(c, ks, dst) do { _Pragma("unroll") for (int j = 0; j < 8; ++j) (dst)[j] = (short)*(const LAS bf16_t*)(rdV + (16 * (ks) + 8 * (j >> 2) + (j & 3)) * 128 + 64 * (c)); } while (0)
            f32x16 O[2], sc;
            if (PASS2) {
#pragma unroll
                for (int e = 0; e < 16; ++e) { O[0][e] = 0.f; O[1][e] = 0.f; sc[e] = 0.f; } }
#pragma unroll
            for (int a = 0; a < 2; ++a) {
                const float lbv = a == 0 ? lb0 : lb1;
                bf16x8 Ahi[2], Alo[2];
                f32x16 kT, qT;
#pragma unroll
                for (int e = 0; e < 16; ++e) { kT[e] = 0.f; qT[e] = 0.f; }
#pragma unroll
                for (int ks = 0; ks < 2; ++ks) {
                    float lf[8], kk[8];
#pragma unroll
                    for (int j = 0; j < 8; ++j) { const float fl = bf2f(*(const LAS bf16_t*)(rdA + (16 * ks + j) * 128 + 64 * a));
                        const float f = lbv + (1.0f - lbv) * sigmoidf_(fl);
                        lf[j] = fmaxf(__logf(f), -80.0f); kk[j] = 1.0f - f; }
                    Ahi[ks] = pk8(lf[0], lf[1], lf[2], lf[3], lf[4], lf[5], lf[6], lf[7]);
                    float lo[8];
#pragma unroll
                    for (int j = 0; j < 8; ++j) lo[j] = lf[j] - bf2f((bf16_t)Ahi[ks][j]);
                    Alo[ks] = pk8(lo[0], lo[1], lo[2], lo[3], lo[4], lo[5], lo[6], lo[7]);
                    const bf16x8 Ak = pk8(kk[0], kk[1], kk[2], kk[3], kk[4], kk[5], kk[6], kk[7]);
                    const bf16x8 Id = mk_const<2>(ks, hh, r);
                    kT = MFMA32(Ak, Id, kT);
                    if (PASS2) { bf16x8 Aq;
#pragma unroll
                        for (int j = 0; j < 8; ++j) Aq[j] = (short)*(const LAS bf16_t*)(rdA + 4096 + (16 * ks + j) * 128 + 64 * a);
                        qT = MFMA32(Aq, Id, qT); }
                }
                __builtin_amdgcn_sched_barrier(0);
                if (PASS2) {
                    f32x16 bT;
#pragma unroll
                    for (int e = 0; e < 16; ++e) bT[e] = 0.f;
#pragma unroll
                    for (int ks = 0; ks < 2; ++ks) { const bf16x8 Mle = mk_const<0>(ks, hh, r); bT = MFMA32(Ahi[ks], Mle, bT); bT = MFMA32(Alo[ks], Mle, bT); }
#pragma unroll
                    for (int e = 0; e < 16; ++e) bT[e] = qT[e] * __expf(bT[e]);
#pragma unroll
                    for (int s2 = 0; s2 < 2; ++s2) { const bf16x8 Qtp = PACK_STEP(bT, s2);
#pragma unroll
                        for (int c = 0; c < 2; ++c) O[c] = MFMA32(Qtp, PACK_STEP(S[a][c], s2), O[c]); }
                    __builtin_amdgcn_sched_barrier(0);
                }
                bf16x8 Kh0, Kh1;
                {
                    f32x16 RT;
#pragma unroll
                    for (int e = 0; e < 16; ++e) RT[e] = 0.f;
#pragma unroll
                    for (int ks = 0; ks < 2; ++ks) { const bf16x8 Mgt = mk_const<1>(ks, hh, r); RT = MFMA32(Ahi[ks], Mgt, RT); RT = MFMA32(Alo[ks], Mgt, RT); }
#pragma unroll
                    for (int e = 0; e < 16; ++e) { kT[e] *= __expf(RT[e]); if (PASS2) qT[e] *= __expf(fminf(-RT[e], 80.0f)); }
                    Kh0 = PACK_STEP(kT, 0); Kh1 = PACK_STEP(kT, 1);
                    if (PASS2) { sc = MFMA32(Kh0, PACK_STEP(qT, 0), sc); sc = MFMA32(Kh1, PACK_STEP(qT, 1), sc); }
                    __builtin_amdgcn_sched_barrier(0);
                }
                {
                    f32x16 CT;
#pragma unroll
                    for (int e = 0; e < 16; ++e) CT[e] = 0.f;
#pragma unroll
                    for (int ks = 0; ks < 2; ++ks) { bf16x8 One;
#pragma unroll
                        for (int j = 0; j < 8; ++j) One[j] = (short)0x3F80;
                        CT = MFMA32(Ahi[ks], One, CT); CT = MFMA32(Alo[ks], One, CT); }
#pragma unroll
                    for (int e = 0; e < 16; ++e) { const float dd = __expf(CT[e]); S[a][0][e] *= dd; S[a][1][e] *= dd; if (!PASS2) CT[e] = dd; }
                    if (!PASS2 && r == 0) {
#pragma unroll
                        for (int e = 0; e < 16; ++e) Dsum[((size_t)task * 4 + ci) * 64 + 32 * a + crow(e, hh)] = CT[e]; }
                    __builtin_amdgcn_sched_barrier(0);
                }
                {
                    f32x16 Ks;
#pragma unroll
                    for (int e = 0; e < 16; ++e) Ks[e] = 0.f;
                    Ks = MFMA32(Kh0, mk_const<3>(0, hh, r), Ks); Ks = MFMA32(Kh1, mk_const<3>(1, hh, r), Ks);
#pragma unroll
                    for (int ks = 0; ks < 2; ++ks) { const bf16x8 Ksp = PACK_STEP(Ks, ks);
#pragma unroll
                        for (int c = 0; c < 2; ++c) { bf16x8 Vp; LOAD_VP(c, ks, Vp); S[a][c] = MFMA32(Ksp, Vp, S[a][c]); } }
                    __builtin_amdgcn_sched_barrier(0);
                }
            }
            if (PASS2) {
#pragma unroll
                for (int e = 0; e < 16; ++e) sc[e] = (crow(e, hh) <= r) ? sc[e] : 0.f;
#pragma unroll
                for (int ks = 0; ks < 2; ++ks) { const bf16x8 Pp = PACK_STEP(sc, ks);
#pragma unroll
                    for (int c = 0; c < 2; ++c) { bf16x8 Vp; LOAD_VP(c, ks, Vp); O[c] = MFMA32(Pp, Vp, O[c]); } }
                int lq2 = lz; asm volatile("" : "+v"(lq2));
                const int r2 = lq2 & 31, hh2 = lq2 >> 5;
#pragma unroll
                for (int c = 0; c < 2; ++c)
#pragma unroll
                    for (int e = 0; e < 16; ++e) *(float*)((char*)osc + (unsigned)((((dir * MTOK + rbase + sg * crow(e, hh2)) * DHG) + h * 64 + 32 * c + r2) * 4)) = O[c][e];
            }
#undef LOAD_VP
        }
        if (!PASS2) {
#pragma unroll
            for (int a = 0; a < 2; ++a)
#pragma unroll
                for (int c = 0; c < 2; ++c)
#pragma unroll
                    for (int e = 0; e < 16; ++e) *(float*)((char*)Usum + ((unsigned)(task * 4096 + lz) * 4u + (unsigned)(((a * 2 + c) * 16 + e) * 256))) = S[a][c][e];
        } else {
            asm volatile("s_waitcnt vmcnt(0)" ::: "memory");
            __syncthreads();
            bf16_t* merged = (bf16_t*)(p->ws + WS_R3);
            const int ch4 = h * 64 + (F.lane & 15) * 4; const f32x4 nw4 = *(const f32x4*)(p->norm_hgrn_w + l * DHG + ch4);
#pragma unroll 4
            for (int i = 0; i < 16; ++i) { const int row = b * SEQ + g * 512 + F.wave * 64 + i * 4 + (F.lane >> 4);
                const f32x4 of = *(const f32x4*)((const char*)osc + (unsigned)((row * DHG + ch4) * 4)), ob = *(const f32x4*)((const char*)osc + (unsigned)(((MTOK + row) * DHG + ch4) * 4));
                const u32x2 gq = *(const u32x2*)((const char*)proj + (unsigned)((row * PROJ + 3072 + ch4) * 2));
                const f32x4 ot = of + ob;
                float ms = ot[0] * ot[0] + ot[1] * ot[1] + ot[2] * ot[2] + ot[3] * ot[3];
                ms += __shfl_xor(ms, 1, 64); ms += __shfl_xor(ms, 2, 64); ms += __shfl_xor(ms, 4, 64); ms += __shfl_xor(ms, 8, 64);
                const float rs = rsqrtf(ms * (1.0f / 64.0f) + NORM_EPS);
                const float g0 = __uint_as_float(gq[0] << 16), g1 = __uint_as_float(gq[0] & 0xFFFF0000u), g2 = __uint_as_float(gq[1] << 16), g3 = __uint_as_float(gq[1] & 0xFFFF0000u);
                u32x2 o; o[0] = cvt_pk_bf16(ot[0] * rs * nw4[0] * siluf_(g0), ot[1] * rs * nw4[1] * siluf_(g1)); o[1] = cvt_pk_bf16(ot[2] * rs * nw4[2] * siluf_(g2), ot[3] * rs * nw4[3] * siluf_(g3));
                *(u32x2*)((char*)merged + (unsigned)((row * DM + DLRU + ch4) * 2)) = o; }
            __syncthreads();
        }
    }
}

__device__ __forceinline__ void phase_hgrn_prefix(KParams p, const Ctx& F) {
    float* Usum = (float*)(p->ws + WS_R2); const float* Dsum = Usum + (size_t)HG_TASKS * 4096;
    for (int gt = blockIdx.x * NTHREADS + F.tid; gt < 64 * 4096; gt += F.G * NTHREADS) {
        const int seq = gt >> 12, e = gt & 4095, dir = seq & 1;
        const int tile = e >> 10, reg = (e >> 6) & 15, ln = e & 63; const int d = 32 * (tile >> 1) + crow(reg, ln >> 5);
        float s = 0.f;
#pragma unroll 1
        for (int kb = 0; kb < 32; kb += 16) {
            float u16[16], d16[16];
#pragma unroll
            for (int q = 0; q < 16; ++q) { const int k = kb + q, trp = dir == 0 ? k : 31 - k; const size_t tp = (size_t)seq * 32 + trp;
                u16[q] = Usum[tp * 4096 + e];
                d16[q] = Dsum[(tp * 4 + 0) * 64 + d] * Dsum[(tp * 4 + 1) * 64 + d] * Dsum[(tp * 4 + 2) * 64 + d] * Dsum[(tp * 4 + 3) * 64 + d]; }
#pragma unroll
            for (int q = 0; q < 16; ++q) { const float sin = s; s = d16[q] * s + u16[q]; u16[q] = sin; }
#pragma unroll
            for (int q = 0; q < 16; ++q) { const int k = kb + q, trp = dir == 0 ? k : 31 - k; const size_t tp = (size_t)seq * 32 + trp; Usum[tp * 4096 + e] = u16[q]; }
        }
    }
}

constexpr int RT_PITCH = 2064;
__device__ __forceinline__ void phase_route(KParams p, const Ctx& F, int l) {
    const float* mod = (const float*)(p->ws + WS_MOD) + (size_t)l * NB * 6 * DM;
    const float* xa = (const float*)(p->ws + WS_XA); bf16_t* h2 = (bf16_t*)(p->ws + WS_R2);
    const float* nw = p->norm_ffn_w + l * DM;
    int* cnt = (int*)(p->ws + WS_CTL + CTL_CNT_OFF) + l * NEXP;
    int* tokinfo = (int*)(p->ws + WS_TOKINFO); float* tokw = (float*)(p->ws + WS_TOKW);
    const bf16_t* rwh = (const bf16_t*)(p->ws + WS_RWHI) + (size_t)l * 64 * DM; const bf16_t* rwl = (const bf16_t*)(p->ws + WS_RWLO) + (size_t)l * 64 * DM;
    LAS unsigned char* Ah = F.lds; LAS unsigned char* Al = F.lds + 32 * RT_PITCH; LAS float* part = (LAS float*)F.lds;
    const int r = F.lane & 31, hh = F.lane >> 5;
    for (int tile = blockIdx.x; tile < MTOK / 32; tile += F.G) {
        const int row0 = tile * 32;
#pragma unroll 1
        for (int i = 0; i < 4; ++i) {
            const int rl = F.wave * 4 + i, row = row0 + rl, b = row >> 12; const float* xr = xa + (size_t)row * DM;
            f32x4 v[4]; float ss = 0.f;
#pragma unroll
            for (int q = 0; q < 4; ++q) { v[q] = *(const f32x4*)(xr + F.lane * 4 + 256 * q); ss += v[q][0] * v[q][0] + v[q][1] * v[q][1] + v[q][2] * v[q][2] + v[q][3] * v[q][3]; }
            ss = wave_sum(ss); const float rstd = rsqrtf(ss * (1.0f / DM) + NORM_EPS);
#pragma unroll
            for (int q = 0; q < 4; ++q) { const int col = F.lane * 4 + 256 * q;
                const f32x4 w4 = *(const f32x4*)(nw + col), sh = *(const f32x4*)(mod + (size_t)b * 6 * DM + 3 * DM + col), s1 = *(const f32x4*)(mod + (size_t)b * 6 * DM + 4 * DM + col);
                const f32x4 o = v[q] * rstd * w4 * (s1 + 1.0f) + sh;
                u32x2 pk; pk[0] = cvt_pk_bf16(o[0], o[1]); pk[1] = cvt_pk_bf16(o[2], o[3]);
                *(u32x2*)(h2 + (size_t)row * DM + col) = pk;
                *(LAS u32x2*)(Ah + rl * RT_PITCH + col * 2) = pk;
                u32x2 lo; lo[0] = cvt_pk_bf16(o[0] - __uint_as_float(pk[0] << 16), o[1] - __uint_as_float(pk[0] & 0xFFFF0000u));
                lo[1] = cvt_pk_bf16(o[2] - __uint_as_float(pk[1] << 16), o[3] - __uint_as_float(pk[1] & 0xFFFF0000u));
                *(LAS u32x2*)(Al + rl * RT_PITCH + col * 2) = lo; }
        }
        __syncthreads();
        f32x16 acc[2];
#pragma unroll
        for (int e = 0; e < 16; ++e) { acc[0][e] = 0.f; acc[1][e] = 0.f; }
#pragma unroll 2
        for (int ks = 0; ks < 8; ++ks) { const int k0 = F.wave * 128 + ks * 16 + 8 * hh;
            const bf16x8 ah = *(const LAS bf16x8*)(Ah + r * RT_PITCH + k0 * 2), al = *(const LAS bf16x8*)(Al + r * RT_PITCH + k0 * 2);
#pragma unroll
            for (int nt = 0; nt < 2; ++nt) { const bf16x8 bh = *(const bf16x8*)(rwh + (size_t)(nt * 32 + r) * DM + k0), bl = *(const bf16x8*)(rwl + (size_t)(nt * 32 + r) * DM + k0);
                acc[nt] = MFMA32(ah, bh, acc[nt]); acc[nt] = MFMA32(al, bh, acc[nt]); acc[nt] = MFMA32(ah, bl, acc[nt]); } }
        __syncthreads();
#pragma unroll
        for (int nt = 0; nt < 2; ++nt)
#pragma unroll
            for (int e = 0; e < 16; ++e) part[(F.wave * 32 + crow(e, hh)) * 64 + nt * 32 + r] = acc[nt][e];
        __syncthreads();
        if (F.tid < 32) {
            const int row = row0 + F.tid;
            float lg[36];
#pragma unroll
            for (int n = 0; n < 36; ++n) { float s = 0.f;
#pragma unroll
                for (int w = 0; w < 8; ++w) s += part[(w * 32 + F.tid) * 64 + n];
                lg[n] = s; }
            float gl[4];
#pragma unroll
            for (int j = 0; j < 4; ++j) gl[j] = lg[32 + j] + p->rg_b[l * NGRP + j];
            int gi = 0; float gm = gl[0];
#pragma unroll
            for (int j = 1; j < 4; ++j) if (gl[j] > gm) { gm = gl[j]; gi = j; }
            float gs = 0.f;
#pragma unroll
            for (int j = 0; j < 4; ++j) gs += __expf(gl[j] - gm);
            const float pg = 1.0f / gs;
            float el[8];
#pragma unroll
            for (int j = 0; j < 8; ++j) { float v = lg[j];
#pragma unroll
                for (int q = 1; q < 4; ++q) v = (gi == q) ? lg[q * 8 + j] : v;
                el[j] = v + p->re_b[l * NEXP + gi * 8 + j]; }
            int i0 = 0; float v0 = el[0];
#pragma unroll
            for (int j = 1; j < 8; ++j) if (el[j] > v0) { v0 = el[j]; i0 = j; }
            int i1 = (i0 == 0) ? 1 : 0; float v1 = el[i0 == 0 ? 1 : 0];
#pragma unroll
            for (int j = 0; j < 8; ++j) if (j != i0 && el[j] > v1) { v1 = el[j]; i1 = j; }
            const float ex = __expf(v1 - v0); const float w0 = pg / (1.0f + ex), w1 = pg * ex / (1.0f + ex);
            const int e0 = gi * 8 + i0, e1 = gi * 8 + i1;
            const int p0 = atomicAdd(&cnt[e0], 1), p1 = atomicAdd(&cnt[e1], 1);
            *(int4*)(tokinfo + (size_t)row * 4) = make_int4(e0, p0, e1, p1);
            *(float2*)(tokw + (size_t)row * 2) = make_float2(w0, w1);
        }
        __syncthreads();
    }
}

constexpr int MOE_MAX_UNITS = 8;
__device__ __forceinline__ void build_tile_table(KParams p, const Ctx& F, int l) {
    LAS int* tst = (LAS int*)(F.lds + LDS_MISC + 64);
    LAS int* ulist = (LAS int*)(F.lds + LDS_MISC + 256);
    const int* cnt = (const int*)(p->ws + WS_CTL + CTL_CNT_OFF) + l * NEXP;
    if (F.tid == 0) { int acc = 0; for (int e = 0; e < NEXP; ++e) { tst[e] = acc; acc += (__hip_atomic_load(cnt + e, __ATOMIC_RELAXED, __HIP_MEMORY_SCOPE_AGENT) + 255) >> 8; } tst[NEXP] = acc; }
    __syncthreads();
    if (F.tid <= MOE_MAX_UNITS) { const int L = F.tid * F.G + (int)blockIdx.x, tm = tst[NEXP]; int pm = -1, pn = 0;
        if (F.tid < MOE_MAX_UNITS && L < tm * 4) { const int mt = L >> 2; int e = 0; for (int k = 1; k < NEXP; ++k) e += (tst[k] <= mt) ? 1 : 0; pm = mt; pn = e * 4 + (L & 3); }
        ulist[2 * F.tid] = pm; ulist[2 * F.tid + 1] = pn; }
    __syncthreads();
}

__device__ __forceinline__ void phase_permute(KParams p, const Ctx& F, int l) {
    build_tile_table(p, F, l);
    const LAS int* tst = (const LAS int*)(F.lds + LDS_MISC + 64);
    const bf16_t* h2 = (const bf16_t*)(p->ws + WS_R2); bf16_t* xperm = (bf16_t*)(p->ws + WS_R1);
    const int* tokinfo = (const int*)(p->ws + WS_TOKINFO); const float* tokw = (const float*)(p->ws + WS_TOKW);
    int* rowtok = (int*)(p->ws + WS_ROWTOK); float* roww = (float*)(p->ws + WS_ROWW);
    const int* cnt = (const int*)(p->ws + WS_CTL + CTL_CNT_OFF) + l * NEXP;
    for (int row = F.gwave; row < MTOK; row += F.nwaves) {
        const int4 ti = *(const int4*)(tokinfo + (size_t)row * 4); const float2 tw = *(const float2*)(tokw + (size_t)row * 2);
        const int r0 = tst[ti.x] * 256 + ti.y, r1 = tst[ti.z] * 256 + ti.w;
        const u32x4 a = *(const u32x4*)(h2 + (size_t)row * DM + F.lane * 8), b2 = *(const u32x4*)(h2 + (size_t)row * DM + 512 + F.lane * 8);
        *(u32x4*)(xperm + (size_t)r0 * DM + F.lane * 8) = a; *(u32x4*)(xperm + (size_t)r0 * DM + 512 + F.lane * 8) = b2;
        *(u32x4*)(xperm + (size_t)r1 * DM + F.lane * 8) = a; *(u32x4*)(xperm + (size_t)r1 * DM + 512 + F.lane * 8) = b2;
        if (F.lane == 0) { rowtok[r0] = row * 2; rowtok[r1] = row * 2 + 1; roww[r0] = tw.x; roww[r1] = tw.y; }
    }
    if ((int)blockIdx.x < NEXP) { const int e = blockIdx.x; const int c = __hip_atomic_load(cnt + e, __ATOMIC_RELAXED, __HIP_MEMORY_SCOPE_AGENT);
        const int lo = tst[e] * 256 + c, hi = tst[e + 1] * 256;
        for (int r = lo + F.tid; r < hi; r += NTHREADS) { rowtok[r] = -1; roww[r] = 0.f; } }
}

template <bool FINAL>
__device__ __forceinline__ void phase_combine(KParams p, const Ctx& F, int l, float* xo) {
    const float* mod = (const float*)(p->ws + WS_MOD) + (size_t)l * NB * 6 * DM;
    const float* xa = (const float*)(p->ws + WS_XA); const bf16_t* y = (const bf16_t*)(p->ws + WS_R1);
    for (int row = F.gwave; row < MTOK; row += F.nwaves) {
        const int b = row >> 12; f32x4 v[4]; float ss = 0.f;
#pragma unroll
        for (int i = 0; i < 4; ++i) { const int col = F.lane * 4 + 256 * i;
            const f32x4 xv = *(const f32x4*)(xa + (size_t)row * DM + col), g = *(const f32x4*)(mod + (size_t)b * 6 * DM + 5 * DM + col);
            const u32x2 y0 = *(const u32x2*)(y + (size_t)(row * 2) * DM + col), y1 = *(const u32x2*)(y + (size_t)(row * 2 + 1) * DM + col);
            f32x4 ys; ys[0] = __uint_as_float(y0[0] << 16) + __uint_as_float(y1[0] << 16); ys[1] = __uint_as_float(y0[0] & 0xFFFF0000u) + __uint_as_float(y1[0] & 0xFFFF0000u);
            ys[2] = __uint_as_float(y0[1] << 16) + __uint_as_float(y1[1] << 16); ys[3] = __uint_as_float(y0[1] & 0xFFFF0000u) + __uint_as_float(y1[1] & 0xFFFF0000u);
            v[i] = xv + g * ys; ss += v[i][0] * v[i][0] + v[i][1] * v[i][1] + v[i][2] * v[i][2] + v[i][3] * v[i][3]; }
        if (FINAL) { ss = wave_sum(ss); const float rstd = rsqrtf(ss * (1.0f / DM) + NORM_EPS);
#pragma unroll
            for (int i = 0; i < 4; ++i) { const int col = F.lane * 4 + 256 * i; const f32x4 w4 = *(const f32x4*)(p->final_w + col); *(f32x4*)(p->out + (size_t)row * DM + col) = v[i] * rstd * w4; }
        } else {
#pragma unroll
            for (int i = 0; i < 4; ++i) *(f32x4*)(xo + (size_t)row * DM + F.lane * 4 + 256 * i) = v[i];
            ss = wave_sum(ss); const float rstd = rsqrtf(ss * (1.0f / DM) + NORM_EPS);
            const float* modn = mod + (size_t)NB * 6 * DM; const float* nwn = p->norm_mix_w + (l + 1) * DM; bf16_t* h = (bf16_t*)(p->ws + WS_R2);
#pragma unroll
            for (int i = 0; i < 4; ++i) { const int col = F.lane * 4 + 256 * i;
                const f32x4 w4 = *(const f32x4*)(nwn + col), sh = *(const f32x4*)(modn + (size_t)b * 6 * DM + col), s1 = *(const f32x4*)(modn + (size_t)b * 6 * DM + DM + col);
                const f32x4 o = v[i] * rstd * w4 * (s1 + 1.0f) + sh;
                u32x2 pk; pk[0] = cvt_pk_bf16(o[0], o[1]); pk[1] = cvt_pk_bf16(o[2], o[3]);
                *(u32x2*)(h + (size_t)row * DM + col) = pk; }
        }
    }
}


__device__ __forceinline__ Ctx make_ctx(LAS unsigned char* lds) {
    int tz = threadIdx.x; asm volatile("" : "+v"(tz));
    Ctx F; F.lds = lds; F.tid = tz; F.lane = tz & 63; F.wave = __builtin_amdgcn_readfirstlane(tz >> 6);
    F.G = gridDim.x; F.gwave = blockIdx.x * NWAVES + F.wave; F.nwaves = F.G * NWAVES; return F;
}

constexpr int PH_PER_LAYER = 11, N_PHASES = 1 + DEPTH * PH_PER_LAYER;
#ifndef DBG_MASK
#define DBG_MASK 0xFFFFFFFFu
#endif
#define IN(k) ((((DBG_MASK) >> ((k) == 0 ? 0 : (((k) - 1) % PH_PER_LAYER) + 1)) & 1u) && lo <= (k) && (k) < hi)
#define SEAM(k) do { if (IN(k) && IN((k) + 1)) xcd_barrier(bar); } while (0)
#define SITE KParams P = get_params(); const Ctx F = make_ctx(lds);
#ifndef DBG_REPEAT
#define DBG_REPEAT 0u
#endif
#define NREP(k) (1 + (int)(((DBG_REPEAT) >> ((k) == 0 ? 0 : (((k) - 1) % PH_PER_LAYER) + 1)) & 1u))
#define PHASE(k, ...) { if (IN(k)) { __VA_ARGS__ } if constexpr (NREP(k) == 2) { if (IN(k)) { xcd_barrier(bar); __VA_ARGS__ } } }

template <int l>
__device__ __forceinline__ void run_layer(LAS unsigned char* const lds, const int lo, const int hi, const XcdBarrier& bar) {
        const int base = 1 + l * PH_PER_LAYER;
        if constexpr (l == 0) {
            PHASE(base + 0, SITE phase_norm1(P, F, l, P->x);)
            SEAM(base + 0);
        }
        PHASE(base + 1, SITE
            pg8::Gemm g{(const bf16_t*)(P->ws + WS_R2), (const bf16_t*)(P->ws + WS_WIN) + (size_t)l * PROJ * DM, MTOK, PROJ, DM};
            pg8::StaticOrder S; S.init(MTOK, PROJ, F.G, (int)blockIdx.x);
            pg8::EpiBf16 E{(bf16_t*)(P->ws + WS_R1), PROJ};
            pg8::gemm_phase(F.lds, g, S, E);)
        SEAM(base + 1);
        PHASE(base + 2, SITE phase_lru<false>(P, F, l);)
        PHASE(base + 2, SITE phase_hgrn<false>(P, F, l);)
        SEAM(base + 2);
        PHASE(base + 3, SITE phase_lru<true>(P, F, l);)
        if (IN(base + 3)) { SITE phase_hgrn_prefix(P, F); }
        SEAM(base + 3);
        PHASE(base + 4, SITE phase_hgrn<true>(P, F, l);)
        SEAM(base + 4);
        PHASE(base + 5, SITE
            pg8::Gemm g{(const bf16_t*)(P->ws + WS_R3), (const bf16_t*)(P->ws + WS_WOUT) + (size_t)l * DM * DM, MTOK, DM, DM};
            pg8::StaticOrder S; S.init(MTOK, DM, F.G, (int)blockIdx.x);
            pg8::EpiResid E{(l == 0) ? P->x : P->out, (float*)(P->ws + WS_XA), (const float*)(P->ws + WS_MOD) + (size_t)l * NB * 6 * DM + 2 * DM};
            pg8::gemm_phase(F.lds, g, S, E);)
        SEAM(base + 5);
        PHASE(base + 6, SITE phase_route(P, F, l);)
        SEAM(base + 6);
        PHASE(base + 7, SITE phase_permute(P, F, l);)
        SEAM(base + 7);
        PHASE(base + 8, SITE
            build_tile_table(P, F, l);
            pg8::Gemm g{(const bf16_t*)(P->ws + WS_R1), (const bf16_t*)(P->ws + WS_WGU) + (size_t)l * NEXP * 1024 * DM, MPAD, NEXP * 1024, DM};
            pg8::MoeOrder S{(const LAS int*)(F.lds + LDS_MISC + 256)};
            pg8::EpiGateUp E{(bf16_t*)(P->ws + WS_R2)};
            pg8::gemm_phase(F.lds, g, S, E);)
        SEAM(base + 8);
        PHASE(base + 9, SITE
            build_tile_table(P, F, l);
            pg8::Gemm g{(const bf16_t*)(P->ws + WS_R2), (const bf16_t*)(P->ws + WS_WD) + (size_t)l * NEXP * 1024 * DEXP, MPAD, NEXP * 1024, DEXP};
            pg8::MoeOrder S{(const LAS int*)(F.lds + LDS_MISC + 256)};
            pg8::EpiDown E{(bf16_t*)(P->ws + WS_R1), (const int*)(P->ws + WS_ROWTOK), (const float*)(P->ws + WS_ROWW)};
            pg8::gemm_phase(F.lds, g, S, E);)
        SEAM(base + 9);
        PHASE(base + 10, SITE if (l == DEPTH - 1) phase_combine<true>(P, F, l, nullptr); else phase_combine<false>(P, F, l, P->out);)
        SEAM(base + 10);
    }

__global__ void __launch_bounds__(NTHREADS, 2) mega(Params p_unused) {
    (void)p_unused;
    extern __shared__ __attribute__((aligned(16))) unsigned char lds_raw[];
    LAS unsigned char* const lds = (LAS unsigned char*)lds_raw;
    int lo, hi; XcdBarrier bar;
    { KParams P = get_params(); lo = (int)P->ph_lo; hi = (int)P->ph_hi;
      if (threadIdx.x < 4) ((LAS unsigned*)(lds + LDS_MISC))[threadIdx.x] = 0u;
      __syncthreads();
      bar.bar = (unsigned*)(P->ws + WS_CTL); bar.x = 0; bar.st = nullptr;
      if (hi - lo > 1) bar = xcd_barrier_post((unsigned*)(P->ws + WS_CTL), (volatile LAS unsigned*)(lds + LDS_MISC)); }

    PHASE(0, SITE phase_prologue(P, F);)
    SEAM(0);
    run_layer<0>(lds, lo, hi, bar);
    run_layer<1>(lds, lo, hi, bar);
#undef IN
#undef SEAM
#undef SITE
}

extern "C" void kernel_launch(void* const* d_in, const int* in_sizes, int n_in, void* d_out, int out_size, void* d_ws, size_t ws_size, hipStream_t stream) {
    static int grid = 0;
    if (grid == 0) {
        if (n_in != 26 || in_sizes[0] != MTOK * DM || out_size != MTOK * DM || ws_size < WS_END) {
            fprintf(stderr, "kernel_launch: unexpected shapes (n_in %d, in0 %d, out %d, ws %zu, need %zu); nothing launched\n", n_in, n_in > 0 ? in_sizes[0] : -1, out_size, ws_size, (size_t)WS_END); grid = -1; return; }
        int dev = 0, cus = 0, per_cu = 0;
        if (hipGetDevice(&dev) != hipSuccess || hipDeviceGetAttribute(&cus, hipDeviceAttributeMultiprocessorCount, dev) != hipSuccess) { fprintf(stderr, "kernel_launch: device query failed\n"); grid = -1; return; }
        if (hipFuncSetAttribute((const void*)mega, hipFuncAttributeMaxDynamicSharedMemorySize, LDS_BYTES) != hipSuccess) { fprintf(stderr, "kernel_launch: hipFuncSetAttribute failed\n"); grid = -1; return; }
        if (hipOccupancyMaxActiveBlocksPerMultiprocessor(&per_cu, (const void*)mega, NTHREADS, LDS_BYTES) != hipSuccess || per_cu < 1)
            fprintf(stderr, "kernel_launch: note: occupancy query reports %d workgroups per CU\n", per_cu);
        (void)hipGetLastError();
        grid = cus;
    }
    if (grid < 0) return;
    if (hipMemsetAsync((char*)d_ws + WS_CTL, 0, CTL_ZERO_BYTES, stream) != hipSuccess) { fprintf(stderr, "kernel_launch: memset failed\n"); return; }
    Params p{};
    const float** pf = (const float**)&p;
    for (int i = 0; i < 26; ++i) pf[i] = (const float*)d_in[i];
    p.out = (float*)d_out; p.ws = (unsigned char*)d_ws;
#if MK_PER_PHASE
    for (int ph = 0; ph < N_PHASES; ++ph) { p.ph_lo = ph; p.ph_hi = ph + 1;
        hipLaunchKernelGGL(mega, dim3(grid), dim3(NTHREADS), LDS_BYTES, stream, p);
        const hipError_t le = hipPeekAtLastError();
        if (le != hipSuccess) { fprintf(stderr, "kernel_launch: launch %d failed: %s\n", ph, hipGetErrorName(le)); break; } }
#else
    p.ph_lo = 0; p.ph_hi = N_PHASES;
    hipLaunchKernelGGL(mega, dim3(grid), dim3(NTHREADS), LDS_BYTES, stream, p);
    const hipError_t le = hipPeekAtLastError();
    if (le != hipSuccess) fprintf(stderr, "kernel_launch: launch failed: %s\n", hipGetErrorName(le));
#endif
}
```

```cpp
#include <hip/hip_runtime.h>
#include <stdint.h>
#include <stdio.h>

#ifndef MK_PER_PHASE
#define MK_PER_PHASE 0
#endif

#define LAS __attribute__((address_space(3)))
typedef unsigned short bf16_t;
typedef short bf16x8 __attribute__((ext_vector_type(8)));
typedef float f32x4 __attribute__((ext_vector_type(4)));
typedef float f32x2 __attribute__((ext_vector_type(2)));
typedef unsigned u32x4 __attribute__((ext_vector_type(4)));
typedef unsigned u32x2 __attribute__((ext_vector_type(2)));
typedef int i32x4 __attribute__((ext_vector_type(4)));

constexpr int NB = 4, SEQ = 4096, DM = 1024, MTOK = NB * SEQ, DEPTH = 2;
constexpr int DLRU = 512, DHG = 512, PROJ = 3584, NEXP = 32, DEXP = 512, NGRP = 4, EPG = 8;
constexpr int MPAD = 40960;
constexpr float NORM_EPS = 1e-6f;
constexpr int NWAVES = 8, NTHREADS = 512;

constexpr size_t WS_CTL = 0;
constexpr size_t CTL_ZERO_BYTES = 32768;
constexpr size_t CTL_CNT_OFF = 16384;
constexpr int CNT_STRIDE = 32;
constexpr size_t WS_MOD = 65536;
constexpr size_t WS_WIN = WS_MOD + 196608;
constexpr size_t WS_WOUT = WS_WIN + (size_t)DEPTH * PROJ * DM * 2;
constexpr size_t WS_WGU = WS_WOUT + (size_t)DEPTH * DM * DM * 2;
constexpr size_t WS_WD = WS_WGU + (size_t)DEPTH * NEXP * 1024 * 1024 * 2;
constexpr size_t WS_R1 = WS_WD + (size_t)DEPTH * NEXP * 1024 * 512 * 2;
constexpr size_t WS_R1_Y = 48u << 20;
constexpr size_t WS_R2 = WS_R1 + (size_t)MTOK * PROJ * 2;
constexpr size_t WS_R3 = WS_R2 + (size_t)MPAD * 512 * 2;
constexpr size_t WS_XA = WS_R3 + (size_t)MTOK * DM * 2;
constexpr size_t WS_TOKW = WS_XA + (size_t)MTOK * DM * 4;
constexpr size_t WS_ROWCAP = WS_TOKW + (size_t)MTOK * 8;
constexpr size_t WS_LRUW = WS_ROWCAP + (size_t)NEXP * MTOK * 4;
constexpr size_t WS_SUMA = WS_LRUW + 524288;
constexpr size_t WS_SUMH = WS_SUMA + 1048576;
constexpr size_t WS_RWHI = WS_SUMH + 1048576;
constexpr size_t WS_RWLO = WS_RWHI + (size_t)DEPTH * 64 * DM * 2;
constexpr size_t WS_END = WS_RWLO + (size_t)DEPTH * 64 * DM * 2;

constexpr int LDS_STAGE = 139264;
constexpr int LDS_MISC = LDS_STAGE;
constexpr int LDS_BYTES = LDS_STAGE + 10240;

#define XB_TMO      128
#define XB_XCNT(j)  (256  + 64 * (j))
#define XB_XSUB(j)  (1280 + 64 * (j))
#define XB_XGEN(j)  (2304 + 64 * (j))
#define XB_TOP      3328
#define XB_TOPGEN   3392
#define XCD_BAR_WORDS 3456
#define XB_SPIN_CAP (1u << 22)

__device__ __forceinline__ unsigned xb_ld(unsigned* p)              { return __hip_atomic_load(p, __ATOMIC_RELAXED, __HIP_MEMORY_SCOPE_AGENT); }
__device__ __forceinline__ unsigned xb_add(unsigned* p, unsigned v) { return __hip_atomic_fetch_add(p, v, __ATOMIC_RELAXED, __HIP_MEMORY_SCOPE_AGENT); }
__device__ __forceinline__ unsigned xb_xcc_id() { return (unsigned)__builtin_amdgcn_s_getreg((3 << 11) | 20) & 0xFu; }
#define XB_SPIN(cond, bar) do { unsigned _sp = 0; while (cond) { __builtin_amdgcn_s_sleep(1); \
    if ((++_sp & 255u) == 0u) { if (xb_ld(&(bar)[XB_TMO])) break; if (_sp > XB_SPIN_CAP) { atomicAdd(&(bar)[XB_TMO], 1u); break; } } } } while (0)

struct XcdBarrier { unsigned* bar; unsigned x; volatile LAS unsigned* st; };

__device__ __forceinline__ XcdBarrier xcd_barrier_post(unsigned* bar, volatile LAS unsigned* st) {
    XcdBarrier b; b.bar = bar; b.x = xb_xcc_id(); b.st = st;
    if (threadIdx.x == 0) (void)xb_add(&bar[XB_XCNT(b.x)], 1u);
    return b;
}
__device__ __forceinline__ void xcd_barrier_complete(unsigned* bar, unsigned x, unsigned& nloc, unsigned& nx) {
    const unsigned G = gridDim.x * gridDim.y * gridDim.z;
    unsigned sum, cnt, mine, sp = 0u;
    for (;;) {
        sum = 0u; cnt = 0u; mine = 0u;
#pragma unroll
        for (unsigned j = 0; j < 16; ++j) { const unsigned c = xb_ld(&bar[XB_XCNT(j)]); sum += c; cnt += (c > 0u) ? 1u : 0u; mine = (j == x) ? c : mine; }
        if (sum == G) break;
        __builtin_amdgcn_s_sleep(1);
        if ((++sp & 255u) == 0u) { if (xb_ld(&bar[XB_TMO])) break; if (sp > XB_SPIN_CAP) { atomicAdd(&bar[XB_TMO], 1u); break; } }
    }
    nloc = mine > 0u ? mine : 1u; nx = cnt > 0u ? cnt : 1u;
}
__device__ __forceinline__ void xcd_barrier(const XcdBarrier& b) {
    asm volatile("s_waitcnt vmcnt(0)" ::: "memory");
    __syncthreads();
    if (threadIdx.x == 0) {
        unsigned* bar = b.bar;
        __builtin_amdgcn_s_waitcnt(0);
        unsigned nloc = b.st[0], nx = b.st[1];
        if (nloc == 0u) { xcd_barrier_complete(bar, b.x, nloc, nx); b.st[0] = nloc; b.st[1] = nx; }
        const unsigned old = xb_add(&bar[XB_XSUB(b.x)], 1u);
        const unsigned gen = old / nloc;
        if (old + 1u == (gen + 1u) * nloc) {
            __builtin_amdgcn_fence(__ATOMIC_RELEASE, "agent");
            asm volatile("s_waitcnt vmcnt(0)" ::: "memory");
            const unsigned og = xb_add(&bar[XB_TOP], 1u);
            const unsigned tg = og / nx;
            if (og + 1u == (tg + 1u) * nx) xb_add(&bar[XB_TOPGEN], 1u);
            else XB_SPIN(xb_ld(&bar[XB_TOPGEN]) == tg, bar);
            __builtin_amdgcn_fence(__ATOMIC_ACQUIRE, "agent");
            xb_add(&bar[XB_XGEN(b.x)], 1u);
            asm volatile("s_waitcnt vmcnt(0)" ::: "memory");
        } else {
            XB_SPIN(xb_ld(&bar[XB_XGEN(b.x)]) == gen, bar);
            __builtin_amdgcn_fence(__ATOMIC_ACQUIRE, "agent");
            asm volatile("s_waitcnt vmcnt(0)" ::: "memory");
        }
    }
    __syncthreads();
}

__device__ __forceinline__ float bf2f(bf16_t b) { return __uint_as_float(((unsigned)b) << 16); }
__device__ __forceinline__ bf16_t f2bf(float f) { unsigned u = __float_as_uint(f); u += 0x7FFFu + ((u >> 16) & 1u); return (bf16_t)(u >> 16); }
__device__ __forceinline__ unsigned cvt_pk_bf16(float lo, float hi) { unsigned r; asm volatile("v_cvt_pk_bf16_f32 %0, %1, %2" : "=v"(r) : "v"(lo), "v"(hi)); return r; }
__device__ __forceinline__ float wave_sum(float v) {
#pragma unroll
    for (int m = 32; m >= 1; m >>= 1) v += __shfl_xor(v, m, 64);
    return v;
}
__device__ __forceinline__ float sigmoidf_(float x) { return __builtin_amdgcn_rcpf(1.0f + __expf(-x)); }
__device__ __forceinline__ float siluf_(float x) { return x * sigmoidf_(x); }
__device__ __forceinline__ float gelu_tanh(float x) {
    const float u = 0.7978845608028654f * (x + 0.044715f * x * x * x);
    const float t = 1.0f - 2.0f / (__expf(2.0f * u) + 1.0f);
    return 0.5f * x * (1.0f + t);
}
__device__ __forceinline__ float rdlane(float v, int l) { return __int_as_float(__builtin_amdgcn_readlane(__float_as_int(v), l)); }

namespace pg8 {
constexpr int BM = 256, BK = 64, HALF = 128, HTB = HALF * BK * 2, STAGE_BYTES = 8 * HTB, NXCD = 8, WGM = 8;
__host__ __device__ __forceinline__ int lds_byte(int r, int c) { const int st = (r >> 4) * 2 + (c >> 5), rr = r & 15, cc = c & 31, ob = rr * 64 + cc * 2; return st * 1024 + (ob ^ (((ob >> 9) & 1) << 5)); }
__host__ __device__ __forceinline__ void stage_rc(int b, int& R, int& C) { const int st = b / 1024, sb = b % 1024, swz = sb ^ (((sb >> 9) & 1) << 5); R = (st >> 1) * 16 + swz / 64; C = (st & 1) * 32 + (swz % 64) / 2; }
__host__ __device__ __forceinline__ int perm32(int rho) { const int n = rho >> 4, i = rho & 15; return 8 * (i >> 2) + 4 * n + (i & 3); }

struct Unit { int pm, pn, aux0, aux1; };
struct Gemm { const bf16_t* A; const bf16_t* Bt; int M, N, K; };

struct StaticOrder {
    int nM, nN, nwg, G, c;
    __host__ __device__ void init(int M, int N, int G_, int c_) { nM = M / BM; nN = N / BM; nwg = nM * nN; G = G_; c = c_; }
    __host__ __device__ bool next(int i, Unit& u) const {
        const long L = (long)i * G + c; if (L >= nwg) return false;
        int wgid = (int)L; { const int q = nwg / NXCD, r = nwg % NXCD, xcd = wgid % NXCD, off = wgid / NXCD; wgid = (xcd < r ? xcd * (q + 1) : r * (q + 1) + (xcd - r) * q) + off; }
        const int nig = WGM * nN, gid = wgid / nig, fm = gid * WGM, gsz = (nM - fm) < WGM ? (nM - fm) : WGM;
        u.pm = fm + ((wgid % nig) % gsz); u.pn = (wgid % nig) / gsz; u.aux0 = 0; u.aux1 = 0; return true;
    }
    __device__ __forceinline__ void a_ready(const Unit&) const {}
    __device__ __forceinline__ void done(const Unit&) const {}
};

struct MoeOrder {
    const LAS int* ulist;
    __device__ __forceinline__ bool next(int i, Unit& u) const {
        const int pm = __builtin_amdgcn_readfirstlane(ulist[4 * i]); if (pm < 0) return false;
        u.pm = pm; u.pn = __builtin_amdgcn_readfirstlane(ulist[4 * i + 1]); u.aux0 = __builtin_amdgcn_readfirstlane(ulist[4 * i + 2]); u.aux1 = __builtin_amdgcn_readfirstlane(ulist[4 * i + 3]); return true;
    }
    __device__ __forceinline__ void a_ready(const Unit&) const {}
    __device__ __forceinline__ void done(const Unit&) const {}
};

struct EpiBf16 {
    static constexpr bool PERM = true;
    bf16_t* O; int ldc;
    __device__ __forceinline__ void operator()(const f32x4 (&acc)[2][2][4][2], const Unit& u, int wr, int wc, int fr, int fq) const {
        const int row0 = u.pm * BM + wr * 64 + fr, col0 = u.pn * BM + wc * 32 + 8 * fq;
#pragma unroll
        for (int ai = 0; ai < 2; ++ai)
#pragma unroll
            for (int m = 0; m < 4; ++m) { bf16_t* rowp = O + (size_t)(row0 + ai * HALF + m * 16) * ldc + col0;
#pragma unroll
                for (int bj = 0; bj < 2; ++bj) { const f32x4 v0 = acc[ai][bj][m][0], v1 = acc[ai][bj][m][1];
                    u32x4 o; o[0] = cvt_pk_bf16(v0[0], v0[1]); o[1] = cvt_pk_bf16(v0[2], v0[3]); o[2] = cvt_pk_bf16(v1[0], v1[1]); o[3] = cvt_pk_bf16(v1[2], v1[3]);
                    *(u32x4*)(rowp + bj * HALF) = o; } }
    }
};
struct EpiResid {
    static constexpr bool PERM = false;
    const float* XI; float* XO; const float* gate;
    __device__ __forceinline__ void operator()(const f32x4 (&acc)[2][2][4][2], const Unit& u, int wr, int wc, int fr, int fq) const {
        const int row0 = u.pm * BM + wr * 64 + fr, col0 = u.pn * BM + wc * 32 + 4 * fq;
        const int b = (u.pm * BM) / SEQ;
        f32x4 gv[2][2];
#pragma unroll
        for (int bj = 0; bj < 2; ++bj)
#pragma unroll
            for (int n = 0; n < 2; ++n) gv[bj][n] = *(const f32x4*)(gate + (size_t)b * 6 * DM + col0 + bj * HALF + n * 16);
#pragma unroll
        for (int ai = 0; ai < 2; ++ai)
#pragma unroll
            for (int m = 0; m < 4; ++m) { const size_t ro = (size_t)(row0 + ai * HALF + m * 16) * DM + col0;
#pragma unroll
                for (int bj = 0; bj < 2; ++bj)
#pragma unroll
                    for (int n = 0; n < 2; ++n) { const f32x4 xi = *(const f32x4*)(XI + ro + bj * HALF + n * 16);
                        *(f32x4*)(XO + ro + bj * HALF + n * 16) = xi + gv[bj][n] * acc[ai][bj][m][n]; } }
    }
};
struct EpiGateUp {
    static constexpr bool PERM = true;
    bf16_t* H;
    __device__ __forceinline__ void operator()(const f32x4 (&acc)[2][2][4][2], const Unit& u, int wr, int wc, int fr, int fq) const {
        const int row0 = u.pm * BM + wr * 64 + fr, col0 = (u.pn & 3) * 128 + wc * 32 + 8 * fq;
#pragma unroll
        for (int ai = 0; ai < 2; ++ai)
#pragma unroll
            for (int m = 0; m < 4; ++m) { bf16_t* rowp = H + (size_t)(row0 + ai * HALF + m * 16) * DEXP + col0;
                float h[8];
#pragma unroll
                for (int n = 0; n < 2; ++n)
#pragma unroll
                    for (int q = 0; q < 4; ++q) { const float g = acc[ai][0][m][n][q], up = acc[ai][1][m][n][q]; h[n * 4 + q] = g / (1.0f + __expf(-g)) * up; }
                u32x4 o; o[0] = cvt_pk_bf16(h[0], h[1]); o[1] = cvt_pk_bf16(h[2], h[3]); o[2] = cvt_pk_bf16(h[4], h[5]); o[3] = cvt_pk_bf16(h[6], h[7]);
                *(u32x4*)rowp = o; }
    }
};
struct EpiDown {
    static constexpr bool PERM = true;
    bf16_t* Y; const LAS int* utok; const LAS float* utw;
    __device__ __forceinline__ void operator()(const f32x4 (&acc)[2][2][4][2], const Unit& u, int wr, int wc, int fr, int fq) const {
        const int rl0 = u.aux0 + wr * 64 + fr, col0 = (u.pn & 3) * BM + wc * 32 + 8 * fq;
#pragma unroll
        for (int ai = 0; ai < 2; ++ai)
#pragma unroll
            for (int m = 0; m < 4; ++m) { const int rl = rl0 + ai * HALF + m * 16; const int rt = utok[rl];
                if (rt >= 0) { const float w = utw[rl]; bf16_t* rowp = Y + (size_t)rt * DM + col0;
#pragma unroll
                    for (int bj = 0; bj < 2; ++bj) { const f32x4 v0 = acc[ai][bj][m][0] * w, v1 = acc[ai][bj][m][1] * w;
                        u32x4 o; o[0] = cvt_pk_bf16(v0[0], v0[1]); o[1] = cvt_pk_bf16(v0[2], v0[3]); o[2] = cvt_pk_bf16(v1[0], v1[1]); o[3] = cvt_pk_bf16(v1[2], v1[3]);
                        *(u32x4*)(rowp + bj * HALF) = o; } } }
    }
};

template <class Epi, class Sched>
__device__ __forceinline__ void gemm_phase(LAS unsigned char* lds, const Gemm g, const Sched& S, const Epi& E) {
    const int tid = threadIdx.x, wid = __builtin_amdgcn_readfirstlane(tid >> 6), lane = tid & 63, wr = wid >> 2, wc = wid & 3, fr = lane & 15, fq = lane >> 4;
    const int K = g.K, nt = K / BK;
    unsigned voffA[2], voffB[2];
#pragma unroll
    for (int i = 0; i < 2; ++i) { int R, C; stage_rc(tid * 16 + i * 8192, R, C); const int Rb = Epi::PERM ? ((R & ~31) + perm32(R & 31)) : R;
        voffA[i] = (unsigned)(R * K + C) * 2u; voffB[i] = (unsigned)(Rb * K + C) * 2u; }
    const size_t kstep = (size_t)(BK * 2);
    const size_t hstep = (size_t)HALF * K * 2;
    const size_t tstep = 2 * hstep;
    const unsigned ldsw = (unsigned)wid * 1024u;
    const int aoff = lds_byte(wr * 64 + fr, fq * 8), boff = lds_byte(wc * 32 + fr, fq * 8);
#define PG8_SA(b, h) (((b) * 2 + (h)) * HTB)
#define PG8_SB(b, h) ((4 + (b) * 2 + (h)) * HTB)
#define PG8_STAGE(bufoff, gbase, voff) do { _Pragma("unroll") for (int _i = 0; _i < 2; ++_i) \
        __builtin_amdgcn_global_load_lds((const unsigned*)((const char*)(gbase) + (voff)[_i]), (LAS unsigned*)(lds + (bufoff) + ldsw + _i * 8192), 16, 0, 0); } while (0)
#define PG8_LDA(dst, b, h) do { _Pragma("unroll") for (int m = 0; m < 4; ++m) _Pragma("unroll") for (int k = 0; k < 2; ++k) dst[m][k] = *(const LAS bf16x8*)(lds + PG8_SA(b, h) + aoff + m * 2048 + k * 1024); } while (0)
#define PG8_LDB(dst, b, h) do { _Pragma("unroll") for (int n = 0; n < 2; ++n) _Pragma("unroll") for (int k = 0; k < 2; ++k) dst[n][k] = *(const LAS bf16x8*)(lds + PG8_SB(b, h) + boff + n * 2048 + k * 1024); } while (0)
#define PG8_MMA(ai, bj, At, Bt) do { __builtin_amdgcn_s_setprio(1); _Pragma("unroll") for (int m = 0; m < 4; ++m) _Pragma("unroll") for (int n = 0; n < 2; ++n) _Pragma("unroll") for (int k = 0; k < 2; ++k) \
        acc[ai][bj][m][n] = __builtin_amdgcn_mfma_f32_16x16x32_bf16(Bt[n][k], At[m][k], acc[ai][bj][m][n], 0, 0, 0); __builtin_amdgcn_s_setprio(0); } while (0)
#define PG8_WAIT_V(n) asm volatile("s_waitcnt vmcnt(" #n ")" ::: "memory")
#define PG8_WAIT_L(n) asm volatile("s_waitcnt lgkmcnt(" #n ")" ::: "memory")
#define PG8_BAR __builtin_amdgcn_s_barrier()
#define PG8_SCHED __builtin_amdgcn_sched_barrier(0)
    Unit cur, nxt; int ui = 0;
    if (!S.next(0, cur)) return;
    f32x4 acc[2][2][4][2];
#pragma unroll
    for (int a = 0; a < 2; ++a)
#pragma unroll
        for (int b = 0; b < 2; ++b)
#pragma unroll
            for (int m = 0; m < 4; ++m)
#pragma unroll
                for (int n = 0; n < 2; ++n) acc[a][b][m][n] = (f32x4){0.f, 0.f, 0.f, 0.f};
    bf16x8 At[4][2], B0[2][2], B1[2][2];
    const char* cA = (const char*)g.A + (size_t)cur.pm * tstep; const char* cB = (const char*)g.Bt + (size_t)cur.pn * tstep;
    S.a_ready(cur);
    PG8_STAGE(PG8_SB(0, 0), cB, voffB); PG8_STAGE(PG8_SA(0, 0), cA, voffA); PG8_STAGE(PG8_SB(0, 1), cB + hstep, voffB); PG8_STAGE(PG8_SA(0, 1), cA + hstep, voffA);
    if (wr == 1) PG8_BAR;
    PG8_WAIT_V(4); PG8_BAR;
    PG8_STAGE(PG8_SB(1, 0), cB + kstep, voffB); PG8_STAGE(PG8_SA(1, 0), cA + kstep, voffA); PG8_STAGE(PG8_SB(1, 1), cB + hstep + kstep, voffB);
    PG8_WAIT_V(6); PG8_BAR;
    for (;;) {
        const bool has_next = S.next(ui + 1, nxt);
        const char* nA = has_next ? (const char*)g.A + (size_t)nxt.pm * tstep : cA; const char* nB = has_next ? (const char*)g.Bt + (size_t)nxt.pn * tstep : cB;
        for (int t = 0; t < nt; t += 2) {
            const bool last = (t == nt - 2);
            const char* a1 = cA + (size_t)(t + 1) * kstep;
            const char* a2 = last ? nA : cA + (size_t)(t + 2) * kstep; const char* b2 = last ? nB : cB + (size_t)(t + 2) * kstep;
            const char* a3 = a2 + kstep; const char* b3 = b2 + kstep;
            if (last && has_next) S.a_ready(nxt);
            PG8_LDB(B0, 0, 0); PG8_SCHED; PG8_LDA(At, 0, 0); PG8_STAGE(PG8_SA(1, 1), a1 + hstep, voffA);
            PG8_WAIT_L(8); PG8_BAR; PG8_WAIT_L(0); PG8_MMA(0, 0, At, B0); PG8_BAR; PG8_SCHED;
            PG8_LDB(B1, 0, 1); PG8_STAGE(PG8_SB(0, 0), b2, voffB);
            PG8_BAR; PG8_WAIT_L(0); PG8_MMA(0, 1, At, B1); PG8_BAR;
            PG8_LDA(At, 0, 1); PG8_STAGE(PG8_SA(0, 0), a2, voffA);
            PG8_BAR; PG8_WAIT_L(0); PG8_MMA(1, 0, At, B0); PG8_BAR; PG8_SCHED;
            PG8_STAGE(PG8_SB(0, 1), b2 + hstep, voffB);
            PG8_WAIT_V(6); PG8_BAR; PG8_MMA(1, 1, At, B1); PG8_BAR;
            PG8_LDB(B0, 1, 0); PG8_SCHED; PG8_LDA(At, 1, 0); PG8_STAGE(PG8_SA(0, 1), a2 + hstep, voffA);
            PG8_WAIT_L(8); PG8_BAR; PG8_WAIT_L(0); PG8_MMA(0, 0, At, B0); PG8_BAR; PG8_SCHED;
            PG8_LDB(B1, 1, 1); PG8_STAGE(PG8_SB(1, 0), b3, voffB);
            PG8_BAR; PG8_WAIT_L(0); PG8_MMA(0, 1, At, B1); PG8_BAR;
            PG8_LDA(At, 1, 1); PG8_STAGE(PG8_SA(1, 0), a3, voffA);
            PG8_BAR; PG8_WAIT_L(0); PG8_MMA(1, 0, At, B0); PG8_BAR; PG8_SCHED;
            PG8_STAGE(PG8_SB(1, 1), b3 + hstep, voffB);
            PG8_WAIT_V(6); PG8_BAR; PG8_MMA(1, 1, At, B1); PG8_BAR;
        }
        E(acc, cur, wr, wc, fr, fq); S.done(cur);
        if (!has_next) break;
#pragma unroll
        for (int a = 0; a < 2; ++a)
#pragma unroll
            for (int b = 0; b < 2; ++b)
#pragma unroll
                for (int m = 0; m < 4; ++m)
#pragma unroll
                    for (int n = 0; n < 2; ++n) acc[a][b][m][n] = (f32x4){0.f, 0.f, 0.f, 0.f};
        cur = nxt; cA = nA; cB = nB; ++ui;
    }
    PG8_WAIT_V(0);
    if (wr == 0) PG8_BAR;
    PG8_BAR;
#undef PG8_SA
#undef PG8_SB
#undef PG8_STAGE
#undef PG8_LDA
#undef PG8_LDB
#undef PG8_MMA
#undef PG8_WAIT_V
#undef PG8_WAIT_L
#undef PG8_BAR
#undef PG8_SCHED
}
template <class Epi, class Sched>
__device__ __forceinline__ void gemm_phase_gather(LAS unsigned char* lds, const Gemm g, const Sched& S, const Epi& E, const LAS int* utok) {
    const int tid = threadIdx.x, wid = __builtin_amdgcn_readfirstlane(tid >> 6), lane = tid & 63, wr = wid >> 2, wc = wid & 3, fr = lane & 15, fq = lane >> 4;
    const int K = g.K, nt = K / BK;
    unsigned voffB[2]; int rowA[2]; unsigned colA[2];
#pragma unroll
    for (int i = 0; i < 2; ++i) { int R, C; stage_rc(tid * 16 + i * 8192, R, C); const int Rb = Epi::PERM ? ((R & ~31) + perm32(R & 31)) : R;
        rowA[i] = R; colA[i] = (unsigned)C * 2u; voffB[i] = (unsigned)(Rb * K + C) * 2u; }
    unsigned gC[2][2], gN[2][2];
#define PG8_GOFS(dst, ui_) do { _Pragma("unroll") for (int h_ = 0; h_ < 2; ++h_) _Pragma("unroll") for (int i_ = 0; i_ < 2; ++i_) { \
        const int rt_ = utok[256 * (ui_) + h_ * HALF + rowA[i_]]; (dst)[h_][i_] = (unsigned)(((rt_ < 0 ? 0 : rt_) >> 1) * K) * 2u + colA[i_]; } } while (0)
    const size_t kstep = (size_t)(BK * 2);
    const size_t hstep = (size_t)HALF * K * 2;
    const size_t tstep = 2 * hstep;
    const unsigned ldsw = (unsigned)wid * 1024u;
    const int aoff = lds_byte(wr * 64 + fr, fq * 8), boff = lds_byte(wc * 32 + fr, fq * 8);
#define PG8_SA(b, h) (((b) * 2 + (h)) * HTB)
#define PG8_SB(b, h) ((4 + (b) * 2 + (h)) * HTB)
#define PG8_STAGE(bufoff, gbase, voff) do { _Pragma("unroll") for (int _i = 0; _i < 2; ++_i) \
        __builtin_amdgcn_global_load_lds((const unsigned*)((const char*)(gbase) + (voff)[_i]), (LAS unsigned*)(lds + (bufoff) + ldsw + _i * 8192), 16, 0, 0); } while (0)
#define PG8_LDA(dst, b, h) do { _Pragma("unroll") for (int m = 0; m < 4; ++m) _Pragma("unroll") for (int k = 0; k < 2; ++k) dst[m][k] = *(const LAS bf16x8*)(lds + PG8_SA(b, h) + aoff + m * 2048 + k * 1024); } while (0)
#define PG8_LDB(dst, b, h) do { _Pragma("unroll") for (int n = 0; n < 2; ++n) _Pragma("unroll") for (int k = 0; k < 2; ++k) dst[n][k] = *(const LAS bf16x8*)(lds + PG8_SB(b, h) + boff + n * 2048 + k * 1024); } while (0)
#define PG8_MMA(ai, bj, At, Bt) do { __builtin_amdgcn_s_setprio(1); _Pragma("unroll") for (int m = 0; m < 4; ++m) _Pragma("unroll") for (int n = 0; n < 2; ++n) _Pragma("unroll") for (int k = 0; k < 2; ++k) \
        acc[ai][bj][m][n] = __builtin_amdgcn_mfma_f32_16x16x32_bf16(Bt[n][k], At[m][k], acc[ai][bj][m][n], 0, 0, 0); __builtin_amdgcn_s_setprio(0); } while (0)
#define PG8_WAIT_V(n) asm volatile("s_waitcnt vmcnt(" #n ")" ::: "memory")
#define PG8_WAIT_L(n) asm volatile("s_waitcnt lgkmcnt(" #n ")" ::: "memory")
#define PG8_BAR __builtin_amdgcn_s_barrier()
#define PG8_SCHED __builtin_amdgcn_sched_barrier(0)
    Unit cur, nxt; int ui = 0;
    if (!S.next(0, cur)) return;
    f32x4 acc[2][2][4][2];
#pragma unroll
    for (int a = 0; a < 2; ++a)
#pragma unroll
        for (int b = 0; b < 2; ++b)
#pragma unroll
            for (int m = 0; m < 4; ++m)
#pragma unroll
                for (int n = 0; n < 2; ++n) acc[a][b][m][n] = (f32x4){0.f, 0.f, 0.f, 0.f};
    bf16x8 At[4][2], B0[2][2], B1[2][2];
    const char* cA = (const char*)g.A; const char* cB = (const char*)g.Bt + (size_t)cur.pn * tstep;
    PG8_GOFS(gC, 0);
    S.a_ready(cur);
    PG8_STAGE(PG8_SB(0, 0), cB, voffB); PG8_STAGE(PG8_SA(0, 0), cA, gC[0]); PG8_STAGE(PG8_SB(0, 1), cB + hstep, voffB); PG8_STAGE(PG8_SA(0, 1), cA, gC[1]);
    if (wr == 1) PG8_BAR;
    PG8_WAIT_V(4); PG8_BAR;
    PG8_STAGE(PG8_SB(1, 0), cB + kstep, voffB); PG8_STAGE(PG8_SA(1, 0), cA + kstep, gC[0]); PG8_STAGE(PG8_SB(1, 1), cB + hstep + kstep, voffB);
    PG8_WAIT_V(6); PG8_BAR;
    for (;;) {
        const bool has_next = S.next(ui + 1, nxt);
        const char* nB = has_next ? (const char*)g.Bt + (size_t)nxt.pn * tstep : cB;
        if (has_next) PG8_GOFS(gN, ui + 1); else { gN[0][0] = gC[0][0]; gN[0][1] = gC[0][1]; gN[1][0] = gC[1][0]; gN[1][1] = gC[1][1]; }
        for (int t = 0; t < nt; t += 2) {
            const bool last = (t == nt - 2);
            const char* a1 = cA + (size_t)(t + 1) * kstep;
            const char* a2 = last ? cA : cA + (size_t)(t + 2) * kstep; const char* b2 = last ? nB : cB + (size_t)(t + 2) * kstep;
            unsigned g2[2][2];
            g2[0][0] = last ? gN[0][0] : gC[0][0]; g2[0][1] = last ? gN[0][1] : gC[0][1]; g2[1][0] = last ? gN[1][0] : gC[1][0]; g2[1][1] = last ? gN[1][1] : gC[1][1];
            const char* a3 = a2 + kstep; const char* b3 = b2 + kstep;
            if (last && has_next) S.a_ready(nxt);
            PG8_LDB(B0, 0, 0); PG8_SCHED; PG8_LDA(At, 0, 0); PG8_STAGE(PG8_SA(1, 1), a1, gC[1]);
            PG8_WAIT_L(8); PG8_BAR; PG8_WAIT_L(0); PG8_MMA(0, 0, At, B0); PG8_BAR; PG8_SCHED;
            PG8_LDB(B1, 0, 1); PG8_STAGE(PG8_SB(0, 0), b2, voffB);
            PG8_BAR; PG8_WAIT_L(0); PG8_MMA(0, 1, At, B1); PG8_BAR;
            PG8_LDA(At, 0, 1); PG8_STAGE(PG8_SA(0, 0), a2, g2[0]);
            PG8_BAR; PG8_WAIT_L(0); PG8_MMA(1, 0, At, B0); PG8_BAR; PG8_SCHED;
            PG8_STAGE(PG8_SB(0, 1), b2 + hstep, voffB);
            PG8_WAIT_V(6); PG8_BAR; PG8_MMA(1, 1, At, B1); PG8_BAR;
            PG8_LDB(B0, 1, 0); PG8_SCHED; PG8_LDA(At, 1, 0); PG8_STAGE(PG8_SA(0, 1), a2, g2[1]);
            PG8_WAIT_L(8); PG8_BAR; PG8_WAIT_L(0); PG8_MMA(0, 0, At, B0); PG8_BAR; PG8_SCHED;
            PG8_LDB(B1, 1, 1); PG8_STAGE(PG8_SB(1, 0), b3, voffB);
            PG8_BAR; PG8_WAIT_L(0); PG8_MMA(0, 1, At, B1); PG8_BAR;
            PG8_LDA(At, 1, 1); PG8_STAGE(PG8_SA(1, 0), a3, g2[0]);
            PG8_BAR; PG8_WAIT_L(0); PG8_MMA(1, 0, At, B0); PG8_BAR; PG8_SCHED;
            PG8_STAGE(PG8_SB(1, 1), b3 + hstep, voffB);
            PG8_WAIT_V(6); PG8_BAR; PG8_MMA(1, 1, At, B1); PG8_BAR;
        }
        E(acc, cur, wr, wc, fr, fq); S.done(cur);
        if (!has_next) break;
#pragma unroll
        for (int a = 0; a < 2; ++a)
#pragma unroll
            for (int b = 0; b < 2; ++b)
#pragma unroll
                for (int m = 0; m < 4; ++m)
#pragma unroll
                    for (int n = 0; n < 2; ++n) acc[a][b][m][n] = (f32x4){0.f, 0.f, 0.f, 0.f};
        cur = nxt; cB = nB; ++ui;
        gC[0][0] = gN[0][0]; gC[0][1] = gN[0][1]; gC[1][0] = gN[1][0]; gC[1][1] = gN[1][1];
    }
    PG8_WAIT_V(0);
    if (wr == 0) PG8_BAR;
    PG8_BAR;
#undef PG8_GOFS
#undef PG8_SA
#undef PG8_SB
#undef PG8_STAGE
#undef PG8_LDA
#undef PG8_LDB
#undef PG8_MMA
#undef PG8_WAIT_V
#undef PG8_WAIT_L
#undef PG8_BAR
#undef PG8_SCHED
}
}

struct Params {
    const float* x; const float* c; const float* ada_w; const float* ada_b; const float* norm_mix_w; const float* w_in; const float* conv_w; const float* conv_b;
    const float* lru_wa; const float* lru_ba; const float* lru_wx; const float* lru_bx; const float* lru_lambda; const float* norm_lru_w; const float* hgrn_lb;
    const float* norm_hgrn_w; const float* w_out; const float* norm_ffn_w; const float* rg_w; const float* rg_b; const float* re_w; const float* re_b;
    const float* e_gate; const float* e_up; const float* e_down; const float* final_w;
    float* out; unsigned char* ws;
    long long ph_lo, ph_hi;
};

typedef const __attribute__((address_space(4))) Params* KParams;
__device__ __forceinline__ KParams get_params() { KParams q = (KParams)__builtin_amdgcn_kernarg_segment_ptr(); asm volatile("" : "+s"(q)); return q; }

struct Ctx {
    LAS unsigned char* lds; int tid, lane, wave, G, gwave, nwaves;
};

__device__ __forceinline__ void cvt_tile(const Ctx& F, const float* src, int ldn, bf16_t* dst, int ldd) {
    LAS unsigned char* slab = F.lds + F.wave * 8704;
    const int q = F.lane >> 4, n4 = (F.lane & 15) * 4;
    f32x4 v[16];
#pragma unroll
    for (int i = 0; i < 16; ++i) { const int k = 8 * (i >> 1) + 2 * q + (i & 1); v[i] = *(const f32x4*)(src + (size_t)k * ldn + n4); }
#pragma unroll
    for (int p = 0; p < 8; ++p) { const int k0 = 8 * p + 2 * q;
#pragma unroll
        for (int j = 0; j < 4; ++j) *(LAS unsigned*)(slab + (n4 + j) * 136 + k0 * 2) = cvt_pk_bf16(v[2 * p][j], v[2 * p + 1][j]); }
#pragma unroll
    for (int i = 0; i < 16; ++i) { const int n = 4 * i + q, ch = F.lane & 15;
        const u32x2 w = *(const LAS u32x2*)(slab + n * 136 + ch * 8);
        *(u32x2*)(dst + (size_t)n * ldd + ch * 4) = w; }
}

__device__ __forceinline__ void phase_prologue(KParams p, const Ctx& F) {
    bf16_t* WinT = (bf16_t*)(p->ws + WS_WIN); bf16_t* WoutT = (bf16_t*)(p->ws + WS_WOUT); bf16_t* WguT = (bf16_t*)(p->ws + WS_WGU); bf16_t* WdT = (bf16_t*)(p->ws + WS_WD);
    constexpr int T_IN = 16 * 56, T_OUT = 16 * 16, T_E = NEXP * 128, T_L = T_IN + T_OUT + 3 * T_E;
    for (int task = F.gwave; task < DEPTH * T_L; task += F.nwaves) {
        const int l = task / T_L; int r = task % T_L;
        if (r < T_IN) { const int kt = r / 56, nt = r % 56;
            cvt_tile(F, p->w_in + (size_t)l * DM * PROJ + (size_t)kt * 64 * PROJ + nt * 64, PROJ, WinT + ((size_t)l * PROJ + nt * 64) * DM + kt * 64, DM);
        } else if (r < T_IN + T_OUT) { r -= T_IN; const int kt = r / 16, nt = r % 16;
            cvt_tile(F, p->w_out + (size_t)l * DM * DM + (size_t)kt * 64 * DM + nt * 64, DM, WoutT + ((size_t)l * DM + nt * 64) * DM + kt * 64, DM);
        } else if (r < T_IN + T_OUT + 2 * T_E) { r -= T_IN + T_OUT; const int up = r / T_E; r %= T_E; const int e = r / 128, rr = r % 128, kt = rr / 8, nt = rr % 8, n0 = nt * 64;
            const float* src = (up ? p->e_up : p->e_gate) + ((size_t)(l * NEXP + e) * DM + kt * 64) * DEXP + n0;
            const size_t drow = (size_t)(l * NEXP + e) * 1024 + 256 * (n0 >> 7) + 128 * up + (n0 & 127);
            cvt_tile(F, src, DEXP, WguT + drow * DM + kt * 64, DM);
        } else { r -= T_IN + T_OUT + 2 * T_E; const int e = r / 128, rr = r % 128, kt = rr / 16, nt = rr % 16;
            const float* src = p->e_down + ((size_t)(l * NEXP + e) * DEXP + kt * 64) * DM + nt * 64;
            cvt_tile(F, src, DM, WdT + ((size_t)(l * NEXP + e) * 1024 + nt * 64) * DEXP + kt * 64, DEXP);
        }
    }
    {
        bf16_t* wf = (bf16_t*)(p->ws + WS_LRUW);
        for (int it = blockIdx.x * NTHREADS + F.tid; it < 32768; it += F.G * NTHREADS) {
            const int ln = it & 63, ks = (it >> 6) & 3, ct = (it >> 8) & 1, h = (it >> 9) & 7, m = (it >> 12) & 1, ld = it >> 13;
            const float* src = (m ? p->lru_wx : p->lru_wa) + ((size_t)ld * 8 + h) * 4096 + (size_t)(ks * 16 + 8 * (ln >> 5)) * 64 + ct * 32 + (ln & 31);
            u32x4 o; o[0] = cvt_pk_bf16(src[0], src[64]); o[1] = cvt_pk_bf16(src[128], src[192]); o[2] = cvt_pk_bf16(src[256], src[320]); o[3] = cvt_pk_bf16(src[384], src[448]);
            *(u32x4*)(wf + (size_t)it * 8) = o; }
    }
    {
        bf16_t* rwh = (bf16_t*)(p->ws + WS_RWHI); bf16_t* rwl = (bf16_t*)(p->ws + WS_RWLO);
        for (int it = blockIdx.x * NTHREADS + F.tid; it < DEPTH * 64 * DM; it += F.G * NTHREADS) {
            const int k = it & (DM - 1), n = (it >> 10) & 63, l = it >> 16;
            const float w = n < NEXP ? p->re_w[((size_t)l * DM + k) * NEXP + n] : (n < NEXP + NGRP ? p->rg_w[((size_t)l * DM + k) * NGRP + (n - NEXP)] : 0.f);
            const bf16_t hi = f2bf(w); rwh[it] = hi; rwl[it] = f2bf(w - bf2f(hi)); }
    }
    __syncthreads();
    LAS float* sc = (LAS float*)F.lds;
    LAS float* red = (LAS float*)(F.lds + 16384);
    for (int i = F.tid; i < NB * DM; i += NTHREADS) sc[i] = siluf_(p->c[i]);
    __syncthreads();
    float* mod = (float*)(p->ws + WS_MOD);
    for (int t = blockIdx.x; t < DEPTH * 96; t += F.G) {
        const int l = t / 96, n0 = (t % 96) * 64;
        const float* w = p->ada_w + (size_t)l * DM * 6 * DM + n0 + F.lane;
        float a0 = 0.f, a1 = 0.f, a2 = 0.f, a3 = 0.f;
        const int k0 = F.wave * 128;
#pragma unroll 8
        for (int k = k0; k < k0 + 128; ++k) { const float wv = w[(size_t)k * 6 * DM]; a0 += sc[k] * wv; a1 += sc[DM + k] * wv; a2 += sc[2 * DM + k] * wv; a3 += sc[3 * DM + k] * wv; }
        red[(F.wave * 4 + 0) * 64 + F.lane] = a0; red[(F.wave * 4 + 1) * 64 + F.lane] = a1; red[(F.wave * 4 + 2) * 64 + F.lane] = a2; red[(F.wave * 4 + 3) * 64 + F.lane] = a3;
        __syncthreads();
        if (F.tid < 256) { const int b = F.tid >> 6, ln = F.tid & 63; float s = p->ada_b[l * 6 * DM + n0 + ln];
#pragma unroll
            for (int w8 = 0; w8 < 8; ++w8) s += red[(w8 * 4 + b) * 64 + ln];
            mod[((size_t)l * NB + b) * 6 * DM + n0 + ln] = s; }
        __syncthreads();
    }
}

__device__ __forceinline__ void phase_norm1(KParams p, const Ctx& F, int l, const float* xin) {
    const float* mod = (const float*)(p->ws + WS_MOD) + (size_t)l * NB * 6 * DM;
    bf16_t* h = (bf16_t*)(p->ws + WS_R2);
    const float* nw = p->norm_mix_w + l * DM;
    for (int row = F.gwave; row < MTOK; row += F.nwaves) {
        const int b = row >> 12; const float* xr = xin + (size_t)row * DM;
        f32x4 v[4]; float ss = 0.f;
#pragma unroll
        for (int i = 0; i < 4; ++i) { v[i] = *(const f32x4*)(xr + F.lane * 4 + 256 * i); ss += v[i][0] * v[i][0] + v[i][1] * v[i][1] + v[i][2] * v[i][2] + v[i][3] * v[i][3]; }
        ss = wave_sum(ss); const float rstd = rsqrtf(ss * (1.0f / DM) + NORM_EPS);
#pragma unroll
        for (int i = 0; i < 4; ++i) { const int col = F.lane * 4 + 256 * i;
            const f32x4 w4 = *(const f32x4*)(nw + col), sh = *(const f32x4*)(mod + (size_t)b * 6 * DM + col), s1 = *(const f32x4*)(mod + (size_t)b * 6 * DM + DM + col);
            f32x4 o = v[i] * rstd * w4 * (s1 + 1.0f) + sh;
            u32x2 pk; pk[0] = cvt_pk_bf16(o[0], o[1]); pk[1] = cvt_pk_bf16(o[2], o[3]);
            *(u32x2*)(h + (size_t)row * DM + col) = pk; }
    }
}

__device__ __forceinline__ void phase_conv(KParams p, const Ctx& F, int l) {
    const bf16_t* proj = (const bf16_t*)(p->ws + WS_R1); float* xc = (float*)(p->ws + WS_XA);
    const float* cw = p->conv_w + l * 4 * DLRU; const float* cb = p->conv_b + l * DLRU;
    for (int it = blockIdx.x * NTHREADS + F.tid; it < MTOK * (DLRU / 4); it += F.G * NTHREADS) {
        const int row = it >> 7, c4 = (it & 127) * 4, t = row & (SEQ - 1);
        f32x4 acc = *(const f32x4*)(cb + c4);
#pragma unroll
        for (int k = 0; k < 4; ++k) { const int tt = t + k - 2;
            if (tt >= 0 && tt < SEQ) { const u32x2 pv = *(const u32x2*)(proj + (size_t)(row + k - 2) * PROJ + c4); const f32x4 w4 = *(const f32x4*)(cw + k * DLRU + c4);
                acc[0] += w4[0] * __uint_as_float(pv[0] << 16); acc[1] += w4[1] * __uint_as_float(pv[0] & 0xFFFF0000u);
                acc[2] += w4[2] * __uint_as_float(pv[1] << 16); acc[3] += w4[3] * __uint_as_float(pv[1] & 0xFFFF0000u); } }
        *(f32x4*)(xc + (size_t)row * DLRU + c4) = acc;
    }
}

__device__ __forceinline__ void lru_seq(KParams p, const Ctx& F, int l, int b, int h) {
    const bf16_t* proj = (const bf16_t*)(p->ws + WS_R1); const float* xc = (const float*)(p->ws + WS_XA); float* tmpz = (float*)(p->ws + WS_XA) + (size_t)MTOK * DLRU;
    const int c = h * 64 + F.lane;
    for (int d = 0; d < 2; ++d) {
        float wa_r[64], wx_r[64];
        const float* wa = p->lru_wa + ((size_t)(l * 2 + d) * 8 + h) * 4096 + F.lane; const float* wx = p->lru_wx + ((size_t)(l * 2 + d) * 8 + h) * 4096 + F.lane;
#pragma unroll
        for (int i = 0; i < 64; ++i) { wa_r[i] = wa[i * 64]; wx_r[i] = wx[i * 64]; }
        const float ba = p->lru_ba[(l * 2 + d) * DLRU + c], bx = p->lru_bx[(l * 2 + d) * DLRU + c], lam = p->lru_lambda[(l * 2 + d) * DLRU + c];
        const float cc = -8.0f * log1pf(expf(-lam));
        float hst = 0.f;
        for (int step = 0; step < SEQ; ++step) {
            const int t = d == 0 ? step : SEQ - 1 - step; const size_t row = (size_t)b * SEQ + t;
            const float xv = xc[row * DLRU + c];
            float ra = ba, rx = bx;
#pragma unroll
            for (int i = 0; i < 64; ++i) { const float xi = rdlane(xv, i); ra += xi * wa_r[i]; rx += xi * wx_r[i]; }
            const float r = sigmoidf_(ra), ig = sigmoidf_(rx), la = cc * r, a = expf(la);
            const float u = sqrtf(fmaxf(-expm1f(2.0f * la), 0.f)) * (ig * xv);
            hst = a * hst + u;
            if (d == 0) tmpz[row * DLRU + c] = hst;
            else { const float yv = bf2f(proj[row * PROJ + DLRU + c]); tmpz[row * DLRU + c] = (tmpz[row * DLRU + c] + hst) * gelu_tanh(yv); }
        }
    }
}

__device__ __forceinline__ float hgrn_lb(KParams p, int l, int ch) {
    if (l == 0) return 0.f;
    const float a = p->hgrn_lb[ch], b = p->hgrn_lb[DHG + ch]; const float m = fmaxf(a, b); const float ea = expf(a - m), eb = expf(b - m);
    return eb / (ea + eb);
}

__device__ __forceinline__ void hgrn_seq(KParams p, const Ctx& F, int l, int b, int h) {
    const bf16_t* proj = (const bf16_t*)(p->ws + WS_R1); float* tmpo = (float*)(p->ws + WS_R2); bf16_t* merged = (bf16_t*)(p->ws + WS_R3);
    const int ch = h * 64 + F.lane;
    const float lbv = hgrn_lb(p, l, ch), nw = p->norm_hgrn_w[l * DHG + ch];
    for (int d = 0; d < 2; ++d) {
        float S[64];
#pragma unroll
        for (int i = 0; i < 64; ++i) S[i] = 0.f;
        const int fcol = (d == 0 ? 1536 : 2048) + ch;
        for (int step = 0; step < SEQ; ++step) {
            const int t = d == 0 ? step : SEQ - 1 - step; const size_t row = (size_t)b * SEQ + t; const bf16_t* pr = proj + row * PROJ;
            const float fl = bf2f(pr[fcol]), qv = bf2f(pr[1024 + ch]), vv = bf2f(pr[2560 + ch]);
            const float f = lbv + (1.0f - lbv) * sigmoidf_(fl), k = 1.0f - f;
            float o = 0.f;
#pragma unroll
            for (int i = 0; i < 64; ++i) { const float fd = rdlane(f, i), kd = rdlane(k, i), qd = rdlane(qv, i); S[i] = fd * S[i] + kd * vv; o += qd * S[i]; }
            if (d == 0) tmpo[row * DHG + ch] = o;
            else { const float ot = tmpo[row * DHG + ch] + o; const float ms = wave_sum(ot * ot) * (1.0f / 64.0f);
                const float gv = bf2f(pr[3072 + ch]); const float y = ot * rsqrtf(ms + NORM_EPS) * nw * siluf_(gv);
                merged[row * DM + DLRU + ch] = f2bf(y); }
        }
    }
}

__device__ __forceinline__ void phase_mixer_seq(KParams p, const Ctx& F, int l) {
#ifdef USE_LRU_SEQ
    if (F.wave == 0 && (int)blockIdx.x < 64) {
        const int id = blockIdx.x;
        if (id < 32) lru_seq(p, F, l, id >> 3, id & 7); else hgrn_seq(p, F, l, (id - 32) >> 3, (id - 32) & 7);
    }
#else
    if (F.wave == 0 && (int)blockIdx.x < 32) hgrn_seq(p, F, l, (int)blockIdx.x >> 3, (int)blockIdx.x & 7);
#endif
}

__device__ __forceinline__ void phase_lru_norm(KParams p, const Ctx& F, int l) {
    const float* tmpz = (const float*)(p->ws + WS_XA) + (size_t)MTOK * DLRU; bf16_t* merged = (bf16_t*)(p->ws + WS_R3); const float* nw = p->norm_lru_w + l * DLRU;
    for (int row = F.gwave; row < MTOK; row += F.nwaves) {
        f32x4 v[2]; float ss = 0.f;
#pragma unroll
        for (int i = 0; i < 2; ++i) { v[i] = *(const f32x4*)(tmpz + (size_t)row * DLRU + F.lane * 4 + 256 * i); ss += v[i][0] * v[i][0] + v[i][1] * v[i][1] + v[i][2] * v[i][2] + v[i][3] * v[i][3]; }
        ss = wave_sum(ss); const float rstd = rsqrtf(ss * (1.0f / DLRU) + NORM_EPS);
#pragma unroll
        for (int i = 0; i < 2; ++i) { const int col = F.lane * 4 + 256 * i; const f32x4 w4 = *(const f32x4*)(nw + col); const f32x4 o = v[i] * rstd * w4;
            u32x2 pk; pk[0] = cvt_pk_bf16(o[0], o[1]); pk[1] = cvt_pk_bf16(o[2], o[3]); *(u32x2*)(merged + (size_t)row * DM + col) = pk; }
    }
}

typedef float f32x16 __attribute__((ext_vector_type(16)));
#define MFMA32(a, b, c) __builtin_amdgcn_mfma_f32_32x32x16_bf16((a), (b), (c), 0, 0, 0)
constexpr int XCP = 1040;
template <bool PASS2>
__device__ __forceinline__ void phase_lru(KParams p, const Ctx& F, int l) {
    const bf16_t* proj = (const bf16_t*)(p->ws + WS_R1);
    float* sumA = (float*)(p->ws + WS_SUMA); float* sumH = (float*)(p->ws + WS_SUMH);
    const bf16x8* wf = (const bf16x8*)(p->ws + WS_LRUW);
    LAS unsigned char* xcb = F.lds; LAS unsigned char* zb = F.lds + 64 * XCP; LAS float* cin = (LAS float*)(F.lds + 128 * XCP);
    const float* cw = p->conv_w + l * 4 * DLRU; const float* cb = p->conv_b + l * DLRU;
    for (int task = blockIdx.x; task < NB * 64; task += F.G) {
        const int b = task >> 6, j = task & 63; const int row0 = b * SEQ + j * 64;
        for (int it = F.tid; it < 64 * 64; it += NTHREADS) {
            const int t = it >> 6, c8 = (it & 63) * 8, tg = j * 64 + t;
            f32x4 a0 = *(const f32x4*)(cb + c8), a1 = *(const f32x4*)(cb + c8 + 4);
#pragma unroll
            for (int k = 0; k < 4; ++k) { const int tt = tg + k - 2;
                if (tt >= 0 && tt < SEQ) { const u32x4 pv = *(const u32x4*)(proj + (size_t)(b * SEQ + tt) * PROJ + c8);
                    const f32x4 w0 = *(const f32x4*)(cw + k * DLRU + c8), w1 = *(const f32x4*)(cw + k * DLRU + c8 + 4);
                    a0[0] += w0[0] * __uint_as_float(pv[0] << 16); a0[1] += w0[1] * __uint_as_float(pv[0] & 0xFFFF0000u);
                    a0[2] += w0[2] * __uint_as_float(pv[1] << 16); a0[3] += w0[3] * __uint_as_float(pv[1] & 0xFFFF0000u);
                    a1[0] += w1[0] * __uint_as_float(pv[2] << 16); a1[1] += w1[1] * __uint_as_float(pv[2] & 0xFFFF0000u);
                    a1[2] += w1[2] * __uint_as_float(pv[3] << 16); a1[3] += w1[3] * __uint_as_float(pv[3] & 0xFFFF0000u); } }
            u32x4 o; o[0] = cvt_pk_bf16(a0[0], a0[1]); o[1] = cvt_pk_bf16(a0[2], a0[3]); o[2] = cvt_pk_bf16(a1[0], a1[1]); o[3] = cvt_pk_bf16(a1[2], a1[3]);
            *(LAS u32x4*)(xcb + t * XCP + c8 * 2) = o;
            if (PASS2) *(LAS u32x4*)(zb + t * XCP + c8 * 2) = *(const u32x4*)(proj + (size_t)(row0 + t) * PROJ + DLRU + c8);
        }
        if (PASS2) {
            const int c = F.tid;
            const float* fa = sumA + (size_t)(0 * NB + b) * 64 * DLRU + c; const float* fh = sumH + (size_t)(0 * NB + b) * 64 * DLRU + c;
            const float* ra = sumA + (size_t)(1 * NB + b) * 64 * DLRU + c; const float* rh = sumH + (size_t)(1 * NB + b) * 64 * DLRU + c;
            float s = 0.f;
#pragma unroll 1
            for (int kb = 0; kb < 64; kb += 16) {
                float a16[16], h16[16];
#pragma unroll
                for (int q = 0; q < 16; ++q) { const int k = kb + q; const bool on = k < j; a16[q] = on ? fa[k * DLRU] : 1.f; h16[q] = on ? fh[k * DLRU] : 0.f; }
#pragma unroll
                for (int q = 0; q < 16; ++q) s = a16[q] * s + h16[q];
            }
            cin[c] = s; s = 0.f;
#pragma unroll 1
            for (int kb = 0; kb < 64; kb += 16) {
                float a16[16], h16[16];
#pragma unroll
                for (int q = 0; q < 16; ++q) { const int k = 63 - kb - q; const bool on = k > j; a16[q] = on ? ra[k * DLRU] : 1.f; h16[q] = on ? rh[k * DLRU] : 0.f; }
#pragma unroll
                for (int q = 0; q < 16; ++q) s = a16[q] * s + h16[q];
            }
            cin[DLRU + c] = s;
        }
        __syncthreads();
        {
            const int h = F.wave, r = F.lane & 31, hh = F.lane >> 5;
            const LAS unsigned char* abase = xcb + (32 * ((r >> 2) & 1) + 4 * (r >> 3) + (r & 3)) * XCP + (h * 64 + 8 * hh) * 2;
#pragma unroll 1
            for (int ct = 0; ct < 2; ++ct) {
                const int c = h * 64 + ct * 32 + r;
                float hf[32];
#pragma unroll
                for (int d = 0; d < 2; ++d) {
                    const bf16x8* wba = wf + ((((size_t)(l * 2 + d) * 2 + 0) * 8 + h) * 2 + ct) * 4 * 64 + F.lane;
                    const bf16x8* wbx = wf + ((((size_t)(l * 2 + d) * 2 + 1) * 8 + h) * 2 + ct) * 4 * 64 + F.lane;
                    bf16x8 Ba[4], Bx[4];
#pragma unroll
                    for (int ks = 0; ks < 4; ++ks) { Ba[ks] = wba[ks * 64]; Bx[ks] = wbx[ks * 64]; }
                    const float ba = p->lru_ba[(l * 2 + d) * DLRU + c], bx = p->lru_bx[(l * 2 + d) * DLRU + c];
                    const float cc = -8.0f * log1pf(__expf(-p->lru_lambda[(l * 2 + d) * DLRU + c]));
                    float av[32], uv[32];
#pragma unroll
                    for (int rt = 0; rt < 2; ++rt) {
                        f32x16 za, zx;
#pragma unroll
                        for (int e = 0; e < 16; ++e) { za[e] = 0.f; zx[e] = 0.f; }
#pragma unroll
                        for (int ks = 0; ks < 4; ++ks) { const bf16x8 Af = *(const LAS bf16x8*)(abase + 16 * rt * XCP + ks * 32);
                            za = MFMA32(Af, Ba[ks], za); zx = MFMA32(Af, Bx[ks], zx); }
#pragma unroll
                        for (int reg = 0; reg < 16; ++reg) { const int i = 16 * rt + reg;
                            const float xcv = bf2f(*(const LAS bf16_t*)(xcb + (32 * hh + i) * XCP + c * 2));
                            const float rg = sigmoidf_(za[reg] + ba), ig = sigmoidf_(zx[reg] + bx), la = cc * rg;
                            av[i] = __expf(la); uv[i] = sqrtf(fmaxf(1.0f - __expf(2.0f * la), 0.f)) * (ig * xcv); }
                    }
                    if (d == 0) {
#pragma unroll
                        for (int i = 1; i < 32; ++i) { uv[i] = av[i] * uv[i - 1] + uv[i]; av[i] = av[i] * av[i - 1]; }
                    } else {
#pragma unroll
                        for (int i = 30; i >= 0; --i) { uv[i] = av[i] * uv[i + 1] + uv[i]; av[i] = av[i] * av[i + 1]; }
                    }
                    const float myP = (d == 0) ? av[31] : av[0], myH = (d == 0) ? uv[31] : uv[0];
                    const float oP = __shfl_xor(myP, 32, 64), oH = __shfl_xor(myH, 32, 64);
                    if (!PASS2) {
                        if (hh == 0) { const size_t idx = ((size_t)(d * NB + b) * 64 + j) * DLRU + c;
                            sumA[idx] = myP * oP;
                            sumH[idx] = (d == 0) ? (oH + oP * myH) : (myH + myP * oH); }
                    } else {
                        const float cinv = cin[d * DLRU + c];
                        const bool first = (d == 0) ? (hh == 0) : (hh == 1);
                        const float cy = first ? cinv : (oH + oP * cinv);
                        if (d == 0) {
#pragma unroll
                            for (int i = 0; i < 32; ++i) hf[i] = uv[i] + av[i] * cy;
                        } else {
#pragma unroll
                            for (int i = 0; i < 32; ++i) { const float hs = hf[i] + uv[i] + av[i] * cy;
                                LAS bf16_t* zp = (LAS bf16_t*)(zb + (32 * hh + i) * XCP + c * 2);
                                *zp = f2bf(hs * gelu_tanh(bf2f(*zp))); }
                        }
                    }
                }
            }
        }
        if (PASS2) {
            __syncthreads();
            bf16_t* merged = (bf16_t*)(p->ws + WS_R3); const float* nw = p->norm_lru_w + l * DLRU;
            const f32x4 w0 = *(const f32x4*)(nw + F.lane * 8), w1 = *(const f32x4*)(nw + F.lane * 8 + 4);
#pragma unroll
            for (int q = 0; q < 8; ++q) { const int t = F.wave * 8 + q;
                const u32x4 zv = *(const LAS u32x4*)(zb + t * XCP + F.lane * 16);
                float z[8];
#pragma unroll
                for (int e = 0; e < 4; ++e) { z[2 * e] = __uint_as_float(zv[e] << 16); z[2 * e + 1] = __uint_as_float(zv[e] & 0xFFFF0000u); }
                float ss = 0.f;
#pragma unroll
                for (int e = 0; e < 8; ++e) ss += z[e] * z[e];
                ss = wave_sum(ss); const float rstd = rsqrtf(ss * (1.0f / DLRU) + NORM_EPS);
                u32x4 o; o[0] = cvt_pk_bf16(z[0] * rstd * w0[0], z[1] * rstd * w0[1]); o[1] = cvt_pk_bf16(z[2] * rstd * w0[2], z[3] * rstd * w0[3]);
                o[2] = cvt_pk_bf16(z[4] * rstd * w1[0], z[5] * rstd * w1[1]); o[3] = cvt_pk_bf16(z[6] * rstd * w1[2], z[7] * rstd * w1[3]);
                *(u32x4*)(merged + (size_t)(row0 + t) * DM + F.lane * 8) = o; }
        }
        __syncthreads();
    }
}

typedef __bf16 bf16v8 __attribute__((ext_vector_type(8)));
typedef float f32x8 __attribute__((ext_vector_type(8)));
__device__ __forceinline__ bf16x8 pk8(float a0, float a1, float a2, float a3, float a4, float a5, float a6, float a7) {
    const f32x8 w = {a0, a1, a2, a3, a4, a5, a6, a7}; return __builtin_bit_cast(bf16x8, __builtin_convertvector(w, bf16v8)); }
#define PACK_STEP(x, s) pk8((x)[8 * (s)], (x)[8 * (s) + 1], (x)[8 * (s) + 2], (x)[8 * (s) + 3], (x)[8 * (s) + 4], (x)[8 * (s) + 5], (x)[8 * (s) + 6], (x)[8 * (s) + 7])
__device__ __forceinline__ int crow(int reg, int hh) { return (reg & 3) + 8 * (reg >> 2) + 4 * hh; }
template <int KIND> __device__ __forceinline__ bf16x8 mk_const(int ks, int hh, int r) {
    bf16x8 v;
#pragma unroll
    for (int j = 0; j < 8; ++j) { const int kn = 16 * ks + 8 * hh + j, kp = 16 * ks + 8 * (j >> 2) + 4 * hh + (j & 3);
        const bool on = KIND == 0 ? (kn <= r) : KIND == 1 ? (kn > r) : KIND == 2 ? (kn == r) : (kp == r);
        v[j] = on ? (short)0x3F80 : (short)0; }
    return v;
}
constexpr int HG_TASKS = NB * 8 * 2 * 32;
constexpr int HG_WLDS = 12288;
template <bool PASS2>
__device__ __forceinline__ void phase_hgrn(KParams p, const Ctx& F, int l) {
    const bf16_t* proj = (const bf16_t*)(p->ws + WS_R1);
    float* Usum = (float*)(p->ws + WS_R2); float* Dsum = Usum + (size_t)HG_TASKS * 4096;
    float* osc = (float*)(p->ws + WS_XA);
    int lz = F.lane; asm volatile("" : "+v"(lz));
    const int r = lz & 31, hh = lz >> 5;
    LAS unsigned char* wl = F.lds + F.wave * HG_WLDS;
    const LAS unsigned char* rdA = wl + (8 * hh) * 128 + r * 2;
    const LAS unsigned char* rdV = wl + 8192 + (4 * hh) * 128 + r * 2;
    for (int wg = blockIdx.x; wg < 256; wg += F.G) {
        const int b = wg >> 6, h = (wg >> 3) & 7, g = wg & 7;
        const int dir = F.wave & 1, tr = g * 4 + (F.wave >> 1);
        const int task = ((b * 8 + h) * 2 + dir) * 32 + tr;
        const int r0 = b * SEQ + tr * 128;
        const int fcol = (dir == 0 ? 1536 : 2048) + h * 64;
        const float lb0 = hgrn_lb(p, l, h * 64 + r), lb1 = hgrn_lb(p, l, h * 64 + 32 + r);
        f32x16 S[2][2];
#pragma unroll
        for (int a = 0; a < 2; ++a) {
#pragma unroll
            for (int e = 0; e < 16; ++e) { S[a][0][e] = 0.f; S[a][1][e] = 0.f; } }
        if (PASS2) {
#pragma unroll
            for (int a = 0; a < 2; ++a)
#pragma unroll
                for (int c = 0; c < 2; ++c)
#pragma unroll
                    for (int e = 0; e < 16; ++e) S[a][c][e] = *(const float*)((const char*)Usum + ((unsigned)(task * 4096 + lz) * 4u + (unsigned)(((a * 2 + c) * 16 + e) * 256)));
        }
#pragma unroll 1
        for (int ci = 0; ci < 4; ++ci) {
            const int rbase = dir == 0 ? r0 + 32 * ci : r0 + 127 - 32 * ci, sg = dir == 0 ? 1 : -1;
            {
                int lq = lz; asm volatile("" : "+v"(lq));
                const int lrow = lq >> 3, lcol = (lq & 7) * 8;
#pragma unroll
                for (int i = 0; i < 4; ++i) { const int tau = 8 * i + lrow; const char* pr = (const char*)proj + (unsigned)(((rbase + sg * tau) * PROJ + h * 64 + lcol) * 2);
                    const u32x4 vf = *(const u32x4*)(pr + (fcol - h * 64) * 2), vv = *(const u32x4*)(pr + 2560 * 2);
                    *(LAS u32x4*)(wl + tau * 128 + lcol * 2) = vf; *(LAS u32x4*)(wl + 8192 + tau * 128 + lcol * 2) = vv;
                    if (PASS2) { const u32x4 vq = *(const u32x4*)(pr + 1024 * 2); *(LAS u32x4*)(wl + 4096 + tau * 128 + lcol * 2) = vq; } }
            }
            __builtin_amdgcn_sched_barrier(0);
#define LOAD_VP(c, ks, dst) do { _Pragma("unroll") for (int j = 0; j < 8; ++j) (dst)[j] = (short)*(const LAS bf16_t*)(rdV + (16 * (ks) + 8 * (j >> 2) + (j & 3)) * 128 + 64 * (c)); } while (0)
            f32x16 O[2], sc;
            if (PASS2) {
#pragma unroll
                for (int e = 0; e < 16; ++e) { O[0][e] = 0.f; O[1][e] = 0.f; sc[e] = 0.f; } }
#pragma unroll
            for (int a = 0; a < 2; ++a) {
                const float lbv = a == 0 ? lb0 : lb1;
                bf16x8 Ahi[2], Alo[2];
                f32x16 kT, qT;
#pragma unroll
                for (int e = 0; e < 16; ++e) { kT[e] = 0.f; qT[e] = 0.f; }
#pragma unroll
                for (int ks = 0; ks < 2; ++ks) {
                    float lf[8], kk[8];
#pragma unroll
                    for (int j = 0; j < 8; ++j) { const float fl = bf2f(*(const LAS bf16_t*)(rdA + (16 * ks + j) * 128 + 64 * a));
                        const float f = lbv + (1.0f - lbv) * sigmoidf_(fl);
                        lf[j] = fmaxf(__logf(f), -80.0f); kk[j] = 1.0f - f; }
                    Ahi[ks] = pk8(lf[0], lf[1], lf[2], lf[3], lf[4], lf[5], lf[6], lf[7]);
                    float lo[8];
#pragma unroll
                    for (int j = 0; j < 8; ++j) lo[j] = lf[j] - bf2f((bf16_t)Ahi[ks][j]);
                    Alo[ks] = pk8(lo[0], lo[1], lo[2], lo[3], lo[4], lo[5], lo[6], lo[7]);
                    const bf16x8 Ak = pk8(kk[0], kk[1], kk[2], kk[3], kk[4], kk[5], kk[6], kk[7]);
                    const bf16x8 Id = mk_const<2>(ks, hh, r);
                    kT = MFMA32(Ak, Id, kT);
                    if (PASS2) { bf16x8 Aq;
#pragma unroll
                        for (int j = 0; j < 8; ++j) Aq[j] = (short)*(const LAS bf16_t*)(rdA + 4096 + (16 * ks + j) * 128 + 64 * a);
                        qT = MFMA32(Aq, Id, qT); }
                }
                __builtin_amdgcn_sched_barrier(0);
                if (PASS2) {
                    f32x16 bT;
#pragma unroll
                    for (int e = 0; e < 16; ++e) bT[e] = 0.f;
#pragma unroll
                    for (int ks = 0; ks < 2; ++ks) { const bf16x8 Mle = mk_const<0>(ks, hh, r); bT = MFMA32(Ahi[ks], Mle, bT); bT = MFMA32(Alo[ks], Mle, bT); }
#pragma unroll
                    for (int e = 0; e < 16; ++e) bT[e] = qT[e] * __expf(bT[e]);
#pragma unroll
                    for (int s2 = 0; s2 < 2; ++s2) { const bf16x8 Qtp = PACK_STEP(bT, s2);
#pragma unroll
                        for (int c = 0; c < 2; ++c) O[c] = MFMA32(Qtp, PACK_STEP(S[a][c], s2), O[c]); }
                    __builtin_amdgcn_sched_barrier(0);
                }
                bf16x8 Kh0, Kh1;
                {
                    f32x16 RT;
#pragma unroll
                    for (int e = 0; e < 16; ++e) RT[e] = 0.f;
#pragma unroll
                    for (int ks = 0; ks < 2; ++ks) { const bf16x8 Mgt = mk_const<1>(ks, hh, r); RT = MFMA32(Ahi[ks], Mgt, RT); RT = MFMA32(Alo[ks], Mgt, RT); }
#pragma unroll
                    for (int e = 0; e < 16; ++e) { kT[e] *= __expf(RT[e]); if (PASS2) qT[e] *= __expf(fminf(-RT[e], 80.0f)); }
                    Kh0 = PACK_STEP(kT, 0); Kh1 = PACK_STEP(kT, 1);
                    if (PASS2) { sc = MFMA32(Kh0, PACK_STEP(qT, 0), sc); sc = MFMA32(Kh1, PACK_STEP(qT, 1), sc); }
                    __builtin_amdgcn_sched_barrier(0);
                }
                {
                    f32x16 CT;
#pragma unroll
                    for (int e = 0; e < 16; ++e) CT[e] = 0.f;
#pragma unroll
                    for (int ks = 0; ks < 2; ++ks) { bf16x8 One;
#pragma unroll
                        for (int j = 0; j < 8; ++j) One[j] = (short)0x3F80;
                        CT = MFMA32(Ahi[ks], One, CT); CT = MFMA32(Alo[ks], One, CT); }
#pragma unroll
                    for (int e = 0; e < 16; ++e) { const float dd = __expf(CT[e]); S[a][0][e] *= dd; S[a][1][e] *= dd; if (!PASS2) CT[e] = dd; }
                    if (!PASS2 && r == 0) {
#pragma unroll
                        for (int e = 0; e < 16; ++e) Dsum[((size_t)task * 4 + ci) * 64 + 32 * a + crow(e, hh)] = CT[e]; }
                    __builtin_amdgcn_sched_barrier(0);
                }
                {
                    f32x16 Ks;
#pragma unroll
                    for (int e = 0; e < 16; ++e) Ks[e] = 0.f;
                    Ks = MFMA32(Kh0, mk_const<3>(0, hh, r), Ks); Ks = MFMA32(Kh1, mk_const<3>(1, hh, r), Ks);
#pragma unroll
                    for (int ks = 0; ks < 2; ++ks) { const bf16x8 Ksp = PACK_STEP(Ks, ks);
#pragma unroll
                        for (int c = 0; c < 2; ++c) { bf16x8 Vp; LOAD_VP(c, ks, Vp); S[a][c] = MFMA32(Ksp, Vp, S[a][c]); } }
                    __builtin_amdgcn_sched_barrier(0);
                }
            }
            if (PASS2) {
#pragma unroll
                for (int e = 0; e < 16; ++e) sc[e] = (crow(e, hh) <= r) ? sc[e] : 0.f;
#pragma unroll
                for (int ks = 0; ks < 2; ++ks) { const bf16x8 Pp = PACK_STEP(sc, ks);
#pragma unroll
                    for (int c = 0; c < 2; ++c) { bf16x8 Vp; LOAD_VP(c, ks, Vp); O[c] = MFMA32(Pp, Vp, O[c]); } }
                int lq2 = lz; asm volatile("" : "+v"(lq2));
                const int r2 = lq2 & 31, hh2 = lq2 >> 5;
#pragma unroll
                for (int c = 0; c < 2; ++c)
#pragma unroll
                    for (int e = 0; e < 16; ++e) *(float*)((char*)osc + (unsigned)((((dir * MTOK + rbase + sg * crow(e, hh2)) * DHG) + h * 64 + 32 * c + r2) * 4)) = O[c][e];
            }
#undef LOAD_VP
        }
        if (!PASS2) {
#pragma unroll
            for (int a = 0; a < 2; ++a)
#pragma unroll
                for (int c = 0; c < 2; ++c)
#pragma unroll
                    for (int e = 0; e < 16; ++e) *(float*)((char*)Usum + ((unsigned)(task * 4096 + lz) * 4u + (unsigned)(((a * 2 + c) * 16 + e) * 256))) = S[a][c][e];
        } else {
            asm volatile("s_waitcnt vmcnt(0)" ::: "memory");
            __syncthreads();
            bf16_t* merged = (bf16_t*)(p->ws + WS_R3);
            const int ch4 = h * 64 + (F.lane & 15) * 4; const f32x4 nw4 = *(const f32x4*)(p->norm_hgrn_w + l * DHG + ch4);
#pragma unroll 4
            for (int i = 0; i < 16; ++i) { const int row = b * SEQ + g * 512 + F.wave * 64 + i * 4 + (F.lane >> 4);
                const f32x4 of = *(const f32x4*)((const char*)osc + (unsigned)((row * DHG + ch4) * 4)), ob = *(const f32x4*)((const char*)osc + (unsigned)(((MTOK + row) * DHG + ch4) * 4));
                const u32x2 gq = *(const u32x2*)((const char*)proj + (unsigned)((row * PROJ + 3072 + ch4) * 2));
                const f32x4 ot = of + ob;
                float ms = ot[0] * ot[0] + ot[1] * ot[1] + ot[2] * ot[2] + ot[3] * ot[3];
                ms += __shfl_xor(ms, 1, 64); ms += __shfl_xor(ms, 2, 64); ms += __shfl_xor(ms, 4, 64); ms += __shfl_xor(ms, 8, 64);
                const float rs = rsqrtf(ms * (1.0f / 64.0f) + NORM_EPS);
                const float g0 = __uint_as_float(gq[0] << 16), g1 = __uint_as_float(gq[0] & 0xFFFF0000u), g2 = __uint_as_float(gq[1] << 16), g3 = __uint_as_float(gq[1] & 0xFFFF0000u);
                u32x2 o; o[0] = cvt_pk_bf16(ot[0] * rs * nw4[0] * siluf_(g0), ot[1] * rs * nw4[1] * siluf_(g1)); o[1] = cvt_pk_bf16(ot[2] * rs * nw4[2] * siluf_(g2), ot[3] * rs * nw4[3] * siluf_(g3));
                *(u32x2*)((char*)merged + (unsigned)((row * DM + DLRU + ch4) * 2)) = o; }
            __syncthreads();
        }
    }
}

__device__ __forceinline__ void phase_hgrn_prefix(KParams p, const Ctx& F) {
    float* Usum = (float*)(p->ws + WS_R2); const float* Dsum = Usum + (size_t)HG_TASKS * 4096;
    for (int gt = blockIdx.x * NTHREADS + F.tid; gt < 64 * 4096; gt += F.G * NTHREADS) {
        const int seq = gt >> 12, e = gt & 4095, dir = seq & 1;
        const int tile = e >> 10, reg = (e >> 6) & 15, ln = e & 63; const int d = 32 * (tile >> 1) + crow(reg, ln >> 5);
        float s = 0.f;
#pragma unroll 1
        for (int kb = 0; kb < 32; kb += 16) {
            float u16[16], d16[16];
#pragma unroll
            for (int q = 0; q < 16; ++q) { const int k = kb + q, trp = dir == 0 ? k : 31 - k; const size_t tp = (size_t)seq * 32 + trp;
                u16[q] = Usum[tp * 4096 + e];
                d16[q] = Dsum[(tp * 4 + 0) * 64 + d] * Dsum[(tp * 4 + 1) * 64 + d] * Dsum[(tp * 4 + 2) * 64 + d] * Dsum[(tp * 4 + 3) * 64 + d]; }
#pragma unroll
            for (int q = 0; q < 16; ++q) { const float sin = s; s = d16[q] * s + u16[q]; u16[q] = sin; }
#pragma unroll
            for (int q = 0; q < 16; ++q) { const int k = kb + q, trp = dir == 0 ? k : 31 - k; const size_t tp = (size_t)seq * 32 + trp; Usum[tp * 4096 + e] = u16[q]; }
        }
    }
}

constexpr int RT_PITCH = 2064;
__device__ __forceinline__ void phase_route(KParams p, const Ctx& F, int l) {
    const float* mod = (const float*)(p->ws + WS_MOD) + (size_t)l * NB * 6 * DM;
    const float* xa = (const float*)(p->ws + WS_XA); bf16_t* h2 = (bf16_t*)(p->ws + WS_R2);
    const float* nw = p->norm_ffn_w + l * DM;
    int* cnt = (int*)(p->ws + WS_CTL + CTL_CNT_OFF) + l * NEXP * CNT_STRIDE;
    int* rowcap = (int*)(p->ws + WS_ROWCAP); float* tokw = (float*)(p->ws + WS_TOKW);
    LAS int* hist = (LAS int*)(F.lds + LDS_MISC + 64);
    LAS int* tsel = (LAS int*)(F.lds + LDS_MISC + 1024);
    if (F.tid < 64) hist[F.tid] = 0;
    __syncthreads();
    int ntile = 0;
    const bf16_t* rwh = (const bf16_t*)(p->ws + WS_RWHI) + (size_t)l * 64 * DM; const bf16_t* rwl = (const bf16_t*)(p->ws + WS_RWLO) + (size_t)l * 64 * DM;
    LAS unsigned char* Ah = F.lds; LAS unsigned char* Al = F.lds + 32 * RT_PITCH;
    LAS float* part = (LAS float*)F.lds;
    LAS float* red = (LAS float*)(F.lds + 65536);
    const int r = F.lane & 31, hh = F.lane >> 5;
    for (int tile = blockIdx.x; tile < MTOK / 32; tile += F.G) {
        const int row0 = tile * 32, b = row0 >> 12;
        {
            f32x4 v[4][4]; float ss[4];
#pragma unroll
            for (int i = 0; i < 4; ++i) { const float* xr = xa + (size_t)(row0 + F.wave * 4 + i) * DM; ss[i] = 0.f;
#pragma unroll
                for (int q = 0; q < 4; ++q) v[i][q] = *(const f32x4*)(xr + F.lane * 4 + 256 * q); }
#pragma unroll
            for (int i = 0; i < 4; ++i) {
#pragma unroll
                for (int q = 0; q < 4; ++q) ss[i] += v[i][q][0] * v[i][q][0] + v[i][q][1] * v[i][q][1] + v[i][q][2] * v[i][q][2] + v[i][q][3] * v[i][q][3];
                ss[i] = rsqrtf(wave_sum(ss[i]) * (1.0f / DM) + NORM_EPS); }
#pragma unroll
            for (int q = 0; q < 4; ++q) { const int col = F.lane * 4 + 256 * q;
                const f32x4 w4 = *(const f32x4*)(nw + col), sh = *(const f32x4*)(mod + (size_t)b * 6 * DM + 3 * DM + col), s1 = *(const f32x4*)(mod + (size_t)b * 6 * DM + 4 * DM + col);
                const f32x4 g4 = w4 * (s1 + 1.0f);
#pragma unroll
                for (int i = 0; i < 4; ++i) { const int rl = F.wave * 4 + i;
                    const f32x4 o = v[i][q] * ss[i] * g4 + sh;
                    u32x2 pk; pk[0] = cvt_pk_bf16(o[0], o[1]); pk[1] = cvt_pk_bf16(o[2], o[3]);
                    *(u32x2*)(h2 + (size_t)(row0 + rl) * DM + col) = pk;
                    *(LAS u32x2*)(Ah + rl * RT_PITCH + col * 2) = pk;
                    u32x2 lo; lo[0] = cvt_pk_bf16(o[0] - __uint_as_float(pk[0] << 16), o[1] - __uint_as_float(pk[0] & 0xFFFF0000u));
                    lo[1] = cvt_pk_bf16(o[2] - __uint_as_float(pk[1] << 16), o[3] - __uint_as_float(pk[1] & 0xFFFF0000u));
                    *(LAS u32x2*)(Al + rl * RT_PITCH + col * 2) = lo; } }
        }
        __builtin_amdgcn_sched_barrier(0);
        f32x16 acc[2];
#pragma unroll
        for (int e = 0; e < 16; ++e) { acc[0][e] = 0.f; acc[1][e] = 0.f; }
        {
            bf16x8 bh[8][2];
#pragma unroll
            for (int ks = 0; ks < 8; ++ks)
#pragma unroll
                for (int nt = 0; nt < 2; ++nt) bh[ks][nt] = *(const bf16x8*)(rwh + (size_t)(nt * 32 + r) * DM + F.wave * 128 + ks * 16 + 8 * hh);
            __syncthreads();
#pragma unroll
            for (int ks = 0; ks < 8; ++ks) { const int k0 = F.wave * 128 + ks * 16 + 8 * hh;
                const bf16x8 ah = *(const LAS bf16x8*)(Ah + r * RT_PITCH + k0 * 2), al = *(const LAS bf16x8*)(Al + r * RT_PITCH + k0 * 2);
#pragma unroll
                for (int nt = 0; nt < 2; ++nt) { acc[nt] = MFMA32(ah, bh[ks][nt], acc[nt]); acc[nt] = MFMA32(al, bh[ks][nt], acc[nt]); } }
        }
        __builtin_amdgcn_sched_barrier(0);
        {
            bf16x8 bl[8][2];
#pragma unroll
            for (int ks = 0; ks < 8; ++ks)
#pragma unroll
                for (int nt = 0; nt < 2; ++nt) bl[ks][nt] = *(const bf16x8*)(rwl + (size_t)(nt * 32 + r) * DM + F.wave * 128 + ks * 16 + 8 * hh);
#pragma unroll
            for (int ks = 0; ks < 8; ++ks) { const int k0 = F.wave * 128 + ks * 16 + 8 * hh;
                const bf16x8 ah = *(const LAS bf16x8*)(Ah + r * RT_PITCH + k0 * 2);
#pragma unroll
                for (int nt = 0; nt < 2; ++nt) acc[nt] = MFMA32(ah, bl[ks][nt], acc[nt]); }
        }
        __syncthreads();
#pragma unroll
        for (int nt = 0; nt < 2; ++nt)
#pragma unroll
            for (int e = 0; e < 16; ++e) part[(F.wave * 32 + crow(e, hh)) * 64 + nt * 32 + r] = acc[nt][e];
        __syncthreads();
        {
            const int tk = F.tid >> 4, c4 = (F.tid & 15) * 4; f32x4 sum = (f32x4){0.f, 0.f, 0.f, 0.f};
#pragma unroll
            for (int w = 0; w < 8; ++w) sum += *(const LAS f32x4*)(part + (w * 32 + tk) * 64 + c4);
            *(LAS f32x4*)(red + tk * 64 + c4) = sum;
        }
        __syncthreads();
        if (F.tid < 32) {
            const int row = row0 + F.tid;
            const LAS float* lg = red + F.tid * 64;
            float gl[4];
#pragma unroll
            for (int j = 0; j < 4; ++j) gl[j] = lg[32 + j] + p->rg_b[l * NGRP + j];
            int gi = 0; float gm = gl[0];
#pragma unroll
            for (int j = 1; j < 4; ++j) if (gl[j] > gm) { gm = gl[j]; gi = j; }
            float gs = 0.f;
#pragma unroll
            for (int j = 0; j < 4; ++j) gs += __expf(gl[j] - gm);
            const float pg = 1.0f / gs;
            float el[8];
#pragma unroll
            for (int j = 0; j < 8; ++j) el[j] = lg[gi * 8 + j] + p->re_b[l * NEXP + gi * 8 + j];
            int i0 = 0; float v0 = el[0];
#pragma unroll
            for (int j = 1; j < 8; ++j) if (el[j] > v0) { v0 = el[j]; i0 = j; }
            int i1 = (i0 == 0) ? 1 : 0; float v1 = (i0 == 0) ? el[1] : el[0];
#pragma unroll
            for (int j = 0; j < 8; ++j) if (j != i0 && el[j] > v1) { v1 = el[j]; i1 = j; }
            const float ex = __expf(v1 - v0); const float w0 = pg / (1.0f + ex), w1 = pg * ex / (1.0f + ex);
            const int e0 = gi * 8 + i0, e1 = gi * 8 + i1;
            const int p0 = __hip_atomic_fetch_add(&hist[e0], 1, __ATOMIC_RELAXED, __HIP_MEMORY_SCOPE_WORKGROUP), p1 = __hip_atomic_fetch_add(&hist[e1], 1, __ATOMIC_RELAXED, __HIP_MEMORY_SCOPE_WORKGROUP);
            *(LAS i32x4*)(tsel + (ntile * 32 + F.tid) * 4) = (i32x4){e0, p0, e1, p1};
            *(float2*)(tokw + (size_t)row * 2) = make_float2(w0, w1);
        }
        ++ntile;
        __syncthreads();
    }
    if (F.tid < NEXP) { const int c = hist[F.tid]; hist[32 + F.tid] = c > 0 ? atomicAdd(&cnt[F.tid * CNT_STRIDE], c) : 0; }
    __syncthreads();
    for (int q = F.tid; q < ntile * 32; q += NTHREADS) { const int tile = (int)blockIdx.x + (q >> 5) * F.G, row = tile * 32 + (q & 31);
        const i32x4 t = *(const LAS i32x4*)(tsel + q * 4);
        rowcap[(size_t)t[0] * MTOK + hist[32 + t[0]] + t[1]] = row * 2; rowcap[(size_t)t[2] * MTOK + hist[32 + t[2]] + t[3]] = row * 2 + 1; }
    __syncthreads();
}

constexpr int MOE_MAX_UNITS = 4;
__device__ __forceinline__ void build_tile_table(KParams p, const Ctx& F, int l) {
    LAS int* tst = (LAS int*)(F.lds + LDS_MISC + 64);
    LAS int* ulist = (LAS int*)(F.lds + LDS_MISC + 256);
    LAS int* utok = (LAS int*)(F.lds + LDS_MISC + 1024);
    LAS float* utw = (LAS float*)(F.lds + LDS_MISC + 5120);
    const int* cnt = (const int*)(p->ws + WS_CTL + CTL_CNT_OFF) + l * NEXP * CNT_STRIDE;
    const int* rowcap = (const int*)(p->ws + WS_ROWCAP); const float* tokw = (const float*)(p->ws + WS_TOKW);
    if (F.tid == 0) { int acc = 0; for (int e = 0; e < NEXP; ++e) { tst[e] = acc; acc += (__hip_atomic_load(cnt + e * CNT_STRIDE, __ATOMIC_RELAXED, __HIP_MEMORY_SCOPE_AGENT) + 255) >> 8; } tst[NEXP] = acc; }
    __syncthreads();
    if (F.tid <= MOE_MAX_UNITS) { const int L = F.tid * F.G + (int)blockIdx.x, tm = tst[NEXP]; int pm = -1, pn = 0, a0 = 0, a1 = 0;
        if (F.tid < MOE_MAX_UNITS && L < tm * 4) { const int mt = L >> 2; int e = 0; for (int k = 1; k < NEXP; ++k) e += (tst[k] <= mt) ? 1 : 0;
            const int it = mt - tst[e], c = __hip_atomic_load(cnt + e * CNT_STRIDE, __ATOMIC_RELAXED, __HIP_MEMORY_SCOPE_AGENT);
            pm = mt; pn = e * 4 + (L & 3); a0 = e * MTOK + it * 256; a1 = c - it * 256 < 256 ? c - it * 256 : 256; }
        ulist[4 * F.tid] = pm; ulist[4 * F.tid + 1] = pn; ulist[4 * F.tid + 2] = a0; ulist[4 * F.tid + 3] = a1; }
    __syncthreads();
    for (int q = F.tid; q < MOE_MAX_UNITS * 256; q += NTHREADS) { const int i = q >> 8, rl = q & 255;
        int v = -1; float w = 0.f;
        if (ulist[4 * i] >= 0 && rl < ulist[4 * i + 3]) { v = rowcap[ulist[4 * i + 2] + rl]; w = tokw[v]; }
        utok[q] = v; utw[q] = w; }
    __syncthreads();
    if (F.tid < MOE_MAX_UNITS) ulist[4 * F.tid + 2] = 256 * F.tid;
    __syncthreads();
}

template <bool FINAL>
__device__ __forceinline__ void phase_combine(KParams p, const Ctx& F, int l, float* xo) {
    const float* mod = (const float*)(p->ws + WS_MOD) + (size_t)l * NB * 6 * DM;
    const float* xa = (const float*)(p->ws + WS_XA); const bf16_t* y = (const bf16_t*)(p->ws + WS_R1 + WS_R1_Y);
    for (int row = F.gwave; row < MTOK; row += F.nwaves) {
        const int b = row >> 12; f32x4 v[4]; float ss = 0.f;
#pragma unroll
        for (int i = 0; i < 4; ++i) { const int col = F.lane * 4 + 256 * i;
            const f32x4 xv = *(const f32x4*)(xa + (size_t)row * DM + col), g = *(const f32x4*)(mod + (size_t)b * 6 * DM + 5 * DM + col);
            const u32x2 y0 = *(const u32x2*)(y + (size_t)(row * 2) * DM + col), y1 = *(const u32x2*)(y + (size_t)(row * 2 + 1) * DM + col);
            f32x4 ys; ys[0] = __uint_as_float(y0[0] << 16) + __uint_as_float(y1[0] << 16); ys[1] = __uint_as_float(y0[0] & 0xFFFF0000u) + __uint_as_float(y1[0] & 0xFFFF0000u);
            ys[2] = __uint_as_float(y0[1] << 16) + __uint_as_float(y1[1] << 16); ys[3] = __uint_as_float(y0[1] & 0xFFFF0000u) + __uint_as_float(y1[1] & 0xFFFF0000u);
            v[i] = xv + g * ys; ss += v[i][0] * v[i][0] + v[i][1] * v[i][1] + v[i][2] * v[i][2] + v[i][3] * v[i][3]; }
        if (FINAL) { ss = wave_sum(ss); const float rstd = rsqrtf(ss * (1.0f / DM) + NORM_EPS);
#pragma unroll
            for (int i = 0; i < 4; ++i) { const int col = F.lane * 4 + 256 * i; const f32x4 w4 = *(const f32x4*)(p->final_w + col); *(f32x4*)(p->out + (size_t)row * DM + col) = v[i] * rstd * w4; }
        } else {
#pragma unroll
            for (int i = 0; i < 4; ++i) *(f32x4*)(xo + (size_t)row * DM + F.lane * 4 + 256 * i) = v[i];
            ss = wave_sum(ss); const float rstd = rsqrtf(ss * (1.0f / DM) + NORM_EPS);
            const float* modn = mod + (size_t)NB * 6 * DM; const float* nwn = p->norm_mix_w + (l + 1) * DM; bf16_t* h = (bf16_t*)(p->ws + WS_R2);
#pragma unroll
            for (int i = 0; i < 4; ++i) { const int col = F.lane * 4 + 256 * i;
                const f32x4 w4 = *(const f32x4*)(nwn + col), sh = *(const f32x4*)(modn + (size_t)b * 6 * DM + col), s1 = *(const f32x4*)(modn + (size_t)b * 6 * DM + DM + col);
                const f32x4 o = v[i] * rstd * w4 * (s1 + 1.0f) + sh;
                u32x2 pk; pk[0] = cvt_pk_bf16(o[0], o[1]); pk[1] = cvt_pk_bf16(o[2], o[3]);
                *(u32x2*)(h + (size_t)row * DM + col) = pk; }
        }
    }
}


__device__ __forceinline__ Ctx make_ctx(LAS unsigned char* lds) {
    int tz = threadIdx.x; asm volatile("" : "+v"(tz));
    Ctx F; F.lds = lds; F.tid = tz; F.lane = tz & 63; F.wave = __builtin_amdgcn_readfirstlane(tz >> 6);
    F.G = gridDim.x; F.gwave = blockIdx.x * NWAVES + F.wave; F.nwaves = F.G * NWAVES; return F;
}

constexpr int PH_PER_LAYER = 10, N_PHASES = 1 + DEPTH * PH_PER_LAYER;
#ifndef DBG_MASK
#define DBG_MASK 0xFFFFFFFFu
#endif
#define IN(k) ((((DBG_MASK) >> ((k) == 0 ? 0 : (((k) - 1) % PH_PER_LAYER) + 1)) & 1u) && lo <= (k) && (k) < hi)
#define SEAM(k) do { if (IN(k) && IN((k) + 1)) xcd_barrier(bar); if constexpr (DBG_TIMEPH == (k)) tstamp[1] = __builtin_amdgcn_s_memrealtime(); } while (0)
#define SITE KParams P = get_params(); const Ctx F = make_ctx(lds);
#ifndef DBG_REPEAT
#define DBG_REPEAT 0u
#endif
#define NREP(k) (1 + (int)(((DBG_REPEAT) >> ((k) == 0 ? 0 : (((k) - 1) % PH_PER_LAYER) + 1)) & 1u))
#ifndef DBG_TIMEPH
#define DBG_TIMEPH (-1)
#endif
#define PHASE(k, ...) { if constexpr (DBG_TIMEPH == (k)) { if (tstamp[0] == 0ull) tstamp[0] = __builtin_amdgcn_s_memrealtime(); } if (IN(k)) { __VA_ARGS__ } if constexpr (NREP(k) == 2) { if (IN(k)) { xcd_barrier(bar); __VA_ARGS__ } } }

template <int l>
__device__ __forceinline__ void run_layer(LAS unsigned char* const lds, const int lo, const int hi, const XcdBarrier& bar, unsigned long long (&tstamp)[2]) {
        const int base = 1 + l * PH_PER_LAYER;
        if constexpr (l == 0) {
            PHASE(base + 0, SITE phase_norm1(P, F, l, P->x);)
            SEAM(base + 0);
        }
        PHASE(base + 1, SITE
            pg8::Gemm g{(const bf16_t*)(P->ws + WS_R2), (const bf16_t*)(P->ws + WS_WIN) + (size_t)l * PROJ * DM, MTOK, PROJ, DM};
            pg8::StaticOrder S; S.init(MTOK, PROJ, F.G, (int)blockIdx.x);
            pg8::EpiBf16 E{(bf16_t*)(P->ws + WS_R1), PROJ};
            pg8::gemm_phase(F.lds, g, S, E);)
        SEAM(base + 1);
        PHASE(base + 2, SITE phase_lru<false>(P, F, l);)
        PHASE(base + 2, SITE phase_hgrn<false>(P, F, l);)
        SEAM(base + 2);
        PHASE(base + 3, SITE phase_lru<true>(P, F, l);)
        if (IN(base + 3)) { SITE phase_hgrn_prefix(P, F); }
        SEAM(base + 3);
        PHASE(base + 4, SITE phase_hgrn<true>(P, F, l);)
        SEAM(base + 4);
        PHASE(base + 5, SITE
            pg8::Gemm g{(const bf16_t*)(P->ws + WS_R3), (const bf16_t*)(P->ws + WS_WOUT) + (size_t)l * DM * DM, MTOK, DM, DM};
            pg8::StaticOrder S; S.init(MTOK, DM, F.G, (int)blockIdx.x);
            pg8::EpiResid E{(l == 0) ? P->x : P->out, (float*)(P->ws + WS_XA), (const float*)(P->ws + WS_MOD) + (size_t)l * NB * 6 * DM + 2 * DM};
            pg8::gemm_phase(F.lds, g, S, E);)
        SEAM(base + 5);
        PHASE(base + 6, SITE phase_route(P, F, l);)
        SEAM(base + 6);
        PHASE(base + 7, SITE
            build_tile_table(P, F, l);
            pg8::Gemm g{(const bf16_t*)(P->ws + WS_R2), (const bf16_t*)(P->ws + WS_WGU) + (size_t)l * NEXP * 1024 * DM, MTOK, NEXP * 1024, DM};
            pg8::MoeOrder S{(const LAS int*)(F.lds + LDS_MISC + 256)};
            pg8::EpiGateUp E{(bf16_t*)(P->ws + WS_R1)};
            pg8::gemm_phase_gather(F.lds, g, S, E, (const LAS int*)(F.lds + LDS_MISC + 1024));)
        SEAM(base + 7);
        PHASE(base + 8, SITE
            build_tile_table(P, F, l);
            pg8::Gemm g{(const bf16_t*)(P->ws + WS_R1), (const bf16_t*)(P->ws + WS_WD) + (size_t)l * NEXP * 1024 * DEXP, MPAD, NEXP * 1024, DEXP};
            pg8::MoeOrder S{(const LAS int*)(F.lds + LDS_MISC + 256)};
            pg8::EpiDown E{(bf16_t*)(P->ws + WS_R1 + WS_R1_Y), (const LAS int*)(F.lds + LDS_MISC + 1024), (const LAS float*)(F.lds + LDS_MISC + 5120)};
            pg8::gemm_phase(F.lds, g, S, E);)
        SEAM(base + 8);
        PHASE(base + 9, SITE if (l == DEPTH - 1) phase_combine<true>(P, F, l, nullptr); else phase_combine<false>(P, F, l, P->out);)
        SEAM(base + 9);
    }

__global__ void __launch_bounds__(NTHREADS, 2) mega(Params p_unused) {
    (void)p_unused;
    extern __shared__ __attribute__((aligned(16))) unsigned char lds_raw[];
    LAS unsigned char* const lds = (LAS unsigned char*)lds_raw;
    int lo, hi; XcdBarrier bar; unsigned long long tstamp[2] = {0ull, 0ull};
    { KParams P = get_params(); lo = (int)P->ph_lo; hi = (int)P->ph_hi;
      if (threadIdx.x < 4) ((LAS unsigned*)(lds + LDS_MISC))[threadIdx.x] = 0u;
      __syncthreads();
      bar.bar = (unsigned*)(P->ws + WS_CTL); bar.x = 0; bar.st = nullptr;
      if (hi - lo > 1) bar = xcd_barrier_post((unsigned*)(P->ws + WS_CTL), (volatile LAS unsigned*)(lds + LDS_MISC)); }

    PHASE(0, SITE phase_prologue(P, F);)
    SEAM(0);
    run_layer<0>(lds, lo, hi, bar, tstamp);
    run_layer<1>(lds, lo, hi, bar, tstamp);
    if constexpr (DBG_TIMEPH >= 0) { if (blockIdx.x == 0 && threadIdx.x == 0) { const unsigned long long dt = (tstamp[1] - tstamp[0]) * 10ull, t0 = __builtin_amdgcn_s_memrealtime();
        while (__builtin_amdgcn_s_memrealtime() - t0 < dt) __builtin_amdgcn_s_sleep(8); } }
#undef IN
#undef SEAM
#undef SITE
}

extern "C" void kernel_launch(void* const* d_in, const int* in_sizes, int n_in, void* d_out, int out_size, void* d_ws, size_t ws_size, hipStream_t stream) {
    static int grid = 0;
    if (grid == 0) {
        if (n_in != 26 || in_sizes[0] != MTOK * DM || out_size != MTOK * DM || ws_size < WS_END) {
            fprintf(stderr, "kernel_launch: unexpected shapes (n_in %d, in0 %d, out %d, ws %zu, need %zu); nothing launched\n", n_in, n_in > 0 ? in_sizes[0] : -1, out_size, ws_size, (size_t)WS_END); grid = -1; return; }
        int dev = 0, cus = 0, per_cu = 0;
        if (hipGetDevice(&dev) != hipSuccess || hipDeviceGetAttribute(&cus, hipDeviceAttributeMultiprocessorCount, dev) != hipSuccess) { fprintf(stderr, "kernel_launch: device query failed\n"); grid = -1; return; }
        if (hipFuncSetAttribute((const void*)mega, hipFuncAttributeMaxDynamicSharedMemorySize, LDS_BYTES) != hipSuccess) { fprintf(stderr, "kernel_launch: hipFuncSetAttribute failed\n"); grid = -1; return; }
        if (hipOccupancyMaxActiveBlocksPerMultiprocessor(&per_cu, (const void*)mega, NTHREADS, LDS_BYTES) != hipSuccess || per_cu < 1)
            fprintf(stderr, "kernel_launch: note: occupancy query reports %d workgroups per CU\n", per_cu);
        (void)hipGetLastError();
        grid = cus;
    }
    if (grid < 0) return;
    if (hipMemsetAsync((char*)d_ws + WS_CTL, 0, CTL_ZERO_BYTES, stream) != hipSuccess) { fprintf(stderr, "kernel_launch: memset failed\n"); return; }
    Params p{};
    const float** pf = (const float**)&p;
    for (int i = 0; i < 26; ++i) pf[i] = (const float*)d_in[i];
    p.out = (float*)d_out; p.ws = (unsigned char*)d_ws;
#if MK_PER_PHASE
    for (int ph = 0; ph < N_PHASES; ++ph) { p.ph_lo = ph; p.ph_hi = ph + 1;
        hipLaunchKernelGGL(mega, dim3(grid), dim3(NTHREADS), LDS_BYTES, stream, p);
        const hipError_t le = hipPeekAtLastError();
        if (le != hipSuccess) { fprintf(stderr, "kernel_launch: launch %d failed: %s\n", ph, hipGetErrorName(le)); break; } }
#else
    p.ph_lo = 0; p.ph_hi = N_PHASES;
    hipLaunchKernelGGL(mega, dim3(grid), dim3(NTHREADS), LDS_BYTES, stream, p);
    const hipError_t le = hipPeekAtLastError();
    if (le != hipSuccess) fprintf(stderr, "kernel_launch: launch failed: %s\n", hipGetErrorName(le));
#endif
}
```

```cpp
#include <hip/hip_runtime.h>
#include <stdint.h>
#include <stdio.h>

#ifndef MK_PER_PHASE
#define MK_PER_PHASE 0
#endif

#define LAS __attribute__((address_space(3)))
typedef unsigned short bf16_t;
typedef short bf16x8 __attribute__((ext_vector_type(8)));
typedef float f32x4 __attribute__((ext_vector_type(4)));
typedef float f32x2 __attribute__((ext_vector_type(2)));
typedef unsigned u32x4 __attribute__((ext_vector_type(4)));
typedef unsigned u32x2 __attribute__((ext_vector_type(2)));
typedef int i32x4 __attribute__((ext_vector_type(4)));

constexpr int NB = 4, SEQ = 4096, DM = 1024, MTOK = NB * SEQ, DEPTH = 2;
constexpr int DLRU = 512, DHG = 512, PROJ = 3584, NEXP = 32, DEXP = 512, NGRP = 4, EPG = 8;
constexpr int MPAD = 40960;
constexpr float NORM_EPS = 1e-6f;
constexpr int NWAVES = 8, NTHREADS = 512;

constexpr size_t WS_CTL = 0;
constexpr size_t CTL_ZERO_BYTES = 32768;
constexpr size_t CTL_CNT_OFF = 16384;
constexpr int CNT_STRIDE = 32;
constexpr size_t WS_MOD = 65536;
constexpr size_t WS_WIN = WS_MOD + 196608;
constexpr size_t WS_WOUT = WS_WIN + (size_t)DEPTH * PROJ * DM * 2;
constexpr size_t WS_WGU = WS_WOUT + (size_t)DEPTH * DM * DM * 2;
constexpr size_t WS_WD = WS_WGU + (size_t)DEPTH * NEXP * 1024 * 1024 * 2;
constexpr size_t WS_R1 = WS_WD + (size_t)DEPTH * NEXP * 1024 * 512 * 2;
constexpr size_t WS_R1_Y = 48u << 20;
constexpr size_t WS_R2 = WS_R1 + (size_t)MTOK * PROJ * 2;
constexpr size_t WS_R3 = WS_R2 + (size_t)MPAD * 512 * 2;
constexpr size_t WS_XA = WS_R3 + (size_t)MTOK * DM * 2;
constexpr size_t WS_TOKW = WS_XA + (size_t)MTOK * DM * 4;
constexpr size_t WS_ROWCAP = WS_TOKW + (size_t)MTOK * 8;
constexpr size_t WS_LRUW = WS_ROWCAP + (size_t)NEXP * MTOK * 4;
constexpr size_t WS_SUMA = WS_LRUW + 524288;
constexpr size_t WS_SUMH = WS_SUMA + 1048576;
constexpr size_t WS_RWHI = WS_SUMH + 1048576;
constexpr size_t WS_RWLO = WS_RWHI + (size_t)DEPTH * 64 * DM * 2;
constexpr size_t WS_END = WS_RWLO + (size_t)DEPTH * 64 * DM * 2;

constexpr int LDS_STAGE = 139264;
constexpr int LDS_MISC = LDS_STAGE;
constexpr int LDS_BYTES = LDS_STAGE + 10240;

#define XB_TMO      128
#define XB_XCNT(j)  (256  + 64 * (j))
#define XB_XSUB(j)  (1280 + 64 * (j))
#define XB_XGEN(j)  (2304 + 64 * (j))
#define XB_TOP      3328
#define XB_TOPGEN   3392
#define XCD_BAR_WORDS 3456
#define XB_SPIN_CAP (1u << 22)

__device__ __forceinline__ unsigned xb_ld(unsigned* p)              { return __hip_atomic_load(p, __ATOMIC_RELAXED, __HIP_MEMORY_SCOPE_AGENT); }
__device__ __forceinline__ unsigned xb_add(unsigned* p, unsigned v) { return __hip_atomic_fetch_add(p, v, __ATOMIC_RELAXED, __HIP_MEMORY_SCOPE_AGENT); }
__device__ __forceinline__ unsigned xb_xcc_id() { return (unsigned)__builtin_amdgcn_s_getreg((3 << 11) | 20) & 0xFu; }
#define XB_SPIN(cond, bar) do { unsigned _sp = 0; while (cond) { __builtin_amdgcn_s_sleep(1); \
    if ((++_sp & 255u) == 0u) { if (xb_ld(&(bar)[XB_TMO])) break; if (_sp > XB_SPIN_CAP) { atomicAdd(&(bar)[XB_TMO], 1u); break; } } } } while (0)

struct XcdBarrier { unsigned* bar; unsigned x; volatile LAS unsigned* st; };

__device__ __forceinline__ XcdBarrier xcd_barrier_post(unsigned* bar, volatile LAS unsigned* st) {
    XcdBarrier b; b.bar = bar; b.x = xb_xcc_id(); b.st = st;
    if (threadIdx.x == 0) (void)xb_add(&bar[XB_XCNT(b.x)], 1u);
    return b;
}
__device__ __forceinline__ void xcd_barrier_complete(unsigned* bar, unsigned x, unsigned& nloc, unsigned& nx) {
    const unsigned G = gridDim.x * gridDim.y * gridDim.z;
    unsigned sum, cnt, mine, sp = 0u;
    for (;;) {
        sum = 0u; cnt = 0u; mine = 0u;
#pragma unroll
        for (unsigned j = 0; j < 16; ++j) { const unsigned c = xb_ld(&bar[XB_XCNT(j)]); sum += c; cnt += (c > 0u) ? 1u : 0u; mine = (j == x) ? c : mine; }
        if (sum == G) break;
        __builtin_amdgcn_s_sleep(1);
        if ((++sp & 255u) == 0u) { if (xb_ld(&bar[XB_TMO])) break; if (sp > XB_SPIN_CAP) { atomicAdd(&bar[XB_TMO], 1u); break; } }
    }
    nloc = mine > 0u ? mine : 1u; nx = cnt > 0u ? cnt : 1u;
}
__device__ __forceinline__ void xcd_barrier(const XcdBarrier& b) {
    asm volatile("s_waitcnt vmcnt(0)" ::: "memory");
    __syncthreads();
    if (threadIdx.x == 0) {
        unsigned* bar = b.bar;
        __builtin_amdgcn_s_waitcnt(0);
        unsigned nloc = b.st[0], nx = b.st[1];
        if (nloc == 0u) { xcd_barrier_complete(bar, b.x, nloc, nx); b.st[0] = nloc; b.st[1] = nx; }
        const unsigned old = xb_add(&bar[XB_XSUB(b.x)], 1u);
        const unsigned gen = old / nloc;
        if (old + 1u == (gen + 1u) * nloc) {
            __builtin_amdgcn_fence(__ATOMIC_RELEASE, "agent");
            asm volatile("s_waitcnt vmcnt(0)" ::: "memory");
            const unsigned og = xb_add(&bar[XB_TOP], 1u);
            const unsigned tg = og / nx;
            if (og + 1u == (tg + 1u) * nx) xb_add(&bar[XB_TOPGEN], 1u);
            else XB_SPIN(xb_ld(&bar[XB_TOPGEN]) == tg, bar);
            __builtin_amdgcn_fence(__ATOMIC_ACQUIRE, "agent");
            xb_add(&bar[XB_XGEN(b.x)], 1u);
            asm volatile("s_waitcnt vmcnt(0)" ::: "memory");
        } else {
            XB_SPIN(xb_ld(&bar[XB_XGEN(b.x)]) == gen, bar);
            __builtin_amdgcn_fence(__ATOMIC_ACQUIRE, "agent");
            asm volatile("s_waitcnt vmcnt(0)" ::: "memory");
        }
    }
    __syncthreads();
}

#ifndef DBG_TA
#define DBG_TA (-1)
#endif
#ifndef DBG_TB
#define DBG_TB (-1)
#endif
#define TP(n, ldsbase) do { if ((DBG_TA == (n) || DBG_TB == (n)) && blockIdx.x == 0 && threadIdx.x == 0) { LAS unsigned long long* ts_ = (LAS unsigned long long*)((ldsbase) + LDS_MISC + 32); \
    const unsigned long long now_ = __builtin_amdgcn_s_memrealtime(); if (DBG_TA == (n) && ts_[0] == 0ull) ts_[0] = now_; if (DBG_TB == (n)) ts_[1] = now_; } } while (0)
__device__ __forceinline__ float bf2f(bf16_t b) { return __uint_as_float(((unsigned)b) << 16); }
__device__ __forceinline__ bf16_t f2bf(float f) { unsigned u = __float_as_uint(f); u += 0x7FFFu + ((u >> 16) & 1u); return (bf16_t)(u >> 16); }
__device__ __forceinline__ unsigned cvt_pk_bf16(float lo, float hi) { unsigned r; asm volatile("v_cvt_pk_bf16_f32 %0, %1, %2" : "=v"(r) : "v"(lo), "v"(hi)); return r; }
__device__ __forceinline__ void st16_wt(void* p, u32x4 v) { asm volatile("global_store_dwordx4 %0, %1, off sc1\n\ts_nop 1" :: "v"(p), "v"(v) : "memory"); }
__device__ __forceinline__ float wave_sum(float v) {
#pragma unroll
    for (int m = 32; m >= 1; m >>= 1) v += __shfl_xor(v, m, 64);
    return v;
}
#define LOG2E_F 1.4426950408889634f
__device__ __forceinline__ float fexp2(float x) { return __builtin_amdgcn_exp2f(x); }
__device__ __forceinline__ float flog2(float x) { return __builtin_amdgcn_logf(x); }
__device__ __forceinline__ float frcp(float x) { return __builtin_amdgcn_rcpf(x); }
__device__ __forceinline__ float sigmoidf_(float x) { return frcp(1.0f + fexp2(-LOG2E_F * x)); }
__device__ __forceinline__ float siluf_(float x) { return x * sigmoidf_(x); }
__device__ __forceinline__ float gelu_tanh(float x) {
    const float u2 = 1.5957691216057308f * (x + 0.044715f * x * x * x);
    return x * sigmoidf_(u2);
}
__device__ __forceinline__ float rdlane(float v, int l) { return __int_as_float(__builtin_amdgcn_readlane(__float_as_int(v), l)); }

namespace pg8 {
constexpr int BM = 256, BK = 64, HALF = 128, HTB = HALF * BK * 2, STAGE_BYTES = 8 * HTB, NXCD = 8, WGM = 8;
__host__ __device__ __forceinline__ int lds_byte(int r, int c) { const int st = (r >> 4) * 2 + (c >> 5), rr = r & 15, cc = c & 31, ob = rr * 64 + cc * 2; return st * 1024 + (ob ^ (((ob >> 9) & 1) << 5)); }
__host__ __device__ __forceinline__ void stage_rc(int b, int& R, int& C) { const int st = b / 1024, sb = b % 1024, swz = sb ^ (((sb >> 9) & 1) << 5); R = (st >> 1) * 16 + swz / 64; C = (st & 1) * 32 + (swz % 64) / 2; }
__host__ __device__ __forceinline__ int perm32(int rho) { const int n = rho >> 4, i = rho & 15; return 8 * (i >> 2) + 4 * n + (i & 3); }

struct Unit { int pm, pn, aux0, aux1; };
struct Gemm { const bf16_t* A; const bf16_t* Bt; int M, N, K; };

struct StaticOrder {
    int nM, nN, nwg, G, c;
    __host__ __device__ void init(int M, int N, int G_, int c_) { nM = M / BM; nN = N / BM; nwg = nM * nN; G = G_; c = c_; }
    __host__ __device__ bool next(int i, Unit& u) const {
        const long L = (long)i * G + c; if (L >= nwg) return false;
        int wgid = (int)L; { const int q = nwg / NXCD, r = nwg % NXCD, xcd = wgid % NXCD, off = wgid / NXCD; wgid = (xcd < r ? xcd * (q + 1) : r * (q + 1) + (xcd - r) * q) + off; }
        const int nig = WGM * nN, gid = wgid / nig, fm = gid * WGM, gsz = (nM - fm) < WGM ? (nM - fm) : WGM;
        u.pm = fm + ((wgid % nig) % gsz); u.pn = (wgid % nig) / gsz; u.aux0 = 0; u.aux1 = 0; return true;
    }
    __device__ __forceinline__ void a_ready(const Unit&) const {}
    __device__ __forceinline__ void done(const Unit&) const {}
};

struct MoeOrder {
    const LAS int* ulist;
    __device__ __forceinline__ bool next(int i, Unit& u) const {
        const int pm = __builtin_amdgcn_readfirstlane(ulist[4 * i]); if (pm < 0) return false;
        u.pm = pm; u.pn = __builtin_amdgcn_readfirstlane(ulist[4 * i + 1]); u.aux0 = __builtin_amdgcn_readfirstlane(ulist[4 * i + 2]); u.aux1 = __builtin_amdgcn_readfirstlane(ulist[4 * i + 3]); return true;
    }
    __device__ __forceinline__ void a_ready(const Unit&) const {}
    __device__ __forceinline__ void done(const Unit&) const {}
};

struct EpiBf16 {
    static constexpr bool PERM = true;
    bf16_t* O; int ldc;
    __device__ __forceinline__ void operator()(const f32x4 (&acc)[2][2][4][2], const Unit& u, int wr, int wc, int fr, int fq) const {
        const int row0 = u.pm * BM + wr * 64 + fr, col0 = u.pn * BM + wc * 32 + 8 * fq;
#pragma unroll
        for (int ai = 0; ai < 2; ++ai)
#pragma unroll
            for (int m = 0; m < 4; ++m) { bf16_t* rowp = O + (size_t)(row0 + ai * HALF + m * 16) * ldc + col0;
#pragma unroll
                for (int bj = 0; bj < 2; ++bj) { const f32x4 v0 = acc[ai][bj][m][0], v1 = acc[ai][bj][m][1];
                    u32x4 o; o[0] = cvt_pk_bf16(v0[0], v0[1]); o[1] = cvt_pk_bf16(v0[2], v0[3]); o[2] = cvt_pk_bf16(v1[0], v1[1]); o[3] = cvt_pk_bf16(v1[2], v1[3]);
                    st16_wt(rowp + bj * HALF, o); } }
    }
};
template <bool XIN_F32>
struct EpiResid {
    static constexpr bool PERM = true;
    const void* XI; bf16_t* XO; const float* gate;
    __device__ __forceinline__ void operator()(const f32x4 (&acc)[2][2][4][2], const Unit& u, int wr, int wc, int fr, int fq) const {
        const int row0 = u.pm * BM + wr * 64 + fr, col0 = u.pn * BM + wc * 32 + 8 * fq;
        const int b = (u.pm * BM) / SEQ;
        f32x4 gv[2][2];
#pragma unroll
        for (int bj = 0; bj < 2; ++bj)
#pragma unroll
            for (int n = 0; n < 2; ++n) gv[bj][n] = *(const f32x4*)(gate + (size_t)b * 6 * DM + col0 + bj * HALF + n * 4);
#pragma unroll
        for (int ai = 0; ai < 2; ++ai)
#pragma unroll
            for (int m = 0; m < 4; ++m) { const size_t ro = (size_t)(row0 + ai * HALF + m * 16) * DM + col0;
#pragma unroll
                for (int bj = 0; bj < 2; ++bj) { f32x4 x0, x1;
                    if (XIN_F32) { x0 = *(const f32x4*)((const float*)XI + ro + bj * HALF); x1 = *(const f32x4*)((const float*)XI + ro + bj * HALF + 4); }
                    else { const u32x4 xv = *(const u32x4*)((const bf16_t*)XI + ro + bj * HALF);
                        x0 = (f32x4){__uint_as_float(xv[0] << 16), __uint_as_float(xv[0] & 0xFFFF0000u), __uint_as_float(xv[1] << 16), __uint_as_float(xv[1] & 0xFFFF0000u)};
                        x1 = (f32x4){__uint_as_float(xv[2] << 16), __uint_as_float(xv[2] & 0xFFFF0000u), __uint_as_float(xv[3] << 16), __uint_as_float(xv[3] & 0xFFFF0000u)}; }
                    const f32x4 v0 = x0 + gv[bj][0] * acc[ai][bj][m][0], v1 = x1 + gv[bj][1] * acc[ai][bj][m][1];
                    u32x4 o; o[0] = cvt_pk_bf16(v0[0], v0[1]); o[1] = cvt_pk_bf16(v0[2], v0[3]); o[2] = cvt_pk_bf16(v1[0], v1[1]); o[3] = cvt_pk_bf16(v1[2], v1[3]);
                    st16_wt(XO + ro + bj * HALF, o); } }
    }
};
struct EpiGateUp {
    static constexpr bool PERM = true;
    bf16_t* H;
    __device__ __forceinline__ void operator()(const f32x4 (&acc)[2][2][4][2], const Unit& u, int wr, int wc, int fr, int fq) const {
        const int row0 = u.pm * BM + wr * 64 + fr, col0 = (u.pn & 3) * 128 + wc * 32 + 8 * fq;
#pragma unroll
        for (int ai = 0; ai < 2; ++ai)
#pragma unroll
            for (int m = 0; m < 4; ++m) { bf16_t* rowp = H + (size_t)(row0 + ai * HALF + m * 16) * DEXP + col0;
                float h[8];
#pragma unroll
                for (int n = 0; n < 2; ++n)
#pragma unroll
                    for (int q = 0; q < 4; ++q) { const float g = acc[ai][0][m][n][q], up = acc[ai][1][m][n][q]; h[n * 4 + q] = g * __builtin_amdgcn_rcpf(1.0f + __builtin_amdgcn_exp2f(-1.4426950408889634f * g)) * up; }
                u32x4 o; o[0] = cvt_pk_bf16(h[0], h[1]); o[1] = cvt_pk_bf16(h[2], h[3]); o[2] = cvt_pk_bf16(h[4], h[5]); o[3] = cvt_pk_bf16(h[6], h[7]);
                st16_wt(rowp, o); }
    }
};
struct EpiDown {
    static constexpr bool PERM = true;
    bf16_t* Y; const LAS int* utok; const LAS float* utw;
    __device__ __forceinline__ void operator()(const f32x4 (&acc)[2][2][4][2], const Unit& u, int wr, int wc, int fr, int fq) const {
        const int rl0 = u.aux0 + wr * 64 + fr, col0 = (u.pn & 3) * BM + wc * 32 + 8 * fq;
#pragma unroll
        for (int ai = 0; ai < 2; ++ai)
#pragma unroll
            for (int m = 0; m < 4; ++m) { const int rl = rl0 + ai * HALF + m * 16; const int rt = utok[rl];
                if (rt >= 0) { const float w = utw[rl]; bf16_t* rowp = Y + (size_t)rt * DM + col0;
#pragma unroll
                    for (int bj = 0; bj < 2; ++bj) { const f32x4 v0 = acc[ai][bj][m][0] * w, v1 = acc[ai][bj][m][1] * w;
                        u32x4 o; o[0] = cvt_pk_bf16(v0[0], v0[1]); o[1] = cvt_pk_bf16(v0[2], v0[3]); o[2] = cvt_pk_bf16(v1[0], v1[1]); o[3] = cvt_pk_bf16(v1[2], v1[3]);
                        st16_wt(rowp + bj * HALF, o); } } }
    }
};

template <class Epi, class Sched>
__device__ __forceinline__ void gemm_phase(LAS unsigned char* lds, const Gemm g, const Sched& S, const Epi& E) {
    const int tid = threadIdx.x, wid = __builtin_amdgcn_readfirstlane(tid >> 6), lane = tid & 63, wr = wid >> 2, wc = wid & 3, fr = lane & 15, fq = lane >> 4;
    const int K = g.K, nt = K / BK;
    unsigned voffA[2], voffB[2];
#pragma unroll
    for (int i = 0; i < 2; ++i) { int R, C; stage_rc(tid * 16 + i * 8192, R, C); const int Rb = Epi::PERM ? ((R & ~31) + perm32(R & 31)) : R;
        voffA[i] = (unsigned)(R * K + C) * 2u; voffB[i] = (unsigned)(Rb * K + C) * 2u; }
    const size_t kstep = (size_t)(BK * 2);
    const size_t hstep = (size_t)HALF * K * 2;
    const size_t tstep = 2 * hstep;
    const unsigned ldsw = (unsigned)wid * 1024u;
    const int aoff = lds_byte(wr * 64 + fr, fq * 8), boff = lds_byte(wc * 32 + fr, fq * 8);
#define PG8_SA(b, h) (((b) * 2 + (h)) * HTB)
#define PG8_SB(b, h) ((4 + (b) * 2 + (h)) * HTB)
#define PG8_STAGE(bufoff, gbase, voff) do { _Pragma("unroll") for (int _i = 0; _i < 2; ++_i) \
        __builtin_amdgcn_global_load_lds((const unsigned*)((const char*)(gbase) + (voff)[_i]), (LAS unsigned*)(lds + (bufoff) + ldsw + _i * 8192), 16, 0, 0); } while (0)
#define PG8_LDA(dst, b, h) do { _Pragma("unroll") for (int m = 0; m < 4; ++m) _Pragma("unroll") for (int k = 0; k < 2; ++k) dst[m][k] = *(const LAS bf16x8*)(lds + PG8_SA(b, h) + aoff + m * 2048 + k * 1024); } while (0)
#define PG8_LDB(dst, b, h) do { _Pragma("unroll") for (int n = 0; n < 2; ++n) _Pragma("unroll") for (int k = 0; k < 2; ++k) dst[n][k] = *(const LAS bf16x8*)(lds + PG8_SB(b, h) + boff + n * 2048 + k * 1024); } while (0)
#define PG8_MMA(ai, bj, At, Bt) do { __builtin_amdgcn_s_setprio(1); _Pragma("unroll") for (int m = 0; m < 4; ++m) _Pragma("unroll") for (int n = 0; n < 2; ++n) _Pragma("unroll") for (int k = 0; k < 2; ++k) \
        acc[ai][bj][m][n] = __builtin_amdgcn_mfma_f32_16x16x32_bf16(Bt[n][k], At[m][k], acc[ai][bj][m][n], 0, 0, 0); __builtin_amdgcn_s_setprio(0); } while (0)
#define PG8_WAIT_V(n) asm volatile("s_waitcnt vmcnt(" #n ")" ::: "memory")
#define PG8_WAIT_L(n) asm volatile("s_waitcnt lgkmcnt(" #n ")" ::: "memory")
#define PG8_BAR __builtin_amdgcn_s_barrier()
#define PG8_SCHED __builtin_amdgcn_sched_barrier(0)
    Unit cur, nxt; int ui = 0;
    if (!S.next(0, cur)) return;
    f32x4 acc[2][2][4][2];
#pragma unroll
    for (int a = 0; a < 2; ++a)
#pragma unroll
        for (int b = 0; b < 2; ++b)
#pragma unroll
            for (int m = 0; m < 4; ++m)
#pragma unroll
                for (int n = 0; n < 2; ++n) acc[a][b][m][n] = (f32x4){0.f, 0.f, 0.f, 0.f};
    bf16x8 At[4][2], B0[2][2], B1[2][2];
    const char* cA = (const char*)g.A + (size_t)cur.pm * tstep; const char* cB = (const char*)g.Bt + (size_t)cur.pn * tstep;
    S.a_ready(cur);
    PG8_STAGE(PG8_SB(0, 0), cB, voffB); PG8_STAGE(PG8_SA(0, 0), cA, voffA); PG8_STAGE(PG8_SB(0, 1), cB + hstep, voffB); PG8_STAGE(PG8_SA(0, 1), cA + hstep, voffA);
    if (wr == 1) PG8_BAR;
    PG8_WAIT_V(4); PG8_BAR;
    PG8_STAGE(PG8_SB(1, 0), cB + kstep, voffB); PG8_STAGE(PG8_SA(1, 0), cA + kstep, voffA); PG8_STAGE(PG8_SB(1, 1), cB + hstep + kstep, voffB);
    PG8_WAIT_V(6); PG8_BAR;
    for (;;) {
        const bool has_next = S.next(ui + 1, nxt);
        const bool half1 = !(cur.aux1 > 0 && cur.aux1 <= HALF);
        const char* nA = has_next ? (const char*)g.A + (size_t)nxt.pm * tstep : cA; const char* nB = has_next ? (const char*)g.Bt + (size_t)nxt.pn * tstep : cB;
        for (int t = 0; t < nt; t += 2) {
            const bool last = (t == nt - 2);
            const char* a1 = cA + (size_t)(t + 1) * kstep;
            const char* a2 = last ? nA : cA + (size_t)(t + 2) * kstep; const char* b2 = last ? nB : cB + (size_t)(t + 2) * kstep;
            const char* a3 = a2 + kstep; const char* b3 = b2 + kstep;
            if (last && has_next) S.a_ready(nxt);
            PG8_LDB(B0, 0, 0); PG8_SCHED; PG8_LDA(At, 0, 0); PG8_STAGE(PG8_SA(1, 1), a1 + hstep, voffA);
            PG8_WAIT_L(8); PG8_BAR; PG8_WAIT_L(0); PG8_MMA(0, 0, At, B0); PG8_BAR; PG8_SCHED;
            PG8_LDB(B1, 0, 1); PG8_STAGE(PG8_SB(0, 0), b2, voffB);
            PG8_BAR; PG8_WAIT_L(0); PG8_MMA(0, 1, At, B1); PG8_BAR;
            if (half1) PG8_LDA(At, 0, 1); PG8_STAGE(PG8_SA(0, 0), a2, voffA);
            PG8_BAR; PG8_WAIT_L(0); if (half1) PG8_MMA(1, 0, At, B0); PG8_BAR; PG8_SCHED;
            PG8_STAGE(PG8_SB(0, 1), b2 + hstep, voffB);
            PG8_WAIT_V(6); PG8_BAR; if (half1) PG8_MMA(1, 1, At, B1); PG8_BAR;
            PG8_LDB(B0, 1, 0); PG8_SCHED; PG8_LDA(At, 1, 0); PG8_STAGE(PG8_SA(0, 1), a2 + hstep, voffA);
            PG8_WAIT_L(8); PG8_BAR; PG8_WAIT_L(0); PG8_MMA(0, 0, At, B0); PG8_BAR; PG8_SCHED;
            PG8_LDB(B1, 1, 1); PG8_STAGE(PG8_SB(1, 0), b3, voffB);
            PG8_BAR; PG8_WAIT_L(0); PG8_MMA(0, 1, At, B1); PG8_BAR;
            if (half1) PG8_LDA(At, 1, 1); PG8_STAGE(PG8_SA(1, 0), a3, voffA);
            PG8_BAR; PG8_WAIT_L(0); if (half1) PG8_MMA(1, 0, At, B0); PG8_BAR; PG8_SCHED;
            PG8_STAGE(PG8_SB(1, 1), b3 + hstep, voffB);
            PG8_WAIT_V(6); PG8_BAR; if (half1) PG8_MMA(1, 1, At, B1); PG8_BAR;
        }
        E(acc, cur, wr, wc, fr, fq); S.done(cur);
        if (!has_next) break;
#pragma unroll
        for (int a = 0; a < 2; ++a)
#pragma unroll
            for (int b = 0; b < 2; ++b)
#pragma unroll
                for (int m = 0; m < 4; ++m)
#pragma unroll
                    for (int n = 0; n < 2; ++n) acc[a][b][m][n] = (f32x4){0.f, 0.f, 0.f, 0.f};
        cur = nxt; cA = nA; cB = nB; ++ui;
    }
    PG8_WAIT_V(0);
    if (wr == 0) PG8_BAR;
    PG8_BAR;
#undef PG8_SA
#undef PG8_SB
#undef PG8_STAGE
#undef PG8_LDA
#undef PG8_LDB
#undef PG8_MMA
#undef PG8_WAIT_V
#undef PG8_WAIT_L
#undef PG8_BAR
#undef PG8_SCHED
}
template <class Epi, class Sched>
__device__ __forceinline__ void gemm_phase_gather(LAS unsigned char* lds, const Gemm g, const Sched& S, const Epi& E, const LAS int* utok) {
    const int tid = threadIdx.x, wid = __builtin_amdgcn_readfirstlane(tid >> 6), lane = tid & 63, wr = wid >> 2, wc = wid & 3, fr = lane & 15, fq = lane >> 4;
    const int K = g.K, nt = K / BK;
    unsigned voffB[2]; int rowA[2]; unsigned colA[2];
#pragma unroll
    for (int i = 0; i < 2; ++i) { int R, C; stage_rc(tid * 16 + i * 8192, R, C); const int Rb = Epi::PERM ? ((R & ~31) + perm32(R & 31)) : R;
        rowA[i] = R; colA[i] = (unsigned)C * 2u; voffB[i] = (unsigned)(Rb * K + C) * 2u; }
    unsigned gC[2][2], gN[2][2];
#define PG8_GOFS(dst, ui_) do { _Pragma("unroll") for (int h_ = 0; h_ < 2; ++h_) _Pragma("unroll") for (int i_ = 0; i_ < 2; ++i_) { \
        const int rt_ = utok[256 * (ui_) + h_ * HALF + rowA[i_]]; (dst)[h_][i_] = (unsigned)(((rt_ < 0 ? 0 : rt_) >> 1) * K) * 2u + colA[i_]; } } while (0)
    const size_t kstep = (size_t)(BK * 2);
    const size_t hstep = (size_t)HALF * K * 2;
    const size_t tstep = 2 * hstep;
    const unsigned ldsw = (unsigned)wid * 1024u;
    const int aoff = lds_byte(wr * 64 + fr, fq * 8), boff = lds_byte(wc * 32 + fr, fq * 8);
#define PG8_SA(b, h) (((b) * 2 + (h)) * HTB)
#define PG8_SB(b, h) ((4 + (b) * 2 + (h)) * HTB)
#define PG8_STAGE(bufoff, gbase, voff) do { _Pragma("unroll") for (int _i = 0; _i < 2; ++_i) \
        __builtin_amdgcn_global_load_lds((const unsigned*)((const char*)(gbase) + (voff)[_i]), (LAS unsigned*)(lds + (bufoff) + ldsw + _i * 8192), 16, 0, 0); } while (0)
#define PG8_LDA(dst, b, h) do { _Pragma("unroll") for (int m = 0; m < 4; ++m) _Pragma("unroll") for (int k = 0; k < 2; ++k) dst[m][k] = *(const LAS bf16x8*)(lds + PG8_SA(b, h) + aoff + m * 2048 + k * 1024); } while (0)
#define PG8_LDB(dst, b, h) do { _Pragma("unroll") for (int n = 0; n < 2; ++n) _Pragma("unroll") for (int k = 0; k < 2; ++k) dst[n][k] = *(const LAS bf16x8*)(lds + PG8_SB(b, h) + boff + n * 2048 + k * 1024); } while (0)
#define PG8_MMA(ai, bj, At, Bt) do { __builtin_amdgcn_s_setprio(1); _Pragma("unroll") for (int m = 0; m < 4; ++m) _Pragma("unroll") for (int n = 0; n < 2; ++n) _Pragma("unroll") for (int k = 0; k < 2; ++k) \
        acc[ai][bj][m][n] = __builtin_amdgcn_mfma_f32_16x16x32_bf16(Bt[n][k], At[m][k], acc[ai][bj][m][n], 0, 0, 0); __builtin_amdgcn_s_setprio(0); } while (0)
#define PG8_WAIT_V(n) asm volatile("s_waitcnt vmcnt(" #n ")" ::: "memory")
#define PG8_WAIT_L(n) asm volatile("s_waitcnt lgkmcnt(" #n ")" ::: "memory")
#define PG8_BAR __builtin_amdgcn_s_barrier()
#define PG8_SCHED __builtin_amdgcn_sched_barrier(0)
    Unit cur, nxt; int ui = 0;
    if (!S.next(0, cur)) return;
    f32x4 acc[2][2][4][2];
#pragma unroll
    for (int a = 0; a < 2; ++a)
#pragma unroll
        for (int b = 0; b < 2; ++b)
#pragma unroll
            for (int m = 0; m < 4; ++m)
#pragma unroll
                for (int n = 0; n < 2; ++n) acc[a][b][m][n] = (f32x4){0.f, 0.f, 0.f, 0.f};
    bf16x8 At[4][2], B0[2][2], B1[2][2];
    const char* cA = (const char*)g.A; const char* cB = (const char*)g.Bt + (size_t)cur.pn * tstep;
    PG8_GOFS(gC, 0);
    S.a_ready(cur);
    PG8_STAGE(PG8_SB(0, 0), cB, voffB); PG8_STAGE(PG8_SA(0, 0), cA, gC[0]); PG8_STAGE(PG8_SB(0, 1), cB + hstep, voffB); PG8_STAGE(PG8_SA(0, 1), cA, gC[1]);
    if (wr == 1) PG8_BAR;
    PG8_WAIT_V(4); PG8_BAR;
    PG8_STAGE(PG8_SB(1, 0), cB + kstep, voffB); PG8_STAGE(PG8_SA(1, 0), cA + kstep, gC[0]); PG8_STAGE(PG8_SB(1, 1), cB + hstep + kstep, voffB);
    PG8_WAIT_V(6); PG8_BAR;
    for (;;) {
        const bool has_next = S.next(ui + 1, nxt);
        const bool half1 = !(cur.aux1 > 0 && cur.aux1 <= HALF);
        const char* nB = has_next ? (const char*)g.Bt + (size_t)nxt.pn * tstep : cB;
        if (has_next) PG8_GOFS(gN, ui + 1); else { gN[0][0] = gC[0][0]; gN[0][1] = gC[0][1]; gN[1][0] = gC[1][0]; gN[1][1] = gC[1][1]; }
        for (int t = 0; t < nt; t += 2) {
            const bool last = (t == nt - 2);
            const char* a1 = cA + (size_t)(t + 1) * kstep;
            const char* a2 = last ? cA : cA + (size_t)(t + 2) * kstep; const char* b2 = last ? nB : cB + (size_t)(t + 2) * kstep;
            unsigned g2[2][2];
            g2[0][0] = last ? gN[0][0] : gC[0][0]; g2[0][1] = last ? gN[0][1] : gC[0][1]; g2[1][0] = last ? gN[1][0] : gC[1][0]; g2[1][1] = last ? gN[1][1] : gC[1][1];
            const char* a3 = a2 + kstep; const char* b3 = b2 + kstep;
            if (last && has_next) S.a_ready(nxt);
            PG8_LDB(B0, 0, 0); PG8_SCHED; PG8_LDA(At, 0, 0); PG8_STAGE(PG8_SA(1, 1), a1, gC[1]);
            PG8_WAIT_L(8); PG8_BAR; PG8_WAIT_L(0); PG8_MMA(0, 0, At, B0); PG8_BAR; PG8_SCHED;
            PG8_LDB(B1, 0, 1); PG8_STAGE(PG8_SB(0, 0), b2, voffB);
            PG8_BAR; PG8_WAIT_L(0); PG8_MMA(0, 1, At, B1); PG8_BAR;
            if (half1) PG8_LDA(At, 0, 1); PG8_STAGE(PG8_SA(0, 0), a2, g2[0]);
            PG8_BAR; PG8_WAIT_L(0); if (half1) PG8_MMA(1, 0, At, B0); PG8_BAR; PG8_SCHED;
            PG8_STAGE(PG8_SB(0, 1), b2 + hstep, voffB);
            PG8_WAIT_V(6); PG8_BAR; if (half1) PG8_MMA(1, 1, At, B1); PG8_BAR;
            PG8_LDB(B0, 1, 0); PG8_SCHED; PG8_LDA(At, 1, 0); PG8_STAGE(PG8_SA(0, 1), a2, g2[1]);
            PG8_WAIT_L(8); PG8_BAR; PG8_WAIT_L(0); PG8_MMA(0, 0, At, B0); PG8_BAR; PG8_SCHED;
            PG8_LDB(B1, 1, 1); PG8_STAGE(PG8_SB(1, 0), b3, voffB);
            PG8_BAR; PG8_WAIT_L(0); PG8_MMA(0, 1, At, B1); PG8_BAR;
            if (half1) PG8_LDA(At, 1, 1); PG8_STAGE(PG8_SA(1, 0), a3, g2[0]);
            PG8_BAR; PG8_WAIT_L(0); if (half1) PG8_MMA(1, 0, At, B0); PG8_BAR; PG8_SCHED;
            PG8_STAGE(PG8_SB(1, 1), b3 + hstep, voffB);
            PG8_WAIT_V(6); PG8_BAR; if (half1) PG8_MMA(1, 1, At, B1); PG8_BAR;
        }
        E(acc, cur, wr, wc, fr, fq); S.done(cur);
        if (!has_next) break;
#pragma unroll
        for (int a = 0; a < 2; ++a)
#pragma unroll
            for (int b = 0; b < 2; ++b)
#pragma unroll
                for (int m = 0; m < 4; ++m)
#pragma unroll
                    for (int n = 0; n < 2; ++n) acc[a][b][m][n] = (f32x4){0.f, 0.f, 0.f, 0.f};
        cur = nxt; cB = nB; ++ui;
        gC[0][0] = gN[0][0]; gC[0][1] = gN[0][1]; gC[1][0] = gN[1][0]; gC[1][1] = gN[1][1];
    }
    PG8_WAIT_V(0);
    if (wr == 0) PG8_BAR;
    PG8_BAR;
#undef PG8_GOFS
#undef PG8_SA
#undef PG8_SB
#undef PG8_STAGE
#undef PG8_LDA
#undef PG8_LDB
#undef PG8_MMA
#undef PG8_WAIT_V
#undef PG8_WAIT_L
#undef PG8_BAR
#undef PG8_SCHED
}
}

struct Params {
    const float* x; const float* c; const float* ada_w; const float* ada_b; const float* norm_mix_w; const float* w_in; const float* conv_w; const float* conv_b;
    const float* lru_wa; const float* lru_ba; const float* lru_wx; const float* lru_bx; const float* lru_lambda; const float* norm_lru_w; const float* hgrn_lb;
    const float* norm_hgrn_w; const float* w_out; const float* norm_ffn_w; const float* rg_w; const float* rg_b; const float* re_w; const float* re_b;
    const float* e_gate; const float* e_up; const float* e_down; const float* final_w;
    float* out; unsigned char* ws;
    long long ph_lo, ph_hi;
};

typedef const __attribute__((address_space(4))) Params* KParams;
__device__ __forceinline__ KParams get_params() { KParams q = (KParams)__builtin_amdgcn_kernarg_segment_ptr(); asm volatile("" : "+s"(q)); return q; }

struct Ctx {
    LAS unsigned char* lds; int tid, lane, wave, G, gwave, nwaves;
};

struct CvtDesc { const float* src; bf16_t* dst; int ldn, ldd; };
__device__ __forceinline__ void cvt_load(const Ctx& F, const CvtDesc& d, f32x4 (&v)[16]) {
    const int q = F.lane >> 4, n4 = (F.lane & 15) * 4;
#pragma unroll
    for (int i = 0; i < 16; ++i) { const int k = 8 * (i >> 1) + 2 * q + (i & 1); v[i] = *(const f32x4*)(d.src + (size_t)k * d.ldn + n4); }
}
__device__ __forceinline__ void cvt_store(const Ctx& F, const CvtDesc& d, const f32x4 (&v)[16]) {
    LAS unsigned char* slab = F.lds + F.wave * 8704;
    const int q = F.lane >> 4, n4 = (F.lane & 15) * 4;
#pragma unroll
    for (int p = 0; p < 8; ++p) { const int k0 = 8 * p + 2 * q;
#pragma unroll
        for (int j = 0; j < 4; ++j) *(LAS unsigned*)(slab + (n4 + j) * 136 + k0 * 2) = cvt_pk_bf16(v[2 * p][j], v[2 * p + 1][j]); }
#pragma unroll
    for (int i = 0; i < 16; ++i) { const int n = 4 * i + q, ch = F.lane & 15;
        const u32x2 w = *(const LAS u32x2*)(slab + n * 136 + ch * 8);
        *(u32x2*)(d.dst + (size_t)n * d.ldd + ch * 4) = w; }
}
__device__ __forceinline__ CvtDesc cvt_desc(KParams p, int task) {
    bf16_t* WinT = (bf16_t*)(p->ws + WS_WIN); bf16_t* WoutT = (bf16_t*)(p->ws + WS_WOUT); bf16_t* WguT = (bf16_t*)(p->ws + WS_WGU); bf16_t* WdT = (bf16_t*)(p->ws + WS_WD);
    constexpr int T_IN = 16 * 56, T_OUT = 16 * 16, T_E = NEXP * 128, T_L = T_IN + T_OUT + 3 * T_E;
    const int l = task / T_L; int r = task % T_L; CvtDesc d;
    if (r < T_IN) { const int blk = r >> 3, w = r & 7, kt = (blk / 28) * 4 + (w >> 1), nt = (blk % 28) * 2 + (w & 1);
        d.src = p->w_in + (size_t)l * DM * PROJ + (size_t)kt * 64 * PROJ + nt * 64; d.ldn = PROJ; d.dst = WinT + ((size_t)l * PROJ + nt * 64) * DM + kt * 64; d.ldd = DM;
    } else if (r < T_IN + T_OUT) { r -= T_IN; const int blk = r >> 3, w = r & 7, kt = (blk / 8) * 4 + (w >> 1), nt = (blk % 8) * 2 + (w & 1);
        d.src = p->w_out + (size_t)l * DM * DM + (size_t)kt * 64 * DM + nt * 64; d.ldn = DM; d.dst = WoutT + ((size_t)l * DM + nt * 64) * DM + kt * 64; d.ldd = DM;
    } else if (r < T_IN + T_OUT + 2 * T_E) { r -= T_IN + T_OUT; const int up = r / T_E; r %= T_E; const int e = r / 128, rr = r % 128, blk = rr >> 3, w = rr & 7, kt = (blk / 4) * 4 + (w >> 1), nt = (blk % 4) * 2 + (w & 1), n0 = nt * 64;
        d.src = (up ? p->e_up : p->e_gate) + ((size_t)(l * NEXP + e) * DM + kt * 64) * DEXP + n0; d.ldn = DEXP;
        const size_t drow = (size_t)(l * NEXP + e) * 1024 + 256 * (n0 >> 7) + 128 * up + (n0 & 127);
        d.dst = WguT + drow * DM + kt * 64; d.ldd = DM;
    } else { r -= T_IN + T_OUT + 2 * T_E; const int e = r / 128, rr = r % 128, blk = rr >> 3, w = rr & 7, kt = (blk / 8) * 4 + (w >> 1), nt = (blk % 8) * 2 + (w & 1);
        d.src = p->e_down + ((size_t)(l * NEXP + e) * DEXP + kt * 64) * DM + nt * 64; d.ldn = DM;
        d.dst = WdT + ((size_t)(l * NEXP + e) * 1024 + nt * 64) * DEXP + kt * 64; d.ldd = DEXP;
    }
    return d;
}

__device__ __forceinline__ void phase_convert(KParams p, const Ctx& F) {
    constexpr int NT = DEPTH * (16 * 56 + 16 * 16 + 3 * NEXP * 128);
    int task = F.gwave;
    if (task >= NT) return;
    f32x4 va[16], vb[16];
    CvtDesc da = cvt_desc(p, task), db = da;
    cvt_load(F, da, va);
    for (;;) {
        const int t1 = task + F.nwaves; const bool h1 = t1 < NT;
        if (h1) { db = cvt_desc(p, t1); cvt_load(F, db, vb); }
        cvt_store(F, da, va);
        if (!h1) break;
        const int t2 = t1 + F.nwaves; const bool h2 = t2 < NT;
        if (h2) { da = cvt_desc(p, t2); cvt_load(F, da, va); }
        cvt_store(F, db, vb);
        if (!h2) break;
        task = t2;
    }
}

__device__ __forceinline__ void phase_prologue(KParams p, const Ctx& F) {
    {
        bf16_t* wf = (bf16_t*)(p->ws + WS_LRUW);
        for (int it = blockIdx.x * NTHREADS + F.tid; it < 32768; it += F.G * NTHREADS) {
            const int ln = it & 63, ks = (it >> 6) & 3, ct = (it >> 8) & 1, h = (it >> 9) & 7, m = (it >> 12) & 1, ld = it >> 13;
            const float* src = (m ? p->lru_wx : p->lru_wa) + ((size_t)ld * 8 + h) * 4096 + (size_t)(ks * 16 + 8 * (ln >> 5)) * 64 + ct * 32 + (ln & 31);
            u32x4 o; o[0] = cvt_pk_bf16(src[0], src[64]); o[1] = cvt_pk_bf16(src[128], src[192]); o[2] = cvt_pk_bf16(src[256], src[320]); o[3] = cvt_pk_bf16(src[384], src[448]);
            *(u32x4*)(wf + (size_t)it * 8) = o; }
    }
    {
        bf16_t* rwh = (bf16_t*)(p->ws + WS_RWHI); bf16_t* rwl = (bf16_t*)(p->ws + WS_RWLO);
        for (int it = blockIdx.x * NTHREADS + F.tid; it < DEPTH * 64 * DM; it += F.G * NTHREADS) {
            const int k = it & (DM - 1), n = (it >> 10) & 63, l = it >> 16;
            const float w = n < NEXP ? p->re_w[((size_t)l * DM + k) * NEXP + n] : (n < NEXP + NGRP ? p->rg_w[((size_t)l * DM + k) * NGRP + (n - NEXP)] : 0.f);
            const bf16_t hi = f2bf(w); rwh[it] = hi; rwl[it] = f2bf(w - bf2f(hi)); }
    }
    __syncthreads();
    LAS float* sc = (LAS float*)F.lds;
    LAS float* red = (LAS float*)(F.lds + 16384);
    for (int i = F.tid; i < NB * DM; i += NTHREADS) sc[i] = siluf_(p->c[i]);
    __syncthreads();
    float* mod = (float*)(p->ws + WS_MOD);
    for (int t = blockIdx.x; t < DEPTH * 96; t += F.G) {
        const int l = t / 96, n0 = (t % 96) * 64;
        const float* w = p->ada_w + (size_t)l * DM * 6 * DM + n0 + F.lane;
        float a0 = 0.f, a1 = 0.f, a2 = 0.f, a3 = 0.f;
        const int k0 = F.wave * 128;
#pragma unroll 32
        for (int k = k0; k < k0 + 128; ++k) { const float wv = w[(size_t)k * 6 * DM]; a0 += sc[k] * wv; a1 += sc[DM + k] * wv; a2 += sc[2 * DM + k] * wv; a3 += sc[3 * DM + k] * wv; }
        red[(F.wave * 4 + 0) * 64 + F.lane] = a0; red[(F.wave * 4 + 1) * 64 + F.lane] = a1; red[(F.wave * 4 + 2) * 64 + F.lane] = a2; red[(F.wave * 4 + 3) * 64 + F.lane] = a3;
        __syncthreads();
        if (F.tid < 256) { const int b = F.tid >> 6, ln = F.tid & 63; float s = p->ada_b[l * 6 * DM + n0 + ln];
#pragma unroll
            for (int w8 = 0; w8 < 8; ++w8) s += red[(w8 * 4 + b) * 64 + ln];
            mod[((size_t)l * NB + b) * 6 * DM + n0 + ln] = s; }
        __syncthreads();
    }
}

__device__ __forceinline__ void phase_norm1(KParams p, const Ctx& F, int l, const float* xin) {
    const float* mod = (const float*)(p->ws + WS_MOD) + (size_t)l * NB * 6 * DM;
    bf16_t* h = (bf16_t*)(p->ws + WS_R2);
    const float* nw = p->norm_mix_w + l * DM;
    for (int row0 = F.gwave; row0 < MTOK; row0 += 2 * F.nwaves) {
        f32x4 v[2][4]; float rs[2];
#pragma unroll
        for (int u = 0; u < 2; ++u) { const float* xr = xin + (size_t)(row0 + u * F.nwaves) * DM;
#pragma unroll
            for (int i = 0; i < 4; ++i) v[u][i] = *(const f32x4*)(xr + F.lane * 4 + 256 * i); }
#pragma unroll
        for (int u = 0; u < 2; ++u) { float ss = 0.f;
#pragma unroll
            for (int i = 0; i < 4; ++i) ss += v[u][i][0] * v[u][i][0] + v[u][i][1] * v[u][i][1] + v[u][i][2] * v[u][i][2] + v[u][i][3] * v[u][i][3];
            rs[u] = rsqrtf(wave_sum(ss) * (1.0f / DM) + NORM_EPS); }
#pragma unroll
        for (int u = 0; u < 2; ++u) { const int row = row0 + u * F.nwaves, b = row >> 12;
#pragma unroll
            for (int i = 0; i < 4; ++i) { const int col = F.lane * 4 + 256 * i;
                const f32x4 w4 = *(const f32x4*)(nw + col), sh = *(const f32x4*)(mod + (size_t)b * 6 * DM + col), s1 = *(const f32x4*)(mod + (size_t)b * 6 * DM + DM + col);
                const f32x4 o = v[u][i] * rs[u] * w4 * (s1 + 1.0f) + sh;
                u32x2 pk; pk[0] = cvt_pk_bf16(o[0], o[1]); pk[1] = cvt_pk_bf16(o[2], o[3]);
                *(u32x2*)(h + (size_t)row * DM + col) = pk; } }
    }
}

__device__ __forceinline__ void phase_conv(KParams p, const Ctx& F, int l) {
    const bf16_t* proj = (const bf16_t*)(p->ws + WS_R1); float* xc = (float*)(p->ws + WS_XA);
    const float* cw = p->conv_w + l * 4 * DLRU; const float* cb = p->conv_b + l * DLRU;
    for (int it = blockIdx.x * NTHREADS + F.tid; it < MTOK * (DLRU / 4); it += F.G * NTHREADS) {
        const int row = it >> 7, c4 = (it & 127) * 4, t = row & (SEQ - 1);
        f32x4 acc = *(const f32x4*)(cb + c4);
#pragma unroll
        for (int k = 0; k < 4; ++k) { const int tt = t + k - 2;
            if (tt >= 0 && tt < SEQ) { const u32x2 pv = *(const u32x2*)(proj + (size_t)(row + k - 2) * PROJ + c4); const f32x4 w4 = *(const f32x4*)(cw + k * DLRU + c4);
                acc[0] += w4[0] * __uint_as_float(pv[0] << 16); acc[1] += w4[1] * __uint_as_float(pv[0] & 0xFFFF0000u);
                acc[2] += w4[2] * __uint_as_float(pv[1] << 16); acc[3] += w4[3] * __uint_as_float(pv[1] & 0xFFFF0000u); } }
        *(f32x4*)(xc + (size_t)row * DLRU + c4) = acc;
    }
}

__device__ __forceinline__ void lru_seq(KParams p, const Ctx& F, int l, int b, int h) {
    const bf16_t* proj = (const bf16_t*)(p->ws + WS_R1); const float* xc = (const float*)(p->ws + WS_XA); float* tmpz = (float*)(p->ws + WS_XA) + (size_t)MTOK * DLRU;
    const int c = h * 64 + F.lane;
    for (int d = 0; d < 2; ++d) {
        float wa_r[64], wx_r[64];
        const float* wa = p->lru_wa + ((size_t)(l * 2 + d) * 8 + h) * 4096 + F.lane; const float* wx = p->lru_wx + ((size_t)(l * 2 + d) * 8 + h) * 4096 + F.lane;
#pragma unroll
        for (int i = 0; i < 64; ++i) { wa_r[i] = wa[i * 64]; wx_r[i] = wx[i * 64]; }
        const float ba = p->lru_ba[(l * 2 + d) * DLRU + c], bx = p->lru_bx[(l * 2 + d) * DLRU + c], lam = p->lru_lambda[(l * 2 + d) * DLRU + c];
        const float cc = -8.0f * log1pf(expf(-lam));
        float hst = 0.f;
        for (int step = 0; step < SEQ; ++step) {
            const int t = d == 0 ? step : SEQ - 1 - step; const size_t row = (size_t)b * SEQ + t;
            const float xv = xc[row * DLRU + c];
            float ra = ba, rx = bx;
#pragma unroll
            for (int i = 0; i < 64; ++i) { const float xi = rdlane(xv, i); ra += xi * wa_r[i]; rx += xi * wx_r[i]; }
            const float r = sigmoidf_(ra), ig = sigmoidf_(rx), la = cc * r, a = expf(la);
            const float u = sqrtf(fmaxf(-expm1f(2.0f * la), 0.f)) * (ig * xv);
            hst = a * hst + u;
            if (d == 0) tmpz[row * DLRU + c] = hst;
            else { const float yv = bf2f(proj[row * PROJ + DLRU + c]); tmpz[row * DLRU + c] = (tmpz[row * DLRU + c] + hst) * gelu_tanh(yv); }
        }
    }
}

__device__ __forceinline__ float hgrn_lb(KParams p, int l, int ch) {
    if (l == 0) return 0.f;
    const float a = p->hgrn_lb[ch], b = p->hgrn_lb[DHG + ch]; const float m = fmaxf(a, b); const float ea = expf(a - m), eb = expf(b - m);
    return eb / (ea + eb);
}

__device__ __forceinline__ void hgrn_seq(KParams p, const Ctx& F, int l, int b, int h) {
    const bf16_t* proj = (const bf16_t*)(p->ws + WS_R1); float* tmpo = (float*)(p->ws + WS_R2); bf16_t* merged = (bf16_t*)(p->ws + WS_R3);
    const int ch = h * 64 + F.lane;
    const float lbv = hgrn_lb(p, l, ch), nw = p->norm_hgrn_w[l * DHG + ch];
    for (int d = 0; d < 2; ++d) {
        float S[64];
#pragma unroll
        for (int i = 0; i < 64; ++i) S[i] = 0.f;
        const int fcol = (d == 0 ? 1536 : 2048) + ch;
        for (int step = 0; step < SEQ; ++step) {
            const int t = d == 0 ? step : SEQ - 1 - step; const size_t row = (size_t)b * SEQ + t; const bf16_t* pr = proj + row * PROJ;
            const float fl = bf2f(pr[fcol]), qv = bf2f(pr[1024 + ch]), vv = bf2f(pr[2560 + ch]);
            const float f = lbv + (1.0f - lbv) * sigmoidf_(fl), k = 1.0f - f;
            float o = 0.f;
#pragma unroll
            for (int i = 0; i < 64; ++i) { const float fd = rdlane(f, i), kd = rdlane(k, i), qd = rdlane(qv, i); S[i] = fd * S[i] + kd * vv; o += qd * S[i]; }
            if (d == 0) tmpo[row * DHG + ch] = o;
            else { const float ot = tmpo[row * DHG + ch] + o; const float ms = wave_sum(ot * ot) * (1.0f / 64.0f);
                const float gv = bf2f(pr[3072 + ch]); const float y = ot * rsqrtf(ms + NORM_EPS) * nw * siluf_(gv);
                merged[row * DM + DLRU + ch] = f2bf(y); }
        }
    }
}

__device__ __forceinline__ void phase_mixer_seq(KParams p, const Ctx& F, int l) {
#ifdef USE_LRU_SEQ
    if (F.wave == 0 && (int)blockIdx.x < 64) {
        const int id = blockIdx.x;
        if (id < 32) lru_seq(p, F, l, id >> 3, id & 7); else hgrn_seq(p, F, l, (id - 32) >> 3, (id - 32) & 7);
    }
#else
    if (F.wave == 0 && (int)blockIdx.x < 32) hgrn_seq(p, F, l, (int)blockIdx.x >> 3, (int)blockIdx.x & 7);
#endif
}

__device__ __forceinline__ void phase_lru_norm(KParams p, const Ctx& F, int l) {
    const float* tmpz = (const float*)(p->ws + WS_XA) + (size_t)MTOK * DLRU; bf16_t* merged = (bf16_t*)(p->ws + WS_R3); const float* nw = p->norm_lru_w + l * DLRU;
    for (int row = F.gwave; row < MTOK; row += F.nwaves) {
        f32x4 v[2]; float ss = 0.f;
#pragma unroll
        for (int i = 0; i < 2; ++i) { v[i] = *(const f32x4*)(tmpz + (size_t)row * DLRU + F.lane * 4 + 256 * i); ss += v[i][0] * v[i][0] + v[i][1] * v[i][1] + v[i][2] * v[i][2] + v[i][3] * v[i][3]; }
        ss = wave_sum(ss); const float rstd = rsqrtf(ss * (1.0f / DLRU) + NORM_EPS);
#pragma unroll
        for (int i = 0; i < 2; ++i) { const int col = F.lane * 4 + 256 * i; const f32x4 w4 = *(const f32x4*)(nw + col); const f32x4 o = v[i] * rstd * w4;
            u32x2 pk; pk[0] = cvt_pk_bf16(o[0], o[1]); pk[1] = cvt_pk_bf16(o[2], o[3]); *(u32x2*)(merged + (size_t)row * DM + col) = pk; }
    }
}

typedef float f32x16 __attribute__((ext_vector_type(16)));
#define MFMA32(a, b, c) __builtin_amdgcn_mfma_f32_32x32x16_bf16((a), (b), (c), 0, 0, 0)
constexpr int XCP = 1040;
template <bool PASS2>
__device__ __forceinline__ void phase_lru(KParams p, const Ctx& F, int l) {
    const bf16_t* proj = (const bf16_t*)(p->ws + WS_R1);
    float* sumA = (float*)(p->ws + WS_SUMA); float* sumH = (float*)(p->ws + WS_SUMH);
    const bf16x8* wf = (const bf16x8*)(p->ws + WS_LRUW);
    LAS unsigned char* xcb = F.lds; LAS unsigned char* zb = F.lds + 64 * XCP; LAS float* cin = (LAS float*)(F.lds + 128 * XCP);
    const float* cw = p->conv_w + l * 4 * DLRU; const float* cb = p->conv_b + l * DLRU;
    for (int task = blockIdx.x; task < NB * 64; task += F.G) {
        const int b = task >> 6, j = task & 63; const int row0 = b * SEQ + j * 64;
        if (l == 0) TP(PASS2 ? 20 : 10, F.lds);
#pragma unroll
        for (int itq = 0; itq < 8; ++itq) { const int it = F.tid + itq * NTHREADS;
            const int t = it >> 6, c8 = (it & 63) * 8, tg = j * 64 + t;
            f32x4 a0 = *(const f32x4*)(cb + c8), a1 = *(const f32x4*)(cb + c8 + 4);
#pragma unroll
            for (int k = 0; k < 4; ++k) { const int tt = tg + k - 2;
                if (tt >= 0 && tt < SEQ) { const u32x4 pv = *(const u32x4*)(proj + (size_t)(b * SEQ + tt) * PROJ + c8);
                    const f32x4 w0 = *(const f32x4*)(cw + k * DLRU + c8), w1 = *(const f32x4*)(cw + k * DLRU + c8 + 4);
                    a0[0] += w0[0] * __uint_as_float(pv[0] << 16); a0[1] += w0[1] * __uint_as_float(pv[0] & 0xFFFF0000u);
                    a0[2] += w0[2] * __uint_as_float(pv[1] << 16); a0[3] += w0[3] * __uint_as_float(pv[1] & 0xFFFF0000u);
                    a1[0] += w1[0] * __uint_as_float(pv[2] << 16); a1[1] += w1[1] * __uint_as_float(pv[2] & 0xFFFF0000u);
                    a1[2] += w1[2] * __uint_as_float(pv[3] << 16); a1[3] += w1[3] * __uint_as_float(pv[3] & 0xFFFF0000u); } }
            u32x4 o; o[0] = cvt_pk_bf16(a0[0], a0[1]); o[1] = cvt_pk_bf16(a0[2], a0[3]); o[2] = cvt_pk_bf16(a1[0], a1[1]); o[3] = cvt_pk_bf16(a1[2], a1[3]);
            *(LAS u32x4*)(xcb + t * XCP + c8 * 2) = o;
            if (PASS2) *(LAS u32x4*)(zb + t * XCP + c8 * 2) = *(const u32x4*)(proj + (size_t)(row0 + t) * PROJ + DLRU + c8);
        }
        if (l == 0) TP(PASS2 ? 21 : 11, F.lds);
        if (PASS2) {
            const int c = F.tid;
            const float* fa = sumA + (size_t)(0 * NB + b) * 64 * DLRU + c; const float* fh = sumH + (size_t)(0 * NB + b) * 64 * DLRU + c;
            const float* ra = sumA + (size_t)(1 * NB + b) * 64 * DLRU + c; const float* rh = sumH + (size_t)(1 * NB + b) * 64 * DLRU + c;
            float s = 0.f;
#pragma unroll 1
            for (int kb = 0; kb < 64; kb += 32) {
                float a16[32], h16[32];
#pragma unroll
                for (int q = 0; q < 32; ++q) { const int k = kb + q; const bool on = k < j; a16[q] = on ? fa[k * DLRU] : 1.f; h16[q] = on ? fh[k * DLRU] : 0.f; }
#pragma unroll
                for (int q = 0; q < 32; ++q) s = a16[q] * s + h16[q];
            }
            cin[c] = s; s = 0.f;
#pragma unroll 1
            for (int kb = 0; kb < 64; kb += 32) {
                float a16[32], h16[32];
#pragma unroll
                for (int q = 0; q < 32; ++q) { const int k = 63 - kb - q; const bool on = k > j; a16[q] = on ? ra[k * DLRU] : 1.f; h16[q] = on ? rh[k * DLRU] : 0.f; }
#pragma unroll
                for (int q = 0; q < 32; ++q) s = a16[q] * s + h16[q];
            }
            cin[DLRU + c] = s;
        }
        __syncthreads();
        if (l == 0) TP(PASS2 ? 22 : 12, F.lds);
        {
            const int h = F.wave, r = F.lane & 31, hh = F.lane >> 5;
            const LAS unsigned char* abase = xcb + (32 * ((r >> 2) & 1) + 4 * (r >> 3) + (r & 3)) * XCP + (h * 64 + 8 * hh) * 2;
#pragma unroll 1
            for (int ct = 0; ct < 2; ++ct) {
                const int c = h * 64 + ct * 32 + r;
                float hf[32];
#pragma unroll
                for (int d = 0; d < 2; ++d) {
                    const bf16x8* wba = wf + ((((size_t)(l * 2 + d) * 2 + 0) * 8 + h) * 2 + ct) * 4 * 64 + F.lane;
                    const bf16x8* wbx = wf + ((((size_t)(l * 2 + d) * 2 + 1) * 8 + h) * 2 + ct) * 4 * 64 + F.lane;
                    bf16x8 Ba[4], Bx[4];
#pragma unroll
                    for (int ks = 0; ks < 4; ++ks) { Ba[ks] = wba[ks * 64]; Bx[ks] = wbx[ks * 64]; }
                    const float ba = p->lru_ba[(l * 2 + d) * DLRU + c], bx = p->lru_bx[(l * 2 + d) * DLRU + c];
                    const float cc2 = -8.0f * LOG2E_F * log1pf(__expf(-p->lru_lambda[(l * 2 + d) * DLRU + c])), nba = -LOG2E_F * ba, nbx = -LOG2E_F * bx;
                    float av[32], uv[32];
#pragma unroll
                    for (int rt = 0; rt < 2; ++rt) {
                        f32x16 za, zx;
#pragma unroll
                        for (int e = 0; e < 16; ++e) { za[e] = 0.f; zx[e] = 0.f; }
#pragma unroll
                        for (int ks = 0; ks < 4; ++ks) { const bf16x8 Af = *(const LAS bf16x8*)(abase + 16 * rt * XCP + ks * 32);
                            za = MFMA32(Af, Ba[ks], za); zx = MFMA32(Af, Bx[ks], zx); }
#pragma unroll
                        for (int reg = 0; reg < 16; ++reg) { const int i = 16 * rt + reg;
                            const float xcv = bf2f(*(const LAS bf16_t*)(xcb + (32 * hh + i) * XCP + c * 2));
                            const float rg = frcp(1.0f + fexp2(fmaf(za[reg], -LOG2E_F, nba))), ig = frcp(1.0f + fexp2(fmaf(zx[reg], -LOG2E_F, nbx)));
                            const float a_ = fexp2(cc2 * rg);
                            av[i] = a_; uv[i] = __builtin_amdgcn_sqrtf(1.0f - a_ * a_) * (ig * xcv); }
                    }
                    if (d == 0) {
#pragma unroll
                        for (int i = 1; i < 32; ++i) { uv[i] = av[i] * uv[i - 1] + uv[i]; av[i] = av[i] * av[i - 1]; }
                    } else {
#pragma unroll
                        for (int i = 30; i >= 0; --i) { uv[i] = av[i] * uv[i + 1] + uv[i]; av[i] = av[i] * av[i + 1]; }
                    }
                    const float myP = (d == 0) ? av[31] : av[0], myH = (d == 0) ? uv[31] : uv[0];
                    const float oP = __shfl_xor(myP, 32, 64), oH = __shfl_xor(myH, 32, 64);
                    if (!PASS2) {
                        if (hh == 0) { const size_t idx = ((size_t)(d * NB + b) * 64 + j) * DLRU + c;
                            sumA[idx] = myP * oP;
                            sumH[idx] = (d == 0) ? (oH + oP * myH) : (myH + myP * oH); }
                    } else {
                        const float cinv = cin[d * DLRU + c];
                        const bool first = (d == 0) ? (hh == 0) : (hh == 1);
                        const float cy = first ? cinv : (oH + oP * cinv);
                        if (d == 0) {
#pragma unroll
                            for (int i = 0; i < 32; ++i) hf[i] = uv[i] + av[i] * cy;
                        } else {
#pragma unroll
                            for (int i = 0; i < 32; ++i) { const float hs = hf[i] + uv[i] + av[i] * cy;
                                LAS bf16_t* zp = (LAS bf16_t*)(zb + (32 * hh + i) * XCP + c * 2);
                                *zp = f2bf(hs * gelu_tanh(bf2f(*zp))); }
                        }
                    }
                }
            }
        }
        if (l == 0) TP(PASS2 ? 23 : 13, F.lds);
        if (PASS2) {
            __syncthreads();
            bf16_t* merged = (bf16_t*)(p->ws + WS_R3); const float* nw = p->norm_lru_w + l * DLRU;
            const f32x4 w0 = *(const f32x4*)(nw + F.lane * 8), w1 = *(const f32x4*)(nw + F.lane * 8 + 4);
#pragma unroll
            for (int q = 0; q < 8; ++q) { const int t = F.wave * 8 + q;
                const u32x4 zv = *(const LAS u32x4*)(zb + t * XCP + F.lane * 16);
                float z[8];
#pragma unroll
                for (int e = 0; e < 4; ++e) { z[2 * e] = __uint_as_float(zv[e] << 16); z[2 * e + 1] = __uint_as_float(zv[e] & 0xFFFF0000u); }
                float ss = 0.f;
#pragma unroll
                for (int e = 0; e < 8; ++e) ss += z[e] * z[e];
                ss = wave_sum(ss); const float rstd = rsqrtf(ss * (1.0f / DLRU) + NORM_EPS);
                u32x4 o; o[0] = cvt_pk_bf16(z[0] * rstd * w0[0], z[1] * rstd * w0[1]); o[1] = cvt_pk_bf16(z[2] * rstd * w0[2], z[3] * rstd * w0[3]);
                o[2] = cvt_pk_bf16(z[4] * rstd * w1[0], z[5] * rstd * w1[1]); o[3] = cvt_pk_bf16(z[6] * rstd * w1[2], z[7] * rstd * w1[3]);
                *(u32x4*)(merged + (size_t)(row0 + t) * DM + F.lane * 8) = o; }
        }
        __syncthreads();
        if (l == 0) TP(PASS2 ? 24 : 14, F.lds);
    }
}

typedef __bf16 bf16v8 __attribute__((ext_vector_type(8)));
typedef float f32x8 __attribute__((ext_vector_type(8)));
__device__ __forceinline__ bf16x8 pk8(float a0, float a1, float a2, float a3, float a4, float a5, float a6, float a7) {
    const f32x8 w = {a0, a1, a2, a3, a4, a5, a6, a7}; return __builtin_bit_cast(bf16x8, __builtin_convertvector(w, bf16v8)); }
#define PACK_STEP(x, s) pk8((x)[8 * (s)], (x)[8 * (s) + 1], (x)[8 * (s) + 2], (x)[8 * (s) + 3], (x)[8 * (s) + 4], (x)[8 * (s) + 5], (x)[8 * (s) + 6], (x)[8 * (s) + 7])
__device__ __forceinline__ int crow(int reg, int hh) { return (reg & 3) + 8 * (reg >> 2) + 4 * hh; }
template <int KIND> __device__ __forceinline__ bf16x8 mk_const(int ks, int hh, int r) {
    bf16x8 v;
#pragma unroll
    for (int j = 0; j < 8; ++j) { const int kn = 16 * ks + 8 * hh + j, kp = 16 * ks + 8 * (j >> 2) + 4 * hh + (j & 3);
        const bool on = KIND == 0 ? (kn <= r) : KIND == 1 ? (kn > r) : KIND == 2 ? (kn == r) : (kp == r);
        v[j] = on ? (short)0x3F80 : (short)0; }
    return v;
}
constexpr int HG_TASKS = NB * 8 * 2 * 32;
constexpr int HG_WLDS = 12288;
template <bool PASS2>
__device__ __forceinline__ void phase_hgrn(KParams p, const Ctx& F, int l) {
    const bf16_t* proj = (const bf16_t*)(p->ws + WS_R1);
    float* Usum = (float*)(p->ws + WS_R2); float* Dsum = Usum + (size_t)HG_TASKS * 4096;
    bf16_t* osc = (bf16_t*)(p->ws + WS_XA);
    int lz = F.lane; asm volatile("" : "+v"(lz));
    const int r = lz & 31, hh = lz >> 5;
    LAS unsigned char* wl = F.lds + F.wave * HG_WLDS;
    const LAS unsigned char* rdA = wl + (8 * hh) * 128 + r * 2;
    const LAS unsigned char* rdV = wl + 8192 + (4 * hh) * 128 + r * 2;
    for (int wg = blockIdx.x; wg < 256; wg += F.G) {
        const int b = wg >> 6, h = (wg >> 3) & 7, g = wg & 7;
        const int dir = F.wave & 1, tr = g * 4 + (F.wave >> 1);
        const int task = ((b * 8 + h) * 2 + dir) * 32 + tr;
        const int r0 = b * SEQ + tr * 128;
        const int fcol = (dir == 0 ? 1536 : 2048) + h * 64;
        if (l == 0) TP(PASS2 ? 30 : 40, F.lds);
        const float lb0 = hgrn_lb(p, l, h * 64 + r), lb1 = hgrn_lb(p, l, h * 64 + 32 + r);
        f32x16 S[2][2];
#pragma unroll
        for (int a = 0; a < 2; ++a) {
#pragma unroll
            for (int e = 0; e < 16; ++e) { S[a][0][e] = 0.f; S[a][1][e] = 0.f; } }
        if (PASS2) {
#pragma unroll
            for (int a = 0; a < 2; ++a)
#pragma unroll
                for (int c = 0; c < 2; ++c)
#pragma unroll
                    for (int e = 0; e < 16; ++e) S[a][c][e] = *(const float*)((const char*)Usum + ((unsigned)(task * 4096 + lz) * 4u + (unsigned)(((a * 2 + c) * 16 + e) * 256)));
        }
        if (l == 0) TP(PASS2 ? 31 : 41, F.lds);
#pragma unroll 1
        for (int ci = 0; ci < 4; ++ci) {
            const int rbase = dir == 0 ? r0 + 32 * ci : r0 + 127 - 32 * ci, sg = dir == 0 ? 1 : -1;
            {
                int lq = lz; asm volatile("" : "+v"(lq));
                const int lrow = lq >> 3, lcol = (lq & 7) * 8;
#pragma unroll
                for (int i = 0; i < 4; ++i) { const int tau = 8 * i + lrow; const char* pr = (const char*)proj + (unsigned)(((rbase + sg * tau) * PROJ + h * 64 + lcol) * 2);
                    const u32x4 vf = *(const u32x4*)(pr + (fcol - h * 64) * 2), vv = *(const u32x4*)(pr + 2560 * 2);
                    *(LAS u32x4*)(wl + tau * 128 + lcol * 2) = vf; *(LAS u32x4*)(wl + 8192 + tau * 128 + lcol * 2) = vv;
                    if (PASS2) { const u32x4 vq = *(const u32x4*)(pr + 1024 * 2); *(LAS u32x4*)(wl + 4096 + tau * 128 + lcol * 2) = vq; } }
            }
            __builtin_amdgcn_sched_barrier(0);
#define LOAD_VP(c, ks, dst) do { _Pragma("unroll") for (int j = 0; j < 8; ++j) (dst)[j] = (short)*(const LAS bf16_t*)(rdV + (16 * (ks) + 8 * (j >> 2) + (j & 3)) * 128 + 64 * (c)); } while (0)
            f32x16 O[2], sc;
            if (PASS2) {
#pragma unroll
                for (int e = 0; e < 16; ++e) { O[0][e] = 0.f; O[1][e] = 0.f; sc[e] = 0.f; } }
#pragma unroll
            for (int a = 0; a < 2; ++a) {
                const float lbv = a == 0 ? lb0 : lb1;
                bf16x8 Ahi[2], Alo[2];
                f32x16 kT, qT;
#pragma unroll
                for (int e = 0; e < 16; ++e) { kT[e] = 0.f; qT[e] = 0.f; }
#pragma unroll
                for (int ks = 0; ks < 2; ++ks) {
                    float lf[8], kk[8];
#pragma unroll
                    for (int j = 0; j < 8; ++j) { const float fl = bf2f(*(const LAS bf16_t*)(rdA + (16 * ks + j) * 128 + 64 * a));
                        const float f = lbv + (1.0f - lbv) * sigmoidf_(fl);
                        lf[j] = fmaxf(flog2(f), -115.0f); kk[j] = 1.0f - f; }
                    Ahi[ks] = pk8(lf[0], lf[1], lf[2], lf[3], lf[4], lf[5], lf[6], lf[7]);
                    float lo[8];
#pragma unroll
                    for (int j = 0; j < 8; ++j) lo[j] = lf[j] - bf2f((bf16_t)Ahi[ks][j]);
                    Alo[ks] = pk8(lo[0], lo[1], lo[2], lo[3], lo[4], lo[5], lo[6], lo[7]);
                    const bf16x8 Ak = pk8(kk[0], kk[1], kk[2], kk[3], kk[4], kk[5], kk[6], kk[7]);
                    const bf16x8 Id = mk_const<2>(ks, hh, r);
                    kT = MFMA32(Ak, Id, kT);
                    if (PASS2) { bf16x8 Aq;
#pragma unroll
                        for (int j = 0; j < 8; ++j) Aq[j] = (short)*(const LAS bf16_t*)(rdA + 4096 + (16 * ks + j) * 128 + 64 * a);
                        qT = MFMA32(Aq, Id, qT); }
                }
                __builtin_amdgcn_sched_barrier(0);
                if (PASS2) {
                    f32x16 bT;
#pragma unroll
                    for (int e = 0; e < 16; ++e) bT[e] = 0.f;
#pragma unroll
                    for (int ks = 0; ks < 2; ++ks) { const bf16x8 Mle = mk_const<0>(ks, hh, r); bT = MFMA32(Ahi[ks], Mle, bT); bT = MFMA32(Alo[ks], Mle, bT); }
#pragma unroll
                    for (int e = 0; e < 16; ++e) bT[e] = qT[e] * fexp2(bT[e]);
#pragma unroll
                    for (int s2 = 0; s2 < 2; ++s2) { const bf16x8 Qtp = PACK_STEP(bT, s2);
#pragma unroll
                        for (int c = 0; c < 2; ++c) O[c] = MFMA32(Qtp, PACK_STEP(S[a][c], s2), O[c]); }
                    __builtin_amdgcn_sched_barrier(0);
                }
                bf16x8 Kh0, Kh1;
                {
                    f32x16 RT;
#pragma unroll
                    for (int e = 0; e < 16; ++e) RT[e] = 0.f;
#pragma unroll
                    for (int ks = 0; ks < 2; ++ks) { const bf16x8 Mgt = mk_const<1>(ks, hh, r); RT = MFMA32(Ahi[ks], Mgt, RT); RT = MFMA32(Alo[ks], Mgt, RT); }
#pragma unroll
                    for (int e = 0; e < 16; ++e) { kT[e] *= fexp2(RT[e]); if (PASS2) qT[e] *= fexp2(fminf(-RT[e], 115.0f)); }
                    Kh0 = PACK_STEP(kT, 0); Kh1 = PACK_STEP(kT, 1);
                    if (PASS2) { sc = MFMA32(Kh0, PACK_STEP(qT, 0), sc); sc = MFMA32(Kh1, PACK_STEP(qT, 1), sc); }
                    __builtin_amdgcn_sched_barrier(0);
                }
                {
                    f32x16 CT;
#pragma unroll
                    for (int e = 0; e < 16; ++e) CT[e] = 0.f;
#pragma unroll
                    for (int ks = 0; ks < 2; ++ks) { bf16x8 One;
#pragma unroll
                        for (int j = 0; j < 8; ++j) One[j] = (short)0x3F80;
                        CT = MFMA32(Ahi[ks], One, CT); CT = MFMA32(Alo[ks], One, CT); }
#pragma unroll
                    for (int e = 0; e < 16; ++e) { const float dd = fexp2(CT[e]); S[a][0][e] *= dd; S[a][1][e] *= dd; if (!PASS2) CT[e] = dd; }
                    if (!PASS2 && r == 0) {
#pragma unroll
                        for (int e = 0; e < 16; ++e) Dsum[((size_t)task * 4 + ci) * 64 + 32 * a + crow(e, hh)] = CT[e]; }
                    __builtin_amdgcn_sched_barrier(0);
                }
                {
                    f32x16 Ks;
#pragma unroll
                    for (int e = 0; e < 16; ++e) Ks[e] = 0.f;
                    Ks = MFMA32(Kh0, mk_const<3>(0, hh, r), Ks); Ks = MFMA32(Kh1, mk_const<3>(1, hh, r), Ks);
#pragma unroll
                    for (int ks = 0; ks < 2; ++ks) { const bf16x8 Ksp = PACK_STEP(Ks, ks);
#pragma unroll
                        for (int c = 0; c < 2; ++c) { bf16x8 Vp; LOAD_VP(c, ks, Vp); S[a][c] = MFMA32(Ksp, Vp, S[a][c]); } }
                    __builtin_amdgcn_sched_barrier(0);
                }
            }
            if (PASS2) {
#pragma unroll
                for (int e = 0; e < 16; ++e) sc[e] = (crow(e, hh) <= r) ? sc[e] : 0.f;
#pragma unroll
                for (int ks = 0; ks < 2; ++ks) { const bf16x8 Pp = PACK_STEP(sc, ks);
#pragma unroll
                    for (int c = 0; c < 2; ++c) { bf16x8 Vp; LOAD_VP(c, ks, Vp); O[c] = MFMA32(Pp, Vp, O[c]); } }
                int lq2 = lz; asm volatile("" : "+v"(lq2));
                const int r2 = lq2 & 31, hh2 = lq2 >> 5;
#pragma unroll
                for (int c = 0; c < 2; ++c)
#pragma unroll
                    for (int e = 0; e < 16; ++e) *(bf16_t*)((char*)osc + (unsigned)((((dir * MTOK + rbase + sg * crow(e, hh2)) * DHG) + h * 64 + 32 * c + r2) * 2)) = f2bf(O[c][e]);
            }
#undef LOAD_VP
        }
        if (l == 0) TP(PASS2 ? 32 : 42, F.lds);
        if (!PASS2) {
#pragma unroll
            for (int a = 0; a < 2; ++a)
#pragma unroll
                for (int c = 0; c < 2; ++c)
#pragma unroll
                    for (int e = 0; e < 16; ++e) *(float*)((char*)Usum + ((unsigned)(task * 4096 + lz) * 4u + (unsigned)(((a * 2 + c) * 16 + e) * 256))) = S[a][c][e];
        } else {
            asm volatile("s_waitcnt vmcnt(0)" ::: "memory");
            __syncthreads();
            bf16_t* merged = (bf16_t*)(p->ws + WS_R3);
            const int ch4 = h * 64 + (F.lane & 15) * 4; const f32x4 nw4 = *(const f32x4*)(p->norm_hgrn_w + l * DHG + ch4);
#pragma unroll 4
            for (int i = 0; i < 16; ++i) { const int row = b * SEQ + g * 512 + F.wave * 64 + i * 4 + (F.lane >> 4);
                const u32x2 qf = *(const u32x2*)((const char*)osc + (unsigned)((row * DHG + ch4) * 2)), qb = *(const u32x2*)((const char*)osc + (unsigned)(((MTOK + row) * DHG + ch4) * 2));
                const f32x4 of = (f32x4){__uint_as_float(qf[0] << 16), __uint_as_float(qf[0] & 0xFFFF0000u), __uint_as_float(qf[1] << 16), __uint_as_float(qf[1] & 0xFFFF0000u)};
                const f32x4 ob = (f32x4){__uint_as_float(qb[0] << 16), __uint_as_float(qb[0] & 0xFFFF0000u), __uint_as_float(qb[1] << 16), __uint_as_float(qb[1] & 0xFFFF0000u)};
                const u32x2 gq = *(const u32x2*)((const char*)proj + (unsigned)((row * PROJ + 3072 + ch4) * 2));
                const f32x4 ot = of + ob;
                float ms = ot[0] * ot[0] + ot[1] * ot[1] + ot[2] * ot[2] + ot[3] * ot[3];
                ms += __shfl_xor(ms, 1, 64); ms += __shfl_xor(ms, 2, 64); ms += __shfl_xor(ms, 4, 64); ms += __shfl_xor(ms, 8, 64);
                const float rs = rsqrtf(ms * (1.0f / 64.0f) + NORM_EPS);
                const float g0 = __uint_as_float(gq[0] << 16), g1 = __uint_as_float(gq[0] & 0xFFFF0000u), g2 = __uint_as_float(gq[1] << 16), g3 = __uint_as_float(gq[1] & 0xFFFF0000u);
                u32x2 o; o[0] = cvt_pk_bf16(ot[0] * rs * nw4[0] * siluf_(g0), ot[1] * rs * nw4[1] * siluf_(g1)); o[1] = cvt_pk_bf16(ot[2] * rs * nw4[2] * siluf_(g2), ot[3] * rs * nw4[3] * siluf_(g3));
                *(u32x2*)((char*)merged + (unsigned)((row * DM + DLRU + ch4) * 2)) = o; }
            __syncthreads();
        }
        if (l == 0) TP(PASS2 ? 33 : 43, F.lds);
    }
}

__device__ __forceinline__ void phase_hgrn_prefix(KParams p, const Ctx& F, int l) {
    float* Usum = (float*)(p->ws + WS_R2); const float* Dsum = Usum + (size_t)HG_TASKS * 4096;
    if (l == 0) TP(50, F.lds);
    for (int gt = blockIdx.x * NTHREADS + F.tid; gt < 64 * 4096; gt += F.G * NTHREADS) {
        const int seq = gt >> 12, e = gt & 4095, dir = seq & 1;
        const int tile = e >> 10, reg = (e >> 6) & 15, ln = e & 63; const int d = 32 * (tile >> 1) + crow(reg, ln >> 5);
        float s = 0.f;
#pragma unroll 1
        for (int kb = 0; kb < 32; kb += 16) {
            float u16[16], d16[16];
#pragma unroll
            for (int q = 0; q < 16; ++q) { const int k = kb + q, trp = dir == 0 ? k : 31 - k; const size_t tp = (size_t)seq * 32 + trp;
                u16[q] = Usum[tp * 4096 + e];
                d16[q] = Dsum[(tp * 4 + 0) * 64 + d] * Dsum[(tp * 4 + 1) * 64 + d] * Dsum[(tp * 4 + 2) * 64 + d] * Dsum[(tp * 4 + 3) * 64 + d]; }
#pragma unroll
            for (int q = 0; q < 16; ++q) { const float sin = s; s = d16[q] * s + u16[q]; u16[q] = sin; }
#pragma unroll
            for (int q = 0; q < 16; ++q) { const int k = kb + q, trp = dir == 0 ? k : 31 - k; const size_t tp = (size_t)seq * 32 + trp; Usum[tp * 4096 + e] = u16[q]; }
        }
    }
    if (l == 0) TP(51, F.lds);
}

constexpr int RT_PITCH = 2064;
__device__ __forceinline__ void phase_route(KParams p, const Ctx& F, int l) {
    const float* mod = (const float*)(p->ws + WS_MOD) + (size_t)l * NB * 6 * DM;
    const bf16_t* xa = (const bf16_t*)(p->ws + WS_XA); bf16_t* h2 = (bf16_t*)(p->ws + WS_R2);
    const float* nw = p->norm_ffn_w + l * DM;
    int* cnt = (int*)(p->ws + WS_CTL + CTL_CNT_OFF) + l * NEXP * CNT_STRIDE;
    int* rowcap = (int*)(p->ws + WS_ROWCAP); float* tokw = (float*)(p->ws + WS_TOKW);
    LAS int* hist = (LAS int*)(F.lds + LDS_MISC + 64);
    LAS int* tsel = (LAS int*)(F.lds + LDS_MISC + 1024);
    if (F.tid < 64) hist[F.tid] = 0;
    __syncthreads();
    int ntile = 0;
    const bf16_t* rwh = (const bf16_t*)(p->ws + WS_RWHI) + (size_t)l * 64 * DM; const bf16_t* rwl = (const bf16_t*)(p->ws + WS_RWLO) + (size_t)l * 64 * DM;
    LAS unsigned char* Ah = F.lds; LAS unsigned char* Al = F.lds + 32 * RT_PITCH;
    LAS float* part = (LAS float*)F.lds;
    LAS float* red = (LAS float*)(F.lds + 65536);
    const int r = F.lane & 31, hh = F.lane >> 5;
    for (int tile = blockIdx.x; tile < MTOK / 32; tile += F.G) {
        const int row0 = tile * 32, b = row0 >> 12;
        {
            f32x4 v[4][4]; float ss[4];
#pragma unroll
            for (int i = 0; i < 4; ++i) { const bf16_t* xr = xa + (size_t)(row0 + F.wave * 4 + i) * DM; ss[i] = 0.f;
#pragma unroll
                for (int q = 0; q < 4; ++q) { const u32x2 xv = *(const u32x2*)(xr + F.lane * 4 + 256 * q);
                    v[i][q] = (f32x4){__uint_as_float(xv[0] << 16), __uint_as_float(xv[0] & 0xFFFF0000u), __uint_as_float(xv[1] << 16), __uint_as_float(xv[1] & 0xFFFF0000u)}; } }
#pragma unroll
            for (int i = 0; i < 4; ++i) {
#pragma unroll
                for (int q = 0; q < 4; ++q) ss[i] += v[i][q][0] * v[i][q][0] + v[i][q][1] * v[i][q][1] + v[i][q][2] * v[i][q][2] + v[i][q][3] * v[i][q][3];
                ss[i] = rsqrtf(wave_sum(ss[i]) * (1.0f / DM) + NORM_EPS); }
#pragma unroll
            for (int q = 0; q < 4; ++q) { const int col = F.lane * 4 + 256 * q;
                const f32x4 w4 = *(const f32x4*)(nw + col), sh = *(const f32x4*)(mod + (size_t)b * 6 * DM + 3 * DM + col), s1 = *(const f32x4*)(mod + (size_t)b * 6 * DM + 4 * DM + col);
                const f32x4 g4 = w4 * (s1 + 1.0f);
#pragma unroll
                for (int i = 0; i < 4; ++i) { const int rl = F.wave * 4 + i;
                    const f32x4 o = v[i][q] * ss[i] * g4 + sh;
                    u32x2 pk; pk[0] = cvt_pk_bf16(o[0], o[1]); pk[1] = cvt_pk_bf16(o[2], o[3]);
                    *(u32x2*)(h2 + (size_t)(row0 + rl) * DM + col) = pk;
                    *(LAS u32x2*)(Ah + rl * RT_PITCH + col * 2) = pk;
                    u32x2 lo; lo[0] = cvt_pk_bf16(o[0] - __uint_as_float(pk[0] << 16), o[1] - __uint_as_float(pk[0] & 0xFFFF0000u));
                    lo[1] = cvt_pk_bf16(o[2] - __uint_as_float(pk[1] << 16), o[3] - __uint_as_float(pk[1] & 0xFFFF0000u));
                    *(LAS u32x2*)(Al + rl * RT_PITCH + col * 2) = lo; } }
        }
        __builtin_amdgcn_sched_barrier(0);
        f32x16 acc[2];
#pragma unroll
        for (int e = 0; e < 16; ++e) { acc[0][e] = 0.f; acc[1][e] = 0.f; }
        {
            bf16x8 bh[8][2];
#pragma unroll
            for (int ks = 0; ks < 8; ++ks)
#pragma unroll
                for (int nt = 0; nt < 2; ++nt) bh[ks][nt] = *(const bf16x8*)(rwh + (size_t)(nt * 32 + r) * DM + F.wave * 128 + ks * 16 + 8 * hh);
            __syncthreads();
#pragma unroll
            for (int ks = 0; ks < 8; ++ks) { const int k0 = F.wave * 128 + ks * 16 + 8 * hh;
                const bf16x8 ah = *(const LAS bf16x8*)(Ah + r * RT_PITCH + k0 * 2), al = *(const LAS bf16x8*)(Al + r * RT_PITCH + k0 * 2);
#pragma unroll
                for (int nt = 0; nt < 2; ++nt) { acc[nt] = MFMA32(ah, bh[ks][nt], acc[nt]); acc[nt] = MFMA32(al, bh[ks][nt], acc[nt]); } }
        }
        __builtin_amdgcn_sched_barrier(0);
        {
            bf16x8 bl[8][2];
#pragma unroll
            for (int ks = 0; ks < 8; ++ks)
#pragma unroll
                for (int nt = 0; nt < 2; ++nt) bl[ks][nt] = *(const bf16x8*)(rwl + (size_t)(nt * 32 + r) * DM + F.wave * 128 + ks * 16 + 8 * hh);
#pragma unroll
            for (int ks = 0; ks < 8; ++ks) { const int k0 = F.wave * 128 + ks * 16 + 8 * hh;
                const bf16x8 ah = *(const LAS bf16x8*)(Ah + r * RT_PITCH + k0 * 2);
#pragma unroll
                for (int nt = 0; nt < 2; ++nt) acc[nt] = MFMA32(ah, bl[ks][nt], acc[nt]); }
        }
        __syncthreads();
#pragma unroll
        for (int nt = 0; nt < 2; ++nt)
#pragma unroll
            for (int e = 0; e < 16; ++e) part[(F.wave * 32 + crow(e, hh)) * 64 + nt * 32 + r] = acc[nt][e];
        __syncthreads();
        {
            const int tk = F.tid >> 4, c4 = (F.tid & 15) * 4; f32x4 sum = (f32x4){0.f, 0.f, 0.f, 0.f};
#pragma unroll
            for (int w = 0; w < 8; ++w) sum += *(const LAS f32x4*)(part + (w * 32 + tk) * 64 + c4);
            *(LAS f32x4*)(red + tk * 64 + c4) = sum;
        }
        __syncthreads();
        if (F.tid < 32) {
            const int row = row0 + F.tid;
            const LAS float* lg = red + F.tid * 64;
            float gl[4];
#pragma unroll
            for (int j = 0; j < 4; ++j) gl[j] = lg[32 + j] + p->rg_b[l * NGRP + j];
            int gi = 0; float gm = gl[0];
#pragma unroll
            for (int j = 1; j < 4; ++j) if (gl[j] > gm) { gm = gl[j]; gi = j; }
            float gs = 0.f;
#pragma unroll
            for (int j = 0; j < 4; ++j) gs += __expf(gl[j] - gm);
            const float pg = 1.0f / gs;
            float el[8];
#pragma unroll
            for (int j = 0; j < 8; ++j) el[j] = lg[gi * 8 + j] + p->re_b[l * NEXP + gi * 8 + j];
            int i0 = 0; float v0 = el[0];
#pragma unroll
            for (int j = 1; j < 8; ++j) if (el[j] > v0) { v0 = el[j]; i0 = j; }
            int i1 = (i0 == 0) ? 1 : 0; float v1 = (i0 == 0) ? el[1] : el[0];
#pragma unroll
            for (int j = 0; j < 8; ++j) if (j != i0 && el[j] > v1) { v1 = el[j]; i1 = j; }
            const float ex = __expf(v1 - v0); const float w0 = pg / (1.0f + ex), w1 = pg * ex / (1.0f + ex);
            const int e0 = gi * 8 + i0, e1 = gi * 8 + i1;
            const int p0 = __hip_atomic_fetch_add(&hist[e0], 1, __ATOMIC_RELAXED, __HIP_MEMORY_SCOPE_WORKGROUP), p1 = __hip_atomic_fetch_add(&hist[e1], 1, __ATOMIC_RELAXED, __HIP_MEMORY_SCOPE_WORKGROUP);
            *(LAS i32x4*)(tsel + (ntile * 32 + F.tid) * 4) = (i32x4){e0, p0, e1, p1};
            *(float2*)(tokw + (size_t)row * 2) = make_float2(w0, w1);
        }
        ++ntile;
        __syncthreads();
    }
    if (F.tid < NEXP) { const int c = hist[F.tid]; hist[32 + F.tid] = c > 0 ? atomicAdd(&cnt[F.tid * CNT_STRIDE], c) : 0; }
    __syncthreads();
    for (int q = F.tid; q < ntile * 32; q += NTHREADS) { const int tile = (int)blockIdx.x + (q >> 5) * F.G, row = tile * 32 + (q & 31);
        const i32x4 t = *(const LAS i32x4*)(tsel + q * 4);
        rowcap[(size_t)t[0] * MTOK + hist[32 + t[0]] + t[1]] = row * 2; rowcap[(size_t)t[2] * MTOK + hist[32 + t[2]] + t[3]] = row * 2 + 1; }
    __syncthreads();
}

constexpr int MOE_MAX_UNITS = 4, HALF_ROWS = 128;
__device__ __forceinline__ void build_tile_table(KParams p, const Ctx& F, int l) {
    LAS int* tst = (LAS int*)(F.lds + LDS_MISC + 64);
    LAS int* ulist = (LAS int*)(F.lds + LDS_MISC + 256);
    LAS int* utok = (LAS int*)(F.lds + LDS_MISC + 1024);
    LAS float* utw = (LAS float*)(F.lds + LDS_MISC + 5120);
    const int* cnt = (const int*)(p->ws + WS_CTL + CTL_CNT_OFF) + l * NEXP * CNT_STRIDE;
    const int* rowcap = (const int*)(p->ws + WS_ROWCAP); const float* tokw = (const float*)(p->ws + WS_TOKW);
    LAS int* tord = (LAS int*)(F.lds + LDS_MISC + 9216);
    LAS int* cl = (LAS int*)(F.lds + LDS_MISC + 9984);
    if (F.tid < NEXP) cl[F.tid] = __hip_atomic_load(cnt + F.tid * CNT_STRIDE, __ATOMIC_RELAXED, __HIP_MEMORY_SCOPE_AGENT);
    __syncthreads();
    if (F.tid == 0) { int acc = 0, nbig = 0;
        for (int e = 0; e < NEXP; ++e) { const int c = cl[e]; tst[e] = acc; acc += (c + 255) >> 8; nbig += (c >> 8) + (((c & 255) > HALF_ROWS) ? 1 : 0); }
        tst[NEXP] = acc;
        int ib = 0, it2 = nbig;
        for (int e = 0; e < NEXP; ++e) { const int c = cl[e], nt = (c + 255) >> 8;
            for (int it = 0; it < nt; ++it) { const int valid = c - it * 256; if (valid > HALF_ROWS) tord[ib++] = (e << 8) | it; else tord[it2++] = (e << 8) | it; } } }
    __syncthreads();
    if (F.tid <= MOE_MAX_UNITS) { const int L = F.tid * F.G + (int)blockIdx.x, tm = tst[NEXP]; int pm = -1, pn = 0, a0 = 0, a1 = 0;
        if (F.tid < MOE_MAX_UNITS && L < tm * 4) { const int ei = tord[L >> 2], e = ei >> 8, it = ei & 255, c = cl[e];
            pm = tst[e] + it; pn = e * 4 + (L & 3); a0 = e * MTOK + it * 256; a1 = c - it * 256 < 256 ? c - it * 256 : 256; }
        ulist[4 * F.tid] = pm; ulist[4 * F.tid + 1] = pn; ulist[4 * F.tid + 2] = a0; ulist[4 * F.tid + 3] = a1; }
    __syncthreads();
    for (int q = F.tid; q < MOE_MAX_UNITS * 256; q += NTHREADS) { const int i = q >> 8, rl = q & 255;
        int v = -1; float w = 0.f;
        if (ulist[4 * i] >= 0 && rl < ulist[4 * i + 3]) { v = rowcap[ulist[4 * i + 2] + rl]; w = tokw[v]; }
        utok[q] = v; utw[q] = w; }
    __syncthreads();
    if (F.tid < MOE_MAX_UNITS) ulist[4 * F.tid + 2] = 256 * F.tid;
    __syncthreads();
}

template <bool FINAL>
__device__ __forceinline__ void phase_combine(KParams p, const Ctx& F, int l, bf16_t* xo) {
    const float* mod = (const float*)(p->ws + WS_MOD) + (size_t)l * NB * 6 * DM;
    const bf16_t* xa = (const bf16_t*)(p->ws + WS_XA); const bf16_t* y = (const bf16_t*)(p->ws + WS_R1 + WS_R1_Y);
    for (int row0 = F.gwave; row0 < MTOK; row0 += 2 * F.nwaves) {
        u32x2 xq[2][4], y0[2][4], y1[2][4];
#pragma unroll
        for (int u = 0; u < 2; ++u) { const size_t row = row0 + u * F.nwaves;
#pragma unroll
            for (int i = 0; i < 4; ++i) { const int col = F.lane * 4 + 256 * i;
                xq[u][i] = *(const u32x2*)(xa + row * DM + col); y0[u][i] = *(const u32x2*)(y + (row * 2) * DM + col); y1[u][i] = *(const u32x2*)(y + (row * 2 + 1) * DM + col); } }
#pragma unroll
        for (int u = 0; u < 2; ++u) { const int row = row0 + u * F.nwaves, b = row >> 12; f32x4 v[4]; float ss = 0.f;
#pragma unroll
            for (int i = 0; i < 4; ++i) { const int col = F.lane * 4 + 256 * i; const f32x4 g = *(const f32x4*)(mod + (size_t)b * 6 * DM + 5 * DM + col);
                const f32x4 xv = (f32x4){__uint_as_float(xq[u][i][0] << 16), __uint_as_float(xq[u][i][0] & 0xFFFF0000u), __uint_as_float(xq[u][i][1] << 16), __uint_as_float(xq[u][i][1] & 0xFFFF0000u)};
                f32x4 ys; ys[0] = __uint_as_float(y0[u][i][0] << 16) + __uint_as_float(y1[u][i][0] << 16); ys[1] = __uint_as_float(y0[u][i][0] & 0xFFFF0000u) + __uint_as_float(y1[u][i][0] & 0xFFFF0000u);
                ys[2] = __uint_as_float(y0[u][i][1] << 16) + __uint_as_float(y1[u][i][1] << 16); ys[3] = __uint_as_float(y0[u][i][1] & 0xFFFF0000u) + __uint_as_float(y1[u][i][1] & 0xFFFF0000u);
                v[i] = xv + g * ys; ss += v[i][0] * v[i][0] + v[i][1] * v[i][1] + v[i][2] * v[i][2] + v[i][3] * v[i][3]; }
            ss = wave_sum(ss); const float rstd = rsqrtf(ss * (1.0f / DM) + NORM_EPS);
            if (FINAL) {
#pragma unroll
                for (int i = 0; i < 4; ++i) { const int col = F.lane * 4 + 256 * i; const f32x4 w4 = *(const f32x4*)(p->final_w + col); *(f32x4*)(p->out + (size_t)row * DM + col) = v[i] * rstd * w4; }
            } else {
                const float* modn = mod + (size_t)NB * 6 * DM; const float* nwn = p->norm_mix_w + (l + 1) * DM; bf16_t* h = (bf16_t*)(p->ws + WS_R2);
#pragma unroll
                for (int i = 0; i < 4; ++i) { const int col = F.lane * 4 + 256 * i;
                    u32x2 pk; pk[0] = cvt_pk_bf16(v[i][0], v[i][1]); pk[1] = cvt_pk_bf16(v[i][2], v[i][3]);
                    *(u32x2*)(xo + (size_t)row * DM + col) = pk;
                    const f32x4 w4 = *(const f32x4*)(nwn + col), sh = *(const f32x4*)(modn + (size_t)b * 6 * DM + col), s1 = *(const f32x4*)(modn + (size_t)b * 6 * DM + DM + col);
                    const f32x4 o = v[i] * rstd * w4 * (s1 + 1.0f) + sh;
                    u32x2 pk2; pk2[0] = cvt_pk_bf16(o[0], o[1]); pk2[1] = cvt_pk_bf16(o[2], o[3]);
                    *(u32x2*)(h + (size_t)row * DM + col) = pk2; }
            }
        }
    }
}


__device__ __forceinline__ Ctx make_ctx(LAS unsigned char* lds) {
    int tz = threadIdx.x; asm volatile("" : "+v"(tz));
    Ctx F; F.lds = lds; F.tid = tz; F.lane = tz & 63; F.wave = __builtin_amdgcn_readfirstlane(tz >> 6);
    F.G = gridDim.x; F.gwave = blockIdx.x * NWAVES + F.wave; F.nwaves = F.G * NWAVES; return F;
}

constexpr int PH_PER_LAYER = 10, N_PHASES = 1 + DEPTH * PH_PER_LAYER;
#ifndef DBG_MASK
#define DBG_MASK 0xFFFFFFFFu
#endif
#define IN(k) ((((DBG_MASK) >> ((k) == 0 ? 0 : (((k) - 1) % PH_PER_LAYER) + 1)) & 1u) && lo <= (k) && (k) < hi)
#define SEAM(k) do { if (IN(k) && IN((k) + 1)) xcd_barrier(bar); if constexpr (DBG_TIMEPH == (k)) tstamp[1] = __builtin_amdgcn_s_memrealtime(); } while (0)
#define SITE KParams P = get_params(); const Ctx F = make_ctx(lds);
#ifndef DBG_REPEAT
#define DBG_REPEAT 0u
#endif
#define NREP(k) (1 + (int)(((DBG_REPEAT) >> ((k) == 0 ? 0 : (((k) - 1) % PH_PER_LAYER) + 1)) & 1u))
#ifndef DBG_TIMEPH
#define DBG_TIMEPH (-1)
#endif
#define PHASE(k, ...) { if constexpr (DBG_TIMEPH == (k)) { if (tstamp[0] == 0ull) tstamp[0] = __builtin_amdgcn_s_memrealtime(); } if (IN(k)) { __VA_ARGS__ } if constexpr (NREP(k) == 2) { if (IN(k)) { xcd_barrier(bar); __VA_ARGS__ } } }

template <int l>
__device__ __forceinline__ void run_layer(LAS unsigned char* const lds, const int lo, const int hi, const XcdBarrier& bar, unsigned long long (&tstamp)[2]) {
        const int base = 1 + l * PH_PER_LAYER;
        if constexpr (l == 0) {
            PHASE(base + 0, { SITE phase_convert(P, F); } { SITE phase_norm1(P, F, l, P->x); })
            SEAM(base + 0);
        }
        PHASE(base + 1, SITE
            pg8::Gemm g{(const bf16_t*)(P->ws + WS_R2), (const bf16_t*)(P->ws + WS_WIN) + (size_t)l * PROJ * DM, MTOK, PROJ, DM};
            pg8::StaticOrder S; S.init(MTOK, PROJ, F.G, (int)blockIdx.x);
            pg8::EpiBf16 E{(bf16_t*)(P->ws + WS_R1), PROJ};
            pg8::gemm_phase(F.lds, g, S, E);)
        SEAM(base + 1);
        PHASE(base + 2, SITE phase_lru<false>(P, F, l);)
        PHASE(base + 2, SITE phase_hgrn<false>(P, F, l);)
        SEAM(base + 2);
        PHASE(base + 3, SITE phase_lru<true>(P, F, l);)
        if (IN(base + 3)) { SITE phase_hgrn_prefix(P, F, l); }
        SEAM(base + 3);
        PHASE(base + 4, SITE phase_hgrn<true>(P, F, l);)
        SEAM(base + 4);
        PHASE(base + 5, SITE
            pg8::Gemm g{(const bf16_t*)(P->ws + WS_R3), (const bf16_t*)(P->ws + WS_WOUT) + (size_t)l * DM * DM, MTOK, DM, DM};
            pg8::StaticOrder S; S.init(MTOK, DM, F.G, (int)blockIdx.x);
            pg8::EpiResid<l == 0> E{(l == 0) ? (const void*)P->x : (const void*)P->out, (bf16_t*)(P->ws + WS_XA), (const float*)(P->ws + WS_MOD) + (size_t)l * NB * 6 * DM + 2 * DM};
            pg8::gemm_phase(F.lds, g, S, E);)
        SEAM(base + 5);
        PHASE(base + 6, SITE phase_route(P, F, l);)
        SEAM(base + 6);
        PHASE(base + 7, SITE
            build_tile_table(P, F, l);
            pg8::Gemm g{(const bf16_t*)(P->ws + WS_R2), (const bf16_t*)(P->ws + WS_WGU) + (size_t)l * NEXP * 1024 * DM, MTOK, NEXP * 1024, DM};
            pg8::MoeOrder S{(const LAS int*)(F.lds + LDS_MISC + 256)};
            pg8::EpiGateUp E{(bf16_t*)(P->ws + WS_R1)};
            pg8::gemm_phase_gather(F.lds, g, S, E, (const LAS int*)(F.lds + LDS_MISC + 1024));)
        SEAM(base + 7);
        PHASE(base + 8, SITE
            build_tile_table(P, F, l);
            pg8::Gemm g{(const bf16_t*)(P->ws + WS_R1), (const bf16_t*)(P->ws + WS_WD) + (size_t)l * NEXP * 1024 * DEXP, MPAD, NEXP * 1024, DEXP};
            pg8::MoeOrder S{(const LAS int*)(F.lds + LDS_MISC + 256)};
            pg8::EpiDown E{(bf16_t*)(P->ws + WS_R1 + WS_R1_Y), (const LAS int*)(F.lds + LDS_MISC + 1024), (const LAS float*)(F.lds + LDS_MISC + 5120)};
            pg8::gemm_phase(F.lds, g, S, E);)
        SEAM(base + 8);
        PHASE(base + 9, SITE if (l == DEPTH - 1) phase_combine<true>(P, F, l, nullptr); else phase_combine<false>(P, F, l, (bf16_t*)P->out);)
        SEAM(base + 9);
    }

__global__ void __launch_bounds__(NTHREADS, 2) mega(Params p_unused) {
    (void)p_unused;
    extern __shared__ __attribute__((aligned(16))) unsigned char lds_raw[];
    LAS unsigned char* const lds = (LAS unsigned char*)lds_raw;
    int lo, hi; XcdBarrier bar; unsigned long long tstamp[2] = {0ull, 0ull};
    { KParams P = get_params(); lo = (int)P->ph_lo; hi = (int)P->ph_hi;
      if (threadIdx.x < 12) ((LAS unsigned*)(lds + LDS_MISC))[threadIdx.x] = 0u;
      __syncthreads();
      bar.bar = (unsigned*)(P->ws + WS_CTL); bar.x = 0; bar.st = nullptr;
      if (hi - lo > 1) bar = xcd_barrier_post((unsigned*)(P->ws + WS_CTL), (volatile LAS unsigned*)(lds + LDS_MISC)); }

    PHASE(0, SITE phase_prologue(P, F);)
    SEAM(0);
    run_layer<0>(lds, lo, hi, bar, tstamp);
    run_layer<1>(lds, lo, hi, bar, tstamp);
    if constexpr (DBG_TA >= 0) { if (blockIdx.x == 0 && threadIdx.x == 0) { const LAS unsigned long long* ts_ = (const LAS unsigned long long*)(lds + LDS_MISC + 32);
        const unsigned long long dt = (ts_[1] - ts_[0]) * 10ull, t0 = __builtin_amdgcn_s_memrealtime();
        while (__builtin_amdgcn_s_memrealtime() - t0 < dt) __builtin_amdgcn_s_sleep(8); } }
    if constexpr (DBG_TIMEPH >= 0) { if (blockIdx.x == 0 && threadIdx.x == 0) { const unsigned long long dt = (tstamp[1] - tstamp[0]) * 10ull, t0 = __builtin_amdgcn_s_memrealtime();
        while (__builtin_amdgcn_s_memrealtime() - t0 < dt) __builtin_amdgcn_s_sleep(8); } }
#undef IN
#undef SEAM
#undef SITE
}

extern "C" void kernel_launch(void* const* d_in, const int* in_sizes, int n_in, void* d_out, int out_size, void* d_ws, size_t ws_size, hipStream_t stream) {
    static int grid = 0;
    if (grid == 0) {
        if (n_in != 26 || in_sizes[0] != MTOK * DM || out_size != MTOK * DM || ws_size < WS_END) {
            fprintf(stderr, "kernel_launch: unexpected shapes (n_in %d, in0 %d, out %d, ws %zu, need %zu); nothing launched\n", n_in, n_in > 0 ? in_sizes[0] : -1, out_size, ws_size, (size_t)WS_END); grid = -1; return; }
        int dev = 0, cus = 0, per_cu = 0;
        if (hipGetDevice(&dev) != hipSuccess || hipDeviceGetAttribute(&cus, hipDeviceAttributeMultiprocessorCount, dev) != hipSuccess) { fprintf(stderr, "kernel_launch: device query failed\n"); grid = -1; return; }
        if (hipFuncSetAttribute((const void*)mega, hipFuncAttributeMaxDynamicSharedMemorySize, LDS_BYTES) != hipSuccess) { fprintf(stderr, "kernel_launch: hipFuncSetAttribute failed\n"); grid = -1; return; }
        if (hipOccupancyMaxActiveBlocksPerMultiprocessor(&per_cu, (const void*)mega, NTHREADS, LDS_BYTES) != hipSuccess || per_cu < 1)
            fprintf(stderr, "kernel_launch: note: occupancy query reports %d workgroups per CU\n", per_cu);
        (void)hipGetLastError();
        grid = cus;
    }
    if (grid < 0) return;
    if (hipMemsetAsync((char*)d_ws + WS_CTL, 0, CTL_ZERO_BYTES, stream) != hipSuccess) { fprintf(stderr, "kernel_launch: memset failed\n"); return; }
    Params p{};
    const float** pf = (const float**)&p;
    for (int i = 0; i < 26; ++i) pf[i] = (const float*)d_in[i];
    p.out = (float*)d_out; p.ws = (unsigned char*)d_ws;
#if MK_PER_PHASE
    for (int ph = 0; ph < N_PHASES; ++ph) { p.ph_lo = ph; p.ph_hi = ph + 1;
        hipLaunchKernelGGL(mega, dim3(grid), dim3(NTHREADS), LDS_BYTES, stream, p);
        const hipError_t le = hipPeekAtLastError();
        if (le != hipSuccess) { fprintf(stderr, "kernel_launch: launch %d failed: %s\n", ph, hipGetErrorName(le)); break; } }
#else
    p.ph_lo = 0; p.ph_hi = N_PHASES;
    hipLaunchKernelGGL(mega, dim3(grid), dim3(NTHREADS), LDS_BYTES, stream, p);
    const hipError_t le = hipPeekAtLastError();
    if (le != hipSuccess) fprintf(stderr, "kernel_launch: launch failed: %s\n", hipGetErrorName(le));
#endif
}
```

```cpp
#include <hip/hip_runtime.h>
#include <stdint.h>
#include <stdio.h>

#ifndef MK_PER_PHASE
#define MK_PER_PHASE 0
#endif

#define LAS __attribute__((address_space(3)))
typedef unsigned short bf16_t;
typedef short bf16x8 __attribute__((ext_vector_type(8)));
typedef float f32x4 __attribute__((ext_vector_type(4)));
typedef float f32x2 __attribute__((ext_vector_type(2)));
typedef unsigned u32x4 __attribute__((ext_vector_type(4)));
typedef unsigned u32x2 __attribute__((ext_vector_type(2)));
typedef int i32x4 __attribute__((ext_vector_type(4)));

constexpr int NB = 4, SEQ = 4096, DM = 1024, MTOK = NB * SEQ, DEPTH = 2;
constexpr int DLRU = 512, DHG = 512, PROJ = 3584, NEXP = 32, DEXP = 512, NGRP = 4, EPG = 8;
constexpr int MPAD = 40960;
constexpr float NORM_EPS = 1e-6f;
constexpr int NWAVES = 8, NTHREADS = 512;

constexpr size_t WS_CTL = 0;
constexpr size_t CTL_ZERO_BYTES = 32768;
constexpr size_t CTL_CNT_OFF = 16384;
constexpr int CNT_STRIDE = 32;
constexpr size_t WS_MOD = 65536;
constexpr size_t WS_WIN = WS_MOD + 196608;
constexpr size_t WS_WOUT = WS_WIN + (size_t)DEPTH * PROJ * DM * 2;
constexpr size_t WS_WGU = WS_WOUT + (size_t)DEPTH * DM * DM * 2;
constexpr size_t WS_WD = WS_WGU + (size_t)DEPTH * NEXP * 1024 * 1024 * 2;
constexpr size_t WS_R1 = WS_WD + (size_t)DEPTH * NEXP * 1024 * 512 * 2;
constexpr size_t WS_R1_Y = 48u << 20;
constexpr size_t WS_R2 = WS_R1 + (size_t)MTOK * PROJ * 2;
constexpr size_t WS_R3 = WS_R2 + (size_t)MPAD * 512 * 2;
constexpr size_t WS_XA = WS_R3 + (size_t)MTOK * DM * 2;
constexpr size_t WS_TOKW = WS_XA + (size_t)MTOK * DM * 4;
constexpr size_t WS_ROWCAP = WS_TOKW + (size_t)MTOK * 8;
constexpr size_t WS_LRUW = WS_ROWCAP + (size_t)NEXP * MTOK * 4;
constexpr size_t WS_SUMA = WS_LRUW + 524288;
constexpr size_t WS_SUMH = WS_SUMA + 1048576;
constexpr size_t WS_RWHI = WS_SUMH + 1048576;
constexpr size_t WS_RWLO = WS_RWHI + (size_t)DEPTH * 64 * DM * 2;
constexpr size_t WS_END = WS_RWLO + (size_t)DEPTH * 64 * DM * 2;

constexpr int LDS_STAGE = 139264;
constexpr int LDS_MISC = LDS_STAGE;
constexpr int LDS_BYTES = LDS_STAGE + 10240;

#define XB_TMO      128
#define XB_XCNT(j)  (256  + 64 * (j))
#define XB_XSUB(j)  (1280 + 64 * (j))
#define XB_XGEN(j)  (2304 + 64 * (j))
#define XB_TOP      3328
#define XB_TOPGEN   3392
#define XCD_BAR_WORDS 3456
#define XB_SPIN_CAP (1u << 22)

__device__ __forceinline__ unsigned xb_ld(unsigned* p)              { return __hip_atomic_load(p, __ATOMIC_RELAXED, __HIP_MEMORY_SCOPE_AGENT); }
__device__ __forceinline__ unsigned xb_add(unsigned* p, unsigned v) { return __hip_atomic_fetch_add(p, v, __ATOMIC_RELAXED, __HIP_MEMORY_SCOPE_AGENT); }
__device__ __forceinline__ unsigned xb_xcc_id() { return (unsigned)__builtin_amdgcn_s_getreg((3 << 11) | 20) & 0xFu; }
#define XB_SPIN(cond, bar) do { unsigned _sp = 0; while (cond) { __builtin_amdgcn_s_sleep(1); \
    if ((++_sp & 255u) == 0u) { if (xb_ld(&(bar)[XB_TMO])) break; if (_sp > XB_SPIN_CAP) { atomicAdd(&(bar)[XB_TMO], 1u); break; } } } } while (0)

struct XcdBarrier { unsigned* bar; unsigned x; volatile LAS unsigned* st; };

__device__ __forceinline__ XcdBarrier xcd_barrier_post(unsigned* bar, volatile LAS unsigned* st) {
    XcdBarrier b; b.bar = bar; b.x = xb_xcc_id(); b.st = st;
    if (threadIdx.x == 0) (void)xb_add(&bar[XB_XCNT(b.x)], 1u);
    return b;
}
__device__ __forceinline__ void xcd_barrier_complete(unsigned* bar, unsigned x, unsigned& nloc, unsigned& nx) {
    const unsigned G = gridDim.x * gridDim.y * gridDim.z;
    unsigned sum, cnt, mine, sp = 0u;
    for (;;) {
        sum = 0u; cnt = 0u; mine = 0u;
#pragma unroll
        for (unsigned j = 0; j < 16; ++j) { const unsigned c = xb_ld(&bar[XB_XCNT(j)]); sum += c; cnt += (c > 0u) ? 1u : 0u; mine = (j == x) ? c : mine; }
        if (sum == G) break;
        __builtin_amdgcn_s_sleep(1);
        if ((++sp & 255u) == 0u) { if (xb_ld(&bar[XB_TMO])) break; if (sp > XB_SPIN_CAP) { atomicAdd(&bar[XB_TMO], 1u); break; } }
    }
    nloc = mine > 0u ? mine : 1u; nx = cnt > 0u ? cnt : 1u;
}
__device__ __forceinline__ void xcd_barrier(const XcdBarrier& b) {
    asm volatile("s_waitcnt vmcnt(0)" ::: "memory");
    __syncthreads();
    if (threadIdx.x == 0) {
        unsigned* bar = b.bar;
        __builtin_amdgcn_s_waitcnt(0);
        unsigned nloc = b.st[0], nx = b.st[1];
        if (nloc == 0u) { xcd_barrier_complete(bar, b.x, nloc, nx); b.st[0] = nloc; b.st[1] = nx; }
        const unsigned old = xb_add(&bar[XB_XSUB(b.x)], 1u);
        const unsigned gen = old / nloc;
        if (old + 1u == (gen + 1u) * nloc) {
            __builtin_amdgcn_fence(__ATOMIC_RELEASE, "agent");
            asm volatile("s_waitcnt vmcnt(0)" ::: "memory");
            const unsigned og = xb_add(&bar[XB_TOP], 1u);
            const unsigned tg = og / nx;
            if (og + 1u == (tg + 1u) * nx) xb_add(&bar[XB_TOPGEN], 1u);
            else XB_SPIN(xb_ld(&bar[XB_TOPGEN]) == tg, bar);
            __builtin_amdgcn_fence(__ATOMIC_ACQUIRE, "agent");
            xb_add(&bar[XB_XGEN(b.x)], 1u);
            asm volatile("s_waitcnt vmcnt(0)" ::: "memory");
        } else {
            XB_SPIN(xb_ld(&bar[XB_XGEN(b.x)]) == gen, bar);
            __builtin_amdgcn_fence(__ATOMIC_ACQUIRE, "agent");
            asm volatile("s_waitcnt vmcnt(0)" ::: "memory");
        }
    }
    __syncthreads();
}

#ifndef DBG_TA
#define DBG_TA (-1)
#endif
#ifndef DBG_TB
#define DBG_TB (-1)
#endif
#ifndef DBG_TT
#define DBG_TT 0
#endif
#define TP(n, ldsbase) do { if ((DBG_TA == (n) || DBG_TB == (n)) && blockIdx.x == 0 && threadIdx.x == DBG_TT) { LAS unsigned long long* ts_ = (LAS unsigned long long*)((ldsbase) + LDS_MISC + 32); \
    const unsigned long long now_ = __builtin_amdgcn_s_memrealtime(); if (DBG_TA == (n) && ts_[0] == 0ull) ts_[0] = now_; if (DBG_TB == (n)) ts_[1] = now_; } } while (0)
__device__ __forceinline__ float bf2f(bf16_t b) { return __uint_as_float(((unsigned)b) << 16); }
__device__ __forceinline__ bf16_t f2bf(float f) { unsigned u = __float_as_uint(f); u += 0x7FFFu + ((u >> 16) & 1u); return (bf16_t)(u >> 16); }
__device__ __forceinline__ unsigned cvt_pk_bf16(float lo, float hi) { unsigned r; asm volatile("v_cvt_pk_bf16_f32 %0, %1, %2" : "=v"(r) : "v"(lo), "v"(hi)); return r; }
__device__ __forceinline__ void st16_wt(void* p, u32x4 v) { asm volatile("global_store_dwordx4 %0, %1, off sc1\n\ts_nop 1" :: "v"(p), "v"(v) : "memory"); }
__device__ __forceinline__ float wave_sum(float v) {
#pragma unroll
    for (int m = 32; m >= 1; m >>= 1) v += __shfl_xor(v, m, 64);
    return v;
}
#define LOG2E_F 1.4426950408889634f
__device__ __forceinline__ float fexp2(float x) { return __builtin_amdgcn_exp2f(x); }
__device__ __forceinline__ float flog2(float x) { return __builtin_amdgcn_logf(x); }
__device__ __forceinline__ float frcp(float x) { return __builtin_amdgcn_rcpf(x); }
__device__ __forceinline__ float sigmoidf_(float x) { return frcp(1.0f + fexp2(-LOG2E_F * x)); }
__device__ __forceinline__ float siluf_(float x) { return x * sigmoidf_(x); }
__device__ __forceinline__ float gelu_tanh(float x) {
    const float u2 = 1.5957691216057308f * (x + 0.044715f * x * x * x);
    return x * sigmoidf_(u2);
}
__device__ __forceinline__ float rdlane(float v, int l) { return __int_as_float(__builtin_amdgcn_readlane(__float_as_int(v), l)); }

namespace pg8 {
constexpr int BM = 256, BK = 64, HALF = 128, HTB = HALF * BK * 2, STAGE_BYTES = 8 * HTB, NXCD = 8, WGM = 8;
__host__ __device__ __forceinline__ int lds_byte(int r, int c) { const int st = (r >> 4) * 2 + (c >> 5), rr = r & 15, cc = c & 31, ob = rr * 64 + cc * 2; return st * 1024 + (ob ^ (((ob >> 9) & 1) << 5)); }
__host__ __device__ __forceinline__ void stage_rc(int b, int& R, int& C) { const int st = b / 1024, sb = b % 1024, swz = sb ^ (((sb >> 9) & 1) << 5); R = (st >> 1) * 16 + swz / 64; C = (st & 1) * 32 + (swz % 64) / 2; }
__host__ __device__ __forceinline__ int perm32(int rho) { const int n = rho >> 4, i = rho & 15; return 8 * (i >> 2) + 4 * n + (i & 3); }

struct Unit { int pm, pn, aux0, aux1; };
struct Gemm { const bf16_t* A; const bf16_t* Bt; int M, N, K; };

struct StaticOrder {
    int nM, nN, nwg, G, c;
    __host__ __device__ void init(int M, int N, int G_, int c_) { nM = M / BM; nN = N / BM; nwg = nM * nN; G = G_; c = c_; }
    __host__ __device__ bool next(int i, Unit& u) const {
        const long L = (long)i * G + c; if (L >= nwg) return false;
        int wgid = (int)L; { const int q = nwg / NXCD, r = nwg % NXCD, xcd = wgid % NXCD, off = wgid / NXCD; wgid = (xcd < r ? xcd * (q + 1) : r * (q + 1) + (xcd - r) * q) + off; }
        const int nig = WGM * nN, gid = wgid / nig, fm = gid * WGM, gsz = (nM - fm) < WGM ? (nM - fm) : WGM;
        u.pm = fm + ((wgid % nig) % gsz); u.pn = (wgid % nig) / gsz; u.aux0 = 0; u.aux1 = 0; return true;
    }
    __device__ __forceinline__ void a_ready(const Unit&) const {}
    __device__ __forceinline__ void done(const Unit&) const {}
};

struct MoeOrder {
    const LAS int* ulist;
    __device__ __forceinline__ bool next(int i, Unit& u) const {
        const int pm = __builtin_amdgcn_readfirstlane(ulist[4 * i]); if (pm < 0) return false;
        u.pm = pm; u.pn = __builtin_amdgcn_readfirstlane(ulist[4 * i + 1]); u.aux0 = __builtin_amdgcn_readfirstlane(ulist[4 * i + 2]); u.aux1 = __builtin_amdgcn_readfirstlane(ulist[4 * i + 3]); return true;
    }
    __device__ __forceinline__ void a_ready(const Unit&) const {}
    __device__ __forceinline__ void done(const Unit&) const {}
};

struct EpiBf16 {
    static constexpr bool PERM = true;
    bf16_t* O; int ldc;
    __device__ __forceinline__ void operator()(const f32x4 (&acc)[2][2][4][2], const Unit& u, int wr, int wc, int fr, int fq) const {
        const int row0 = u.pm * BM + wr * 64 + fr, col0 = u.pn * BM + wc * 32 + 8 * fq;
#pragma unroll
        for (int ai = 0; ai < 2; ++ai)
#pragma unroll
            for (int m = 0; m < 4; ++m) { bf16_t* rowp = O + (size_t)(row0 + ai * HALF + m * 16) * ldc + col0;
#pragma unroll
                for (int bj = 0; bj < 2; ++bj) { const f32x4 v0 = acc[ai][bj][m][0], v1 = acc[ai][bj][m][1];
                    u32x4 o; o[0] = cvt_pk_bf16(v0[0], v0[1]); o[1] = cvt_pk_bf16(v0[2], v0[3]); o[2] = cvt_pk_bf16(v1[0], v1[1]); o[3] = cvt_pk_bf16(v1[2], v1[3]);
                    st16_wt(rowp + bj * HALF, o); } }
    }
};
template <bool XIN_F32>
struct EpiResid {
    static constexpr bool PERM = true;
    const void* XI; bf16_t* XO; const float* gate;
    __device__ __forceinline__ void operator()(const f32x4 (&acc)[2][2][4][2], const Unit& u, int wr, int wc, int fr, int fq) const {
        const int row0 = u.pm * BM + wr * 64 + fr, col0 = u.pn * BM + wc * 32 + 8 * fq;
        const int b = (u.pm * BM) / SEQ;
        f32x4 gv[2][2];
#pragma unroll
        for (int bj = 0; bj < 2; ++bj)
#pragma unroll
            for (int n = 0; n < 2; ++n) gv[bj][n] = *(const f32x4*)(gate + (size_t)b * 6 * DM + col0 + bj * HALF + n * 4);
#pragma unroll
        for (int ai = 0; ai < 2; ++ai) {
            f32x4 xf[4][2][2]; u32x4 xb[4][2];
#pragma unroll
            for (int m = 0; m < 4; ++m) { const size_t ro = (size_t)(row0 + ai * HALF + m * 16) * DM + col0;
#pragma unroll
                for (int bj = 0; bj < 2; ++bj) {
                    if (XIN_F32) { xf[m][bj][0] = *(const f32x4*)((const float*)XI + ro + bj * HALF); xf[m][bj][1] = *(const f32x4*)((const float*)XI + ro + bj * HALF + 4); }
                    else xb[m][bj] = *(const u32x4*)((const bf16_t*)XI + ro + bj * HALF); } }
            __builtin_amdgcn_sched_barrier(0);
#pragma unroll
            for (int m = 0; m < 4; ++m) { const size_t ro = (size_t)(row0 + ai * HALF + m * 16) * DM + col0;
#pragma unroll
                for (int bj = 0; bj < 2; ++bj) { f32x4 x0, x1;
                    if (XIN_F32) { x0 = xf[m][bj][0]; x1 = xf[m][bj][1]; }
                    else { const u32x4 xv = xb[m][bj];
                        x0 = (f32x4){__uint_as_float(xv[0] << 16), __uint_as_float(xv[0] & 0xFFFF0000u), __uint_as_float(xv[1] << 16), __uint_as_float(xv[1] & 0xFFFF0000u)};
                        x1 = (f32x4){__uint_as_float(xv[2] << 16), __uint_as_float(xv[2] & 0xFFFF0000u), __uint_as_float(xv[3] << 16), __uint_as_float(xv[3] & 0xFFFF0000u)}; }
                    const f32x4 v0 = x0 + gv[bj][0] * acc[ai][bj][m][0], v1 = x1 + gv[bj][1] * acc[ai][bj][m][1];
                    u32x4 o; o[0] = cvt_pk_bf16(v0[0], v0[1]); o[1] = cvt_pk_bf16(v0[2], v0[3]); o[2] = cvt_pk_bf16(v1[0], v1[1]); o[3] = cvt_pk_bf16(v1[2], v1[3]);
                    st16_wt(XO + ro + bj * HALF, o); } }
        }
    }
};
struct EpiGateUp {
    static constexpr bool PERM = true;
    bf16_t* H;
    __device__ __forceinline__ void operator()(const f32x4 (&acc)[2][2][4][2], const Unit& u, int wr, int wc, int fr, int fq) const {
        const int row0 = u.pm * BM + wr * 64 + fr, col0 = (u.pn & 3) * 128 + wc * 32 + 8 * fq;
#pragma unroll
        for (int ai = 0; ai < 2; ++ai)
#pragma unroll
            for (int m = 0; m < 4; ++m) { bf16_t* rowp = H + (size_t)(row0 + ai * HALF + m * 16) * DEXP + col0;
                float h[8];
#pragma unroll
                for (int n = 0; n < 2; ++n)
#pragma unroll
                    for (int q = 0; q < 4; ++q) { const float g = acc[ai][0][m][n][q], up = acc[ai][1][m][n][q]; h[n * 4 + q] = g * __builtin_amdgcn_rcpf(1.0f + __builtin_amdgcn_exp2f(-1.4426950408889634f * g)) * up; }
                u32x4 o; o[0] = cvt_pk_bf16(h[0], h[1]); o[1] = cvt_pk_bf16(h[2], h[3]); o[2] = cvt_pk_bf16(h[4], h[5]); o[3] = cvt_pk_bf16(h[6], h[7]);
                st16_wt(rowp, o); }
    }
};
struct EpiDown {
    static constexpr bool PERM = true;
    bf16_t* Y; const LAS int* utok; const LAS float* utw;
    __device__ __forceinline__ void operator()(const f32x4 (&acc)[2][2][4][2], const Unit& u, int wr, int wc, int fr, int fq) const {
        const int rl0 = u.aux0 + wr * 64 + fr, col0 = (u.pn & 3) * BM + wc * 32 + 8 * fq;
#pragma unroll
        for (int ai = 0; ai < 2; ++ai)
#pragma unroll
            for (int m = 0; m < 4; ++m) { const int rl = rl0 + ai * HALF + m * 16; const int rt = utok[rl];
                if (rt >= 0) { const float w = utw[rl]; bf16_t* rowp = Y + (size_t)rt * DM + col0;
#pragma unroll
                    for (int bj = 0; bj < 2; ++bj) { const f32x4 v0 = acc[ai][bj][m][0] * w, v1 = acc[ai][bj][m][1] * w;
                        u32x4 o; o[0] = cvt_pk_bf16(v0[0], v0[1]); o[1] = cvt_pk_bf16(v0[2], v0[3]); o[2] = cvt_pk_bf16(v1[0], v1[1]); o[3] = cvt_pk_bf16(v1[2], v1[3]);
                        st16_wt(rowp + bj * HALF, o); } } }
    }
};

template <class Epi, class Sched>
__device__ __forceinline__ void gemm_phase(LAS unsigned char* lds, const Gemm g, const Sched& S, const Epi& E) {
    const int tid = threadIdx.x, wid = __builtin_amdgcn_readfirstlane(tid >> 6), lane = tid & 63, wr = wid >> 2, wc = wid & 3, fr = lane & 15, fq = lane >> 4;
    const int K = g.K, nt = K / BK;
    unsigned voffA[2], voffB[2];
#pragma unroll
    for (int i = 0; i < 2; ++i) { int R, C; stage_rc(tid * 16 + i * 8192, R, C); const int Rb = Epi::PERM ? ((R & ~31) + perm32(R & 31)) : R;
        voffA[i] = (unsigned)(R * K + C) * 2u; voffB[i] = (unsigned)(Rb * K + C) * 2u; }
    const size_t kstep = (size_t)(BK * 2);
    const size_t hstep = (size_t)HALF * K * 2;
    const size_t tstep = 2 * hstep;
    const unsigned ldsw = (unsigned)wid * 1024u;
    const int aoff = lds_byte(wr * 64 + fr, fq * 8), boff = lds_byte(wc * 32 + fr, fq * 8);
#define PG8_SA(b, h) (((b) * 2 + (h)) * HTB)
#define PG8_SB(b, h) ((4 + (b) * 2 + (h)) * HTB)
#define PG8_STAGE(bufoff, gbase, voff) do { _Pragma("unroll") for (int _i = 0; _i < 2; ++_i) \
        __builtin_amdgcn_global_load_lds((const unsigned*)((const char*)(gbase) + (voff)[_i]), (LAS unsigned*)(lds + (bufoff) + ldsw + _i * 8192), 16, 0, 0); } while (0)
#define PG8_LDA(dst, b, h) do { _Pragma("unroll") for (int m = 0; m < 4; ++m) _Pragma("unroll") for (int k = 0; k < 2; ++k) dst[m][k] = *(const LAS bf16x8*)(lds + PG8_SA(b, h) + aoff + m * 2048 + k * 1024); } while (0)
#define PG8_LDB(dst, b, h) do { _Pragma("unroll") for (int n = 0; n < 2; ++n) _Pragma("unroll") for (int k = 0; k < 2; ++k) dst[n][k] = *(const LAS bf16x8*)(lds + PG8_SB(b, h) + boff + n * 2048 + k * 1024); } while (0)
#define PG8_MMA(ai, bj, At, Bt) do { __builtin_amdgcn_s_setprio(1); _Pragma("unroll") for (int m = 0; m < 4; ++m) _Pragma("unroll") for (int n = 0; n < 2; ++n) _Pragma("unroll") for (int k = 0; k < 2; ++k) \
        acc[ai][bj][m][n] = __builtin_amdgcn_mfma_f32_16x16x32_bf16(Bt[n][k], At[m][k], acc[ai][bj][m][n], 0, 0, 0); __builtin_amdgcn_s_setprio(0); } while (0)
#define PG8_WAIT_V(n) asm volatile("s_waitcnt vmcnt(" #n ")" ::: "memory")
#define PG8_WAIT_L(n) asm volatile("s_waitcnt lgkmcnt(" #n ")" ::: "memory")
#define PG8_BAR __builtin_amdgcn_s_barrier()
#define PG8_SCHED __builtin_amdgcn_sched_barrier(0)
    Unit cur, nxt; int ui = 0;
    if (!S.next(0, cur)) return;
    f32x4 acc[2][2][4][2];
#pragma unroll
    for (int a = 0; a < 2; ++a)
#pragma unroll
        for (int b = 0; b < 2; ++b)
#pragma unroll
            for (int m = 0; m < 4; ++m)
#pragma unroll
                for (int n = 0; n < 2; ++n) acc[a][b][m][n] = (f32x4){0.f, 0.f, 0.f, 0.f};
    bf16x8 At[4][2], B0[2][2], B1[2][2];
    const char* cA = (const char*)g.A + (size_t)cur.pm * tstep; const char* cB = (const char*)g.Bt + (size_t)cur.pn * tstep;
    S.a_ready(cur);
    PG8_STAGE(PG8_SB(0, 0), cB, voffB); PG8_STAGE(PG8_SA(0, 0), cA, voffA); PG8_STAGE(PG8_SB(0, 1), cB + hstep, voffB); PG8_STAGE(PG8_SA(0, 1), cA + hstep, voffA);
    if (wr == 1) PG8_BAR;
    PG8_WAIT_V(4); PG8_BAR;
    PG8_STAGE(PG8_SB(1, 0), cB + kstep, voffB); PG8_STAGE(PG8_SA(1, 0), cA + kstep, voffA); PG8_STAGE(PG8_SB(1, 1), cB + hstep + kstep, voffB);
    PG8_WAIT_V(6); PG8_BAR;
    for (;;) {
        const bool has_next = S.next(ui + 1, nxt);
        const bool half1 = !(cur.aux1 > 0 && cur.aux1 <= HALF);
        const char* nA = has_next ? (const char*)g.A + (size_t)nxt.pm * tstep : cA; const char* nB = has_next ? (const char*)g.Bt + (size_t)nxt.pn * tstep : cB;
        for (int t = 0; t < nt; t += 2) {
            const bool last = (t == nt - 2);
            const char* a1 = cA + (size_t)(t + 1) * kstep;
            const char* a2 = last ? nA : cA + (size_t)(t + 2) * kstep; const char* b2 = last ? nB : cB + (size_t)(t + 2) * kstep;
            const char* a3 = a2 + kstep; const char* b3 = b2 + kstep;
            if (last && has_next) S.a_ready(nxt);
            PG8_LDB(B0, 0, 0); PG8_SCHED; PG8_LDA(At, 0, 0); PG8_STAGE(PG8_SA(1, 1), a1 + hstep, voffA);
            PG8_WAIT_L(8); PG8_BAR; PG8_WAIT_L(0); PG8_MMA(0, 0, At, B0); PG8_BAR; PG8_SCHED;
            PG8_LDB(B1, 0, 1); PG8_STAGE(PG8_SB(0, 0), b2, voffB);
            PG8_BAR; PG8_WAIT_L(0); PG8_MMA(0, 1, At, B1); PG8_BAR;
            if (half1) PG8_LDA(At, 0, 1); PG8_STAGE(PG8_SA(0, 0), a2, voffA);
            PG8_BAR; PG8_WAIT_L(0); if (half1) PG8_MMA(1, 0, At, B0); PG8_BAR; PG8_SCHED;
            PG8_STAGE(PG8_SB(0, 1), b2 + hstep, voffB);
            PG8_WAIT_V(6); PG8_BAR; if (half1) PG8_MMA(1, 1, At, B1); PG8_BAR;
            PG8_LDB(B0, 1, 0); PG8_SCHED; PG8_LDA(At, 1, 0); PG8_STAGE(PG8_SA(0, 1), a2 + hstep, voffA);
            PG8_WAIT_L(8); PG8_BAR; PG8_WAIT_L(0); PG8_MMA(0, 0, At, B0); PG8_BAR; PG8_SCHED;
            PG8_LDB(B1, 1, 1); PG8_STAGE(PG8_SB(1, 0), b3, voffB);
            PG8_BAR; PG8_WAIT_L(0); PG8_MMA(0, 1, At, B1); PG8_BAR;
            if (half1) PG8_LDA(At, 1, 1); PG8_STAGE(PG8_SA(1, 0), a3, voffA);
            PG8_BAR; PG8_WAIT_L(0); if (half1) PG8_MMA(1, 0, At, B0); PG8_BAR; PG8_SCHED;
            PG8_STAGE(PG8_SB(1, 1), b3 + hstep, voffB);
            PG8_WAIT_V(6); PG8_BAR; if (half1) PG8_MMA(1, 1, At, B1); PG8_BAR;
        }
        E(acc, cur, wr, wc, fr, fq); S.done(cur);
        if (!has_next) break;
#pragma unroll
        for (int a = 0; a < 2; ++a)
#pragma unroll
            for (int b = 0; b < 2; ++b)
#pragma unroll
                for (int m = 0; m < 4; ++m)
#pragma unroll
                    for (int n = 0; n < 2; ++n) acc[a][b][m][n] = (f32x4){0.f, 0.f, 0.f, 0.f};
        cur = nxt; cA = nA; cB = nB; ++ui;
    }
    PG8_WAIT_V(0);
    if (wr == 0) PG8_BAR;
    PG8_BAR;
#undef PG8_SA
#undef PG8_SB
#undef PG8_STAGE
#undef PG8_LDA
#undef PG8_LDB
#undef PG8_MMA
#undef PG8_WAIT_V
#undef PG8_WAIT_L
#undef PG8_BAR
#undef PG8_SCHED
}
template <class Epi, class Sched>
__device__ __forceinline__ void gemm_phase_gather(LAS unsigned char* lds, const Gemm g, const Sched& S, const Epi& E, const LAS int* utok) {
    const int tid = threadIdx.x, wid = __builtin_amdgcn_readfirstlane(tid >> 6), lane = tid & 63, wr = wid >> 2, wc = wid & 3, fr = lane & 15, fq = lane >> 4;
    const int K = g.K, nt = K / BK;
    unsigned voffB[2]; int rowA[2]; unsigned colA[2];
#pragma unroll
    for (int i = 0; i < 2; ++i) { int R, C; stage_rc(tid * 16 + i * 8192, R, C); const int Rb = Epi::PERM ? ((R & ~31) + perm32(R & 31)) : R;
        rowA[i] = R; colA[i] = (unsigned)C * 2u; voffB[i] = (unsigned)(Rb * K + C) * 2u; }
    unsigned gC[2][2], gN[2][2];
#define PG8_GOFS(dst, ui_) do { _Pragma("unroll") for (int h_ = 0; h_ < 2; ++h_) _Pragma("unroll") for (int i_ = 0; i_ < 2; ++i_) { \
        const int rt_ = utok[256 * (ui_) + h_ * HALF + rowA[i_]]; (dst)[h_][i_] = (unsigned)(((rt_ < 0 ? 0 : rt_) >> 1) * K) * 2u + colA[i_]; } } while (0)
    const size_t kstep = (size_t)(BK * 2);
    const size_t hstep = (size_t)HALF * K * 2;
    const size_t tstep = 2 * hstep;
    const unsigned ldsw = (unsigned)wid * 1024u;
    const int aoff = lds_byte(wr * 64 + fr, fq * 8), boff = lds_byte(wc * 32 + fr, fq * 8);
#define PG8_SA(b, h) (((b) * 2 + (h)) * HTB)
#define PG8_SB(b, h) ((4 + (b) * 2 + (h)) * HTB)
#define PG8_STAGE(bufoff, gbase, voff) do { _Pragma("unroll") for (int _i = 0; _i < 2; ++_i) \
        __builtin_amdgcn_global_load_lds((const unsigned*)((const char*)(gbase) + (voff)[_i]), (LAS unsigned*)(lds + (bufoff) + ldsw + _i * 8192), 16, 0, 0); } while (0)
#define PG8_LDA(dst, b, h) do { _Pragma("unroll") for (int m = 0; m < 4; ++m) _Pragma("unroll") for (int k = 0; k < 2; ++k) dst[m][k] = *(const LAS bf16x8*)(lds + PG8_SA(b, h) + aoff + m * 2048 + k * 1024); } while (0)
#define PG8_LDB(dst, b, h) do { _Pragma("unroll") for (int n = 0; n < 2; ++n) _Pragma("unroll") for (int k = 0; k < 2; ++k) dst[n][k] = *(const LAS bf16x8*)(lds + PG8_SB(b, h) + boff + n * 2048 + k * 1024); } while (0)
#define PG8_MMA(ai, bj, At, Bt) do { __builtin_amdgcn_s_setprio(1); _Pragma("unroll") for (int m = 0; m < 4; ++m) _Pragma("unroll") for (int n = 0; n < 2; ++n) _Pragma("unroll") for (int k = 0; k < 2; ++k) \
        acc[ai][bj][m][n] = __builtin_amdgcn_mfma_f32_16x16x32_bf16(Bt[n][k], At[m][k], acc[ai][bj][m][n], 0, 0, 0); __builtin_amdgcn_s_setprio(0); } while (0)
#define PG8_WAIT_V(n) asm volatile("s_waitcnt vmcnt(" #n ")" ::: "memory")
#define PG8_WAIT_L(n) asm volatile("s_waitcnt lgkmcnt(" #n ")" ::: "memory")
#define PG8_BAR __builtin_amdgcn_s_barrier()
#define PG8_SCHED __builtin_amdgcn_sched_barrier(0)
    Unit cur, nxt; int ui = 0;
    if (!S.next(0, cur)) return;
    f32x4 acc[2][2][4][2];
#pragma unroll
    for (int a = 0; a < 2; ++a)
#pragma unroll
        for (int b = 0; b < 2; ++b)
#pragma unroll
            for (int m = 0; m < 4; ++m)
#pragma unroll
                for (int n = 0; n < 2; ++n) acc[a][b][m][n] = (f32x4){0.f, 0.f, 0.f, 0.f};
    bf16x8 At[4][2], B0[2][2], B1[2][2];
    const char* cA = (const char*)g.A; const char* cB = (const char*)g.Bt + (size_t)cur.pn * tstep;
    PG8_GOFS(gC, 0);
    S.a_ready(cur);
    PG8_STAGE(PG8_SB(0, 0), cB, voffB); PG8_STAGE(PG8_SA(0, 0), cA, gC[0]); PG8_STAGE(PG8_SB(0, 1), cB + hstep, voffB); PG8_STAGE(PG8_SA(0, 1), cA, gC[1]);
    if (wr == 1) PG8_BAR;
    PG8_WAIT_V(4); PG8_BAR;
    PG8_STAGE(PG8_SB(1, 0), cB + kstep, voffB); PG8_STAGE(PG8_SA(1, 0), cA + kstep, gC[0]); PG8_STAGE(PG8_SB(1, 1), cB + hstep + kstep, voffB);
    PG8_WAIT_V(6); PG8_BAR;
    for (;;) {
        const bool has_next = S.next(ui + 1, nxt);
        const bool half1 = !(cur.aux1 > 0 && cur.aux1 <= HALF);
        const char* nB = has_next ? (const char*)g.Bt + (size_t)nxt.pn * tstep : cB;
        if (has_next) PG8_GOFS(gN, ui + 1); else { gN[0][0] = gC[0][0]; gN[0][1] = gC[0][1]; gN[1][0] = gC[1][0]; gN[1][1] = gC[1][1]; }
        for (int t = 0; t < nt; t += 2) {
            const bool last = (t == nt - 2);
            const char* a1 = cA + (size_t)(t + 1) * kstep;
            const char* a2 = last ? cA : cA + (size_t)(t + 2) * kstep; const char* b2 = last ? nB : cB + (size_t)(t + 2) * kstep;
            unsigned g2[2][2];
            g2[0][0] = last ? gN[0][0] : gC[0][0]; g2[0][1] = last ? gN[0][1] : gC[0][1]; g2[1][0] = last ? gN[1][0] : gC[1][0]; g2[1][1] = last ? gN[1][1] : gC[1][1];
            const char* a3 = a2 + kstep; const char* b3 = b2 + kstep;
            if (last && has_next) S.a_ready(nxt);
            PG8_LDB(B0, 0, 0); PG8_SCHED; PG8_LDA(At, 0, 0); PG8_STAGE(PG8_SA(1, 1), a1, gC[1]);
            PG8_WAIT_L(8); PG8_BAR; PG8_WAIT_L(0); PG8_MMA(0, 0, At, B0); PG8_BAR; PG8_SCHED;
            PG8_LDB(B1, 0, 1); PG8_STAGE(PG8_SB(0, 0), b2, voffB);
            PG8_BAR; PG8_WAIT_L(0); PG8_MMA(0, 1, At, B1); PG8_BAR;
            if (half1) PG8_LDA(At, 0, 1); PG8_STAGE(PG8_SA(0, 0), a2, g2[0]);
            PG8_BAR; PG8_WAIT_L(0); if (half1) PG8_MMA(1, 0, At, B0); PG8_BAR; PG8_SCHED;
            PG8_STAGE(PG8_SB(0, 1), b2 + hstep, voffB);
            PG8_WAIT_V(6); PG8_BAR; if (half1) PG8_MMA(1, 1, At, B1); PG8_BAR;
            PG8_LDB(B0, 1, 0); PG8_SCHED; PG8_LDA(At, 1, 0); PG8_STAGE(PG8_SA(0, 1), a2, g2[1]);
            PG8_WAIT_L(8); PG8_BAR; PG8_WAIT_L(0); PG8_MMA(0, 0, At, B0); PG8_BAR; PG8_SCHED;
            PG8_LDB(B1, 1, 1); PG8_STAGE(PG8_SB(1, 0), b3, voffB);
            PG8_BAR; PG8_WAIT_L(0); PG8_MMA(0, 1, At, B1); PG8_BAR;
            if (half1) PG8_LDA(At, 1, 1); PG8_STAGE(PG8_SA(1, 0), a3, g2[0]);
            PG8_BAR; PG8_WAIT_L(0); if (half1) PG8_MMA(1, 0, At, B0); PG8_BAR; PG8_SCHED;
            PG8_STAGE(PG8_SB(1, 1), b3 + hstep, voffB);
            PG8_WAIT_V(6); PG8_BAR; if (half1) PG8_MMA(1, 1, At, B1); PG8_BAR;
        }
        E(acc, cur, wr, wc, fr, fq); S.done(cur);
        if (!has_next) break;
#pragma unroll
        for (int a = 0; a < 2; ++a)
#pragma unroll
            for (int b = 0; b < 2; ++b)
#pragma unroll
                for (int m = 0; m < 4; ++m)
#pragma unroll
                    for (int n = 0; n < 2; ++n) acc[a][b][m][n] = (f32x4){0.f, 0.f, 0.f, 0.f};
        cur = nxt; cB = nB; ++ui;
        gC[0][0] = gN[0][0]; gC[0][1] = gN[0][1]; gC[1][0] = gN[1][0]; gC[1][1] = gN[1][1];
    }
    PG8_WAIT_V(0);
    if (wr == 0) PG8_BAR;
    PG8_BAR;
#undef PG8_GOFS
#undef PG8_SA
#undef PG8_SB
#undef PG8_STAGE
#undef PG8_LDA
#undef PG8_LDB
#undef PG8_MMA
#undef PG8_WAIT_V
#undef PG8_WAIT_L
#undef PG8_BAR
#undef PG8_SCHED
}
}

struct Params {
    const float* x; const float* c; const float* ada_w; const float* ada_b; const float* norm_mix_w; const float* w_in; const float* conv_w; const float* conv_b;
    const float* lru_wa; const float* lru_ba; const float* lru_wx; const float* lru_bx; const float* lru_lambda; const float* norm_lru_w; const float* hgrn_lb;
    const float* norm_hgrn_w; const float* w_out; const float* norm_ffn_w; const float* rg_w; const float* rg_b; const float* re_w; const float* re_b;
    const float* e_gate; const float* e_up; const float* e_down; const float* final_w;
    float* out; unsigned char* ws;
    long long ph_lo, ph_hi;
};

typedef const __attribute__((address_space(4))) Params* KParams;
__device__ __forceinline__ KParams get_params() { KParams q = (KParams)__builtin_amdgcn_kernarg_segment_ptr(); asm volatile("" : "+s"(q)); return q; }

struct Ctx {
    LAS unsigned char* lds; int tid, lane, wave, G, gwave, nwaves;
};

struct CvtDesc { const float* src; bf16_t* dst; int ldn, ldd; };
__device__ __forceinline__ void cvt_load(const Ctx& F, const CvtDesc& d, f32x4 (&v)[16]) {
    const int q = F.lane >> 4, n4 = (F.lane & 15) * 4;
#pragma unroll
    for (int i = 0; i < 16; ++i) { const int k = 8 * (i >> 1) + 2 * q + (i & 1); v[i] = __builtin_nontemporal_load((const f32x4*)(d.src + (size_t)k * d.ldn + n4)); }
}
__device__ __forceinline__ void cvt_store(const Ctx& F, const CvtDesc& d, const f32x4 (&v)[16]) {
    LAS unsigned char* slab = F.lds + F.wave * 8704;
    const int q = F.lane >> 4, n4 = (F.lane & 15) * 4;
#pragma unroll
    for (int p = 0; p < 8; ++p) { const int k0 = 8 * p + 2 * q;
#pragma unroll
        for (int j = 0; j < 4; ++j) *(LAS unsigned*)(slab + (n4 + j) * 136 + k0 * 2) = cvt_pk_bf16(v[2 * p][j], v[2 * p + 1][j]); }
#pragma unroll
    for (int i = 0; i < 16; ++i) { const int n = 4 * i + q, ch = F.lane & 15;
        const u32x2 w = *(const LAS u32x2*)(slab + n * 136 + ch * 8);
        __builtin_nontemporal_store(w, (u32x2*)(d.dst + (size_t)n * d.ldd + ch * 4)); }
}
__device__ __forceinline__ CvtDesc cvt_desc(KParams p, int task) {
    bf16_t* WinT = (bf16_t*)(p->ws + WS_WIN); bf16_t* WoutT = (bf16_t*)(p->ws + WS_WOUT); bf16_t* WguT = (bf16_t*)(p->ws + WS_WGU); bf16_t* WdT = (bf16_t*)(p->ws + WS_WD);
    constexpr int T_IN = 16 * 56, T_OUT = 16 * 16, T_E = NEXP * 128, T_L = T_IN + T_OUT + 3 * T_E;
    const int l = task / T_L; int r = task % T_L; CvtDesc d;
    if (r < T_IN) { const int blk = r >> 3, w = r & 7, kt = (blk / 28) * 4 + (w >> 1), nt = (blk % 28) * 2 + (w & 1);
        d.src = p->w_in + (size_t)l * DM * PROJ + (size_t)kt * 64 * PROJ + nt * 64; d.ldn = PROJ; d.dst = WinT + ((size_t)l * PROJ + nt * 64) * DM + kt * 64; d.ldd = DM;
    } else if (r < T_IN + T_OUT) { r -= T_IN; const int blk = r >> 3, w = r & 7, kt = (blk / 8) * 4 + (w >> 1), nt = (blk % 8) * 2 + (w & 1);
        d.src = p->w_out + (size_t)l * DM * DM + (size_t)kt * 64 * DM + nt * 64; d.ldn = DM; d.dst = WoutT + ((size_t)l * DM + nt * 64) * DM + kt * 64; d.ldd = DM;
    } else if (r < T_IN + T_OUT + 2 * T_E) { r -= T_IN + T_OUT; const int up = r / T_E; r %= T_E; const int e = r / 128, rr = r % 128, blk = rr >> 3, w = rr & 7, kt = (blk / 4) * 4 + (w >> 1), nt = (blk % 4) * 2 + (w & 1), n0 = nt * 64;
        d.src = (up ? p->e_up : p->e_gate) + ((size_t)(l * NEXP + e) * DM + kt * 64) * DEXP + n0; d.ldn = DEXP;
        const size_t drow = (size_t)(l * NEXP + e) * 1024 + 256 * (n0 >> 7) + 128 * up + (n0 & 127);
        d.dst = WguT + drow * DM + kt * 64; d.ldd = DM;
    } else { r -= T_IN + T_OUT + 2 * T_E; const int e = r / 128, rr = r % 128, blk = rr >> 3, w = rr & 7, kt = (blk / 8) * 4 + (w >> 1), nt = (blk % 8) * 2 + (w & 1);
        d.src = p->e_down + ((size_t)(l * NEXP + e) * DEXP + kt * 64) * DM + nt * 64; d.ldn = DM;
        d.dst = WdT + ((size_t)(l * NEXP + e) * 1024 + nt * 64) * DEXP + kt * 64; d.ldd = DEXP;
    }
    return d;
}

__device__ __forceinline__ void phase_convert(KParams p, const Ctx& F) {
    constexpr int NT = DEPTH * (16 * 56 + 16 * 16 + 3 * NEXP * 128);
    int task = F.gwave;
    if (task >= NT) return;
    f32x4 va[16], vb[16];
    CvtDesc da = cvt_desc(p, task), db = da;
    cvt_load(F, da, va);
    for (;;) {
        const int t1 = task + F.nwaves; const bool h1 = t1 < NT;
        if (h1) { db = cvt_desc(p, t1); cvt_load(F, db, vb); }
        cvt_store(F, da, va);
        if (!h1) break;
        const int t2 = t1 + F.nwaves; const bool h2 = t2 < NT;
        if (h2) { da = cvt_desc(p, t2); cvt_load(F, da, va); }
        cvt_store(F, db, vb);
        if (!h2) break;
        task = t2;
    }
}

__device__ __forceinline__ void phase_prologue(KParams p, const Ctx& F) {
    {
        bf16_t* wf = (bf16_t*)(p->ws + WS_LRUW);
        for (int it = blockIdx.x * NTHREADS + F.tid; it < 32768; it += F.G * NTHREADS) {
            const int ln = it & 63, ks = (it >> 6) & 3, ct = (it >> 8) & 1, h = (it >> 9) & 7, m = (it >> 12) & 1, ld = it >> 13;
            const float* src = (m ? p->lru_wx : p->lru_wa) + ((size_t)ld * 8 + h) * 4096 + (size_t)(ks * 16 + 8 * (ln >> 5)) * 64 + ct * 32 + (ln & 31);
            u32x4 o; o[0] = cvt_pk_bf16(src[0], src[64]); o[1] = cvt_pk_bf16(src[128], src[192]); o[2] = cvt_pk_bf16(src[256], src[320]); o[3] = cvt_pk_bf16(src[384], src[448]);
            *(u32x4*)(wf + (size_t)it * 8) = o; }
    }
    {
        bf16_t* rwh = (bf16_t*)(p->ws + WS_RWHI); bf16_t* rwl = (bf16_t*)(p->ws + WS_RWLO);
        for (int it = blockIdx.x * NTHREADS + F.tid; it < DEPTH * 64 * DM; it += F.G * NTHREADS) {
            const int k = it & (DM - 1), n = (it >> 10) & 63, l = it >> 16;
            const float w = n < NEXP ? p->re_w[((size_t)l * DM + k) * NEXP + n] : (n < NEXP + NGRP ? p->rg_w[((size_t)l * DM + k) * NGRP + (n - NEXP)] : 0.f);
            const bf16_t hi = f2bf(w); rwh[it] = hi; rwl[it] = f2bf(w - bf2f(hi)); }
    }
    __syncthreads();
    LAS float* sc = (LAS float*)F.lds;
    LAS float* red = (LAS float*)(F.lds + 16384);
    for (int i = F.tid; i < NB * DM; i += NTHREADS) sc[i] = siluf_(p->c[i]);
    __syncthreads();
    float* mod = (float*)(p->ws + WS_MOD);
    for (int t = blockIdx.x; t < DEPTH * 96; t += F.G) {
        const int l = t / 96, n0 = (t % 96) * 64;
        const float* w = p->ada_w + (size_t)l * DM * 6 * DM + n0 + F.lane;
        float a0 = 0.f, a1 = 0.f, a2 = 0.f, a3 = 0.f;
        const int k0 = F.wave * 128;
#pragma unroll 32
        for (int k = k0; k < k0 + 128; ++k) { const float wv = __builtin_nontemporal_load(w + (size_t)k * 6 * DM); a0 += sc[k] * wv; a1 += sc[DM + k] * wv; a2 += sc[2 * DM + k] * wv; a3 += sc[3 * DM + k] * wv; }
        red[(F.wave * 4 + 0) * 64 + F.lane] = a0; red[(F.wave * 4 + 1) * 64 + F.lane] = a1; red[(F.wave * 4 + 2) * 64 + F.lane] = a2; red[(F.wave * 4 + 3) * 64 + F.lane] = a3;
        __syncthreads();
        if (F.tid < 256) { const int b = F.tid >> 6, ln = F.tid & 63; float s = p->ada_b[l * 6 * DM + n0 + ln];
#pragma unroll
            for (int w8 = 0; w8 < 8; ++w8) s += red[(w8 * 4 + b) * 64 + ln];
            mod[((size_t)l * NB + b) * 6 * DM + n0 + ln] = s; }
        __syncthreads();
    }
}

__device__ __forceinline__ void phase_norm1(KParams p, const Ctx& F, int l, const float* xin) {
    const float* mod = (const float*)(p->ws + WS_MOD) + (size_t)l * NB * 6 * DM;
    bf16_t* h = (bf16_t*)(p->ws + WS_R2);
    const float* nw = p->norm_mix_w + l * DM;
    for (int row0 = F.gwave; row0 < MTOK; row0 += 2 * F.nwaves) {
        f32x4 v[2][4]; float rs[2];
#pragma unroll
        for (int u = 0; u < 2; ++u) { const float* xr = xin + (size_t)(row0 + u * F.nwaves) * DM;
#pragma unroll
            for (int i = 0; i < 4; ++i) v[u][i] = __builtin_nontemporal_load((const f32x4*)(xr + F.lane * 4 + 256 * i)); }
#pragma unroll
        for (int u = 0; u < 2; ++u) { float ss = 0.f;
#pragma unroll
            for (int i = 0; i < 4; ++i) ss += v[u][i][0] * v[u][i][0] + v[u][i][1] * v[u][i][1] + v[u][i][2] * v[u][i][2] + v[u][i][3] * v[u][i][3];
            rs[u] = rsqrtf(wave_sum(ss) * (1.0f / DM) + NORM_EPS); }
#pragma unroll
        for (int u = 0; u < 2; ++u) { const int row = row0 + u * F.nwaves, b = row >> 12;
#pragma unroll
            for (int i = 0; i < 4; ++i) { const int col = F.lane * 4 + 256 * i;
                const f32x4 w4 = *(const f32x4*)(nw + col), sh = *(const f32x4*)(mod + (size_t)b * 6 * DM + col), s1 = *(const f32x4*)(mod + (size_t)b * 6 * DM + DM + col);
                const f32x4 o = v[u][i] * rs[u] * w4 * (s1 + 1.0f) + sh;
                u32x2 pk; pk[0] = cvt_pk_bf16(o[0], o[1]); pk[1] = cvt_pk_bf16(o[2], o[3]);
                *(u32x2*)(h + (size_t)row * DM + col) = pk; } }
    }
}

__device__ __forceinline__ void phase_conv(KParams p, const Ctx& F, int l) {
    const bf16_t* proj = (const bf16_t*)(p->ws + WS_R1); float* xc = (float*)(p->ws + WS_XA);
    const float* cw = p->conv_w + l * 4 * DLRU; const float* cb = p->conv_b + l * DLRU;
    for (int it = blockIdx.x * NTHREADS + F.tid; it < MTOK * (DLRU / 4); it += F.G * NTHREADS) {
        const int row = it >> 7, c4 = (it & 127) * 4, t = row & (SEQ - 1);
        f32x4 acc = *(const f32x4*)(cb + c4);
#pragma unroll
        for (int k = 0; k < 4; ++k) { const int tt = t + k - 2;
            if (tt >= 0 && tt < SEQ) { const u32x2 pv = *(const u32x2*)(proj + (size_t)(row + k - 2) * PROJ + c4); const f32x4 w4 = *(const f32x4*)(cw + k * DLRU + c4);
                acc[0] += w4[0] * __uint_as_float(pv[0] << 16); acc[1] += w4[1] * __uint_as_float(pv[0] & 0xFFFF0000u);
                acc[2] += w4[2] * __uint_as_float(pv[1] << 16); acc[3] += w4[3] * __uint_as_float(pv[1] & 0xFFFF0000u); } }
        *(f32x4*)(xc + (size_t)row * DLRU + c4) = acc;
    }
}

__device__ __forceinline__ void lru_seq(KParams p, const Ctx& F, int l, int b, int h) {
    const bf16_t* proj = (const bf16_t*)(p->ws + WS_R1); const float* xc = (const float*)(p->ws + WS_XA); float* tmpz = (float*)(p->ws + WS_XA) + (size_t)MTOK * DLRU;
    const int c = h * 64 + F.lane;
    for (int d = 0; d < 2; ++d) {
        float wa_r[64], wx_r[64];
        const float* wa = p->lru_wa + ((size_t)(l * 2 + d) * 8 + h) * 4096 + F.lane; const float* wx = p->lru_wx + ((size_t)(l * 2 + d) * 8 + h) * 4096 + F.lane;
#pragma unroll
        for (int i = 0; i < 64; ++i) { wa_r[i] = wa[i * 64]; wx_r[i] = wx[i * 64]; }
        const float ba = p->lru_ba[(l * 2 + d) * DLRU + c], bx = p->lru_bx[(l * 2 + d) * DLRU + c], lam = p->lru_lambda[(l * 2 + d) * DLRU + c];
        const float cc = -8.0f * log1pf(expf(-lam));
        float hst = 0.f;
        for (int step = 0; step < SEQ; ++step) {
            const int t = d == 0 ? step : SEQ - 1 - step; const size_t row = (size_t)b * SEQ + t;
            const float xv = xc[row * DLRU + c];
            float ra = ba, rx = bx;
#pragma unroll
            for (int i = 0; i < 64; ++i) { const float xi = rdlane(xv, i); ra += xi * wa_r[i]; rx += xi * wx_r[i]; }
            const float r = sigmoidf_(ra), ig = sigmoidf_(rx), la = cc * r, a = expf(la);
            const float u = sqrtf(fmaxf(-expm1f(2.0f * la), 0.f)) * (ig * xv);
            hst = a * hst + u;
            if (d == 0) tmpz[row * DLRU + c] = hst;
            else { const float yv = bf2f(proj[row * PROJ + DLRU + c]); tmpz[row * DLRU + c] = (tmpz[row * DLRU + c] + hst) * gelu_tanh(yv); }
        }
    }
}

__device__ __forceinline__ float hgrn_lb(KParams p, int l, int ch) {
    if (l == 0) return 0.f;
    const float a = p->hgrn_lb[ch], b = p->hgrn_lb[DHG + ch]; const float m = fmaxf(a, b); const float ea = expf(a - m), eb = expf(b - m);
    return eb / (ea + eb);
}

__device__ __forceinline__ void hgrn_seq(KParams p, const Ctx& F, int l, int b, int h) {
    const bf16_t* proj = (const bf16_t*)(p->ws + WS_R1); float* tmpo = (float*)(p->ws + WS_R2); bf16_t* merged = (bf16_t*)(p->ws + WS_R3);
    const int ch = h * 64 + F.lane;
    const float lbv = hgrn_lb(p, l, ch), nw = p->norm_hgrn_w[l * DHG + ch];
    for (int d = 0; d < 2; ++d) {
        float S[64];
#pragma unroll
        for (int i = 0; i < 64; ++i) S[i] = 0.f;
        const int fcol = (d == 0 ? 1536 : 2048) + ch;
        for (int step = 0; step < SEQ; ++step) {
            const int t = d == 0 ? step : SEQ - 1 - step; const size_t row = (size_t)b * SEQ + t; const bf16_t* pr = proj + row * PROJ;
            const float fl = bf2f(pr[fcol]), qv = bf2f(pr[1024 + ch]), vv = bf2f(pr[2560 + ch]);
            const float f = lbv + (1.0f - lbv) * sigmoidf_(fl), k = 1.0f - f;
            float o = 0.f;
#pragma unroll
            for (int i = 0; i < 64; ++i) { const float fd = rdlane(f, i), kd = rdlane(k, i), qd = rdlane(qv, i); S[i] = fd * S[i] + kd * vv; o += qd * S[i]; }
            if (d == 0) tmpo[row * DHG + ch] = o;
            else { const float ot = tmpo[row * DHG + ch] + o; const float ms = wave_sum(ot * ot) * (1.0f / 64.0f);
                const float gv = bf2f(pr[3072 + ch]); const float y = ot * rsqrtf(ms + NORM_EPS) * nw * siluf_(gv);
                merged[row * DM + DLRU + ch] = f2bf(y); }
        }
    }
}

__device__ __forceinline__ void phase_mixer_seq(KParams p, const Ctx& F, int l) {
#ifdef USE_LRU_SEQ
    if (F.wave == 0 && (int)blockIdx.x < 64) {
        const int id = blockIdx.x;
        if (id < 32) lru_seq(p, F, l, id >> 3, id & 7); else hgrn_seq(p, F, l, (id - 32) >> 3, (id - 32) & 7);
    }
#else
    if (F.wave == 0 && (int)blockIdx.x < 32) hgrn_seq(p, F, l, (int)blockIdx.x >> 3, (int)blockIdx.x & 7);
#endif
}

__device__ __forceinline__ void phase_lru_norm(KParams p, const Ctx& F, int l) {
    const float* tmpz = (const float*)(p->ws + WS_XA) + (size_t)MTOK * DLRU; bf16_t* merged = (bf16_t*)(p->ws + WS_R3); const float* nw = p->norm_lru_w + l * DLRU;
    for (int row = F.gwave; row < MTOK; row += F.nwaves) {
        f32x4 v[2]; float ss = 0.f;
#pragma unroll
        for (int i = 0; i < 2; ++i) { v[i] = *(const f32x4*)(tmpz + (size_t)row * DLRU + F.lane * 4 + 256 * i); ss += v[i][0] * v[i][0] + v[i][1] * v[i][1] + v[i][2] * v[i][2] + v[i][3] * v[i][3]; }
        ss = wave_sum(ss); const float rstd = rsqrtf(ss * (1.0f / DLRU) + NORM_EPS);
#pragma unroll
        for (int i = 0; i < 2; ++i) { const int col = F.lane * 4 + 256 * i; const f32x4 w4 = *(const f32x4*)(nw + col); const f32x4 o = v[i] * rstd * w4;
            u32x2 pk; pk[0] = cvt_pk_bf16(o[0], o[1]); pk[1] = cvt_pk_bf16(o[2], o[3]); *(u32x2*)(merged + (size_t)row * DM + col) = pk; }
    }
}

typedef float f32x16 __attribute__((ext_vector_type(16)));
#define MFMA32(a, b, c) __builtin_amdgcn_mfma_f32_32x32x16_bf16((a), (b), (c), 0, 0, 0)
constexpr int XCP = 1040;
template <bool PASS2>
__device__ __forceinline__ void phase_lru(KParams p, const Ctx& F, int l) {
    const bf16_t* proj = (const bf16_t*)(p->ws + WS_R1);
    float* sumA = (float*)(p->ws + WS_SUMA); float* sumH = (float*)(p->ws + WS_SUMH);
    const bf16x8* wf = (const bf16x8*)(p->ws + WS_LRUW);
    LAS unsigned char* xcb = F.lds; LAS unsigned char* zb = F.lds + 64 * XCP; LAS float* cin = (LAS float*)(F.lds + 128 * XCP);
    const float* cw = p->conv_w + l * 4 * DLRU; const float* cb = p->conv_b + l * DLRU;
    for (int task = blockIdx.x; task < NB * 64; task += F.G) {
        const int b = task >> 6, j = task & 63; const int row0 = b * SEQ + j * 64;
        if (l == 0) TP(PASS2 ? 20 : 10, F.lds);
#pragma unroll
        for (int itq = 0; itq < 8; ++itq) { const int it = F.tid + itq * NTHREADS;
            const int t = it >> 6, c8 = (it & 63) * 8, tg = j * 64 + t;
            f32x4 a0 = *(const f32x4*)(cb + c8), a1 = *(const f32x4*)(cb + c8 + 4);
#pragma unroll
            for (int k = 0; k < 4; ++k) { const int tt = tg + k - 2;
                if (tt >= 0 && tt < SEQ) { const u32x4 pv = *(const u32x4*)(proj + (size_t)(b * SEQ + tt) * PROJ + c8);
                    const f32x4 w0 = *(const f32x4*)(cw + k * DLRU + c8), w1 = *(const f32x4*)(cw + k * DLRU + c8 + 4);
                    a0[0] += w0[0] * __uint_as_float(pv[0] << 16); a0[1] += w0[1] * __uint_as_float(pv[0] & 0xFFFF0000u);
                    a0[2] += w0[2] * __uint_as_float(pv[1] << 16); a0[3] += w0[3] * __uint_as_float(pv[1] & 0xFFFF0000u);
                    a1[0] += w1[0] * __uint_as_float(pv[2] << 16); a1[1] += w1[1] * __uint_as_float(pv[2] & 0xFFFF0000u);
                    a1[2] += w1[2] * __uint_as_float(pv[3] << 16); a1[3] += w1[3] * __uint_as_float(pv[3] & 0xFFFF0000u); } }
            u32x4 o; o[0] = cvt_pk_bf16(a0[0], a0[1]); o[1] = cvt_pk_bf16(a0[2], a0[3]); o[2] = cvt_pk_bf16(a1[0], a1[1]); o[3] = cvt_pk_bf16(a1[2], a1[3]);
            *(LAS u32x4*)(xcb + t * XCP + c8 * 2) = o;
            if (PASS2) *(LAS u32x4*)(zb + t * XCP + c8 * 2) = *(const u32x4*)(proj + (size_t)(row0 + t) * PROJ + DLRU + c8);
        }
        if (l == 0) TP(PASS2 ? 21 : 11, F.lds);
        if (PASS2) {
            const int c = F.tid;
            const float* fa = sumA + (size_t)(0 * NB + b) * 64 * DLRU + c; const float* fh = sumH + (size_t)(0 * NB + b) * 64 * DLRU + c;
            const float* ra = sumA + (size_t)(1 * NB + b) * 64 * DLRU + c; const float* rh = sumH + (size_t)(1 * NB + b) * 64 * DLRU + c;
            float s = 0.f;
#pragma unroll 1
            for (int kb = 0; kb < 64; kb += 32) {
                float a16[32], h16[32];
#pragma unroll
                for (int q = 0; q < 32; ++q) { const int k = kb + q; const bool on = k < j; a16[q] = on ? fa[k * DLRU] : 1.f; h16[q] = on ? fh[k * DLRU] : 0.f; }
#pragma unroll
                for (int q = 0; q < 32; ++q) s = a16[q] * s + h16[q];
            }
            cin[c] = s; s = 0.f;
#pragma unroll 1
            for (int kb = 0; kb < 64; kb += 32) {
                float a16[32], h16[32];
#pragma unroll
                for (int q = 0; q < 32; ++q) { const int k = 63 - kb - q; const bool on = k > j; a16[q] = on ? ra[k * DLRU] : 1.f; h16[q] = on ? rh[k * DLRU] : 0.f; }
#pragma unroll
                for (int q = 0; q < 32; ++q) s = a16[q] * s + h16[q];
            }
            cin[DLRU + c] = s;
        }
        __syncthreads();
        if (l == 0) TP(PASS2 ? 22 : 12, F.lds);
        {
            const int h = F.wave, r = F.lane & 31, hh = F.lane >> 5;
            const LAS unsigned char* abase = xcb + (32 * ((r >> 2) & 1) + 4 * (r >> 3) + (r & 3)) * XCP + (h * 64 + 8 * hh) * 2;
#pragma unroll 1
            for (int ct = 0; ct < 2; ++ct) {
                const int c = h * 64 + ct * 32 + r;
                float hf[32];
#pragma unroll
                for (int d = 0; d < 2; ++d) {
                    const bf16x8* wba = wf + ((((size_t)(l * 2 + d) * 2 + 0) * 8 + h) * 2 + ct) * 4 * 64 + F.lane;
                    const bf16x8* wbx = wf + ((((size_t)(l * 2 + d) * 2 + 1) * 8 + h) * 2 + ct) * 4 * 64 + F.lane;
                    bf16x8 Ba[4], Bx[4];
#pragma unroll
                    for (int ks = 0; ks < 4; ++ks) { Ba[ks] = wba[ks * 64]; Bx[ks] = wbx[ks * 64]; }
                    const float ba = p->lru_ba[(l * 2 + d) * DLRU + c], bx = p->lru_bx[(l * 2 + d) * DLRU + c];
                    const float cc2 = -8.0f * LOG2E_F * log1pf(__expf(-p->lru_lambda[(l * 2 + d) * DLRU + c])), nba = -LOG2E_F * ba, nbx = -LOG2E_F * bx;
                    float av[32], uv[32];
#pragma unroll
                    for (int rt = 0; rt < 2; ++rt) {
                        f32x16 za, zx;
#pragma unroll
                        for (int e = 0; e < 16; ++e) { za[e] = 0.f; zx[e] = 0.f; }
#pragma unroll
                        for (int ks = 0; ks < 4; ++ks) { const bf16x8 Af = *(const LAS bf16x8*)(abase + 16 * rt * XCP + ks * 32);
                            za = MFMA32(Af, Ba[ks], za); zx = MFMA32(Af, Bx[ks], zx); }
#pragma unroll
                        for (int reg = 0; reg < 16; ++reg) { const int i = 16 * rt + reg;
                            const float xcv = bf2f(*(const LAS bf16_t*)(xcb + (32 * hh + i) * XCP + c * 2));
                            const float rg = frcp(1.0f + fexp2(fmaf(za[reg], -LOG2E_F, nba))), ig = frcp(1.0f + fexp2(fmaf(zx[reg], -LOG2E_F, nbx)));
                            const float a_ = fexp2(cc2 * rg);
                            av[i] = a_; uv[i] = __builtin_amdgcn_sqrtf(1.0f - a_ * a_) * (ig * xcv); }
                    }
                    if (d == 0) {
#pragma unroll
                        for (int i = 1; i < 32; ++i) { uv[i] = av[i] * uv[i - 1] + uv[i]; av[i] = av[i] * av[i - 1]; }
                    } else {
#pragma unroll
                        for (int i = 30; i >= 0; --i) { uv[i] = av[i] * uv[i + 1] + uv[i]; av[i] = av[i] * av[i + 1]; }
                    }
                    const float myP = (d == 0) ? av[31] : av[0], myH = (d == 0) ? uv[31] : uv[0];
                    const float oP = __shfl_xor(myP, 32, 64), oH = __shfl_xor(myH, 32, 64);
                    if (!PASS2) {
                        if (hh == 0) { const size_t idx = ((size_t)(d * NB + b) * 64 + j) * DLRU + c;
                            sumA[idx] = myP * oP;
                            sumH[idx] = (d == 0) ? (oH + oP * myH) : (myH + myP * oH); }
                    } else {
                        const float cinv = cin[d * DLRU + c];
                        const bool first = (d == 0) ? (hh == 0) : (hh == 1);
                        const float cy = first ? cinv : (oH + oP * cinv);
                        if (d == 0) {
#pragma unroll
                            for (int i = 0; i < 32; ++i) hf[i] = uv[i] + av[i] * cy;
                        } else {
#pragma unroll
                            for (int i = 0; i < 32; ++i) { const float hs = hf[i] + uv[i] + av[i] * cy;
                                LAS bf16_t* zp = (LAS bf16_t*)(zb + (32 * hh + i) * XCP + c * 2);
                                *zp = f2bf(hs * gelu_tanh(bf2f(*zp))); }
                        }
                    }
                }
            }
        }
        if (l == 0) TP(PASS2 ? 23 : 13, F.lds);
        if (PASS2) {
            __syncthreads();
            bf16_t* merged = (bf16_t*)(p->ws + WS_R3); const float* nw = p->norm_lru_w + l * DLRU;
            const f32x4 w0 = *(const f32x4*)(nw + F.lane * 8), w1 = *(const f32x4*)(nw + F.lane * 8 + 4);
#pragma unroll
            for (int q = 0; q < 8; ++q) { const int t = F.wave * 8 + q;
                const u32x4 zv = *(const LAS u32x4*)(zb + t * XCP + F.lane * 16);
                float z[8];
#pragma unroll
                for (int e = 0; e < 4; ++e) { z[2 * e] = __uint_as_float(zv[e] << 16); z[2 * e + 1] = __uint_as_float(zv[e] & 0xFFFF0000u); }
                float ss = 0.f;
#pragma unroll
                for (int e = 0; e < 8; ++e) ss += z[e] * z[e];
                ss = wave_sum(ss); const float rstd = rsqrtf(ss * (1.0f / DLRU) + NORM_EPS);
                u32x4 o; o[0] = cvt_pk_bf16(z[0] * rstd * w0[0], z[1] * rstd * w0[1]); o[1] = cvt_pk_bf16(z[2] * rstd * w0[2], z[3] * rstd * w0[3]);
                o[2] = cvt_pk_bf16(z[4] * rstd * w1[0], z[5] * rstd * w1[1]); o[3] = cvt_pk_bf16(z[6] * rstd * w1[2], z[7] * rstd * w1[3]);
                *(u32x4*)(merged + (size_t)(row0 + t) * DM + F.lane * 8) = o; }
        }
        __syncthreads();
        if (l == 0) TP(PASS2 ? 24 : 14, F.lds);
    }
}

typedef __bf16 bf16v8 __attribute__((ext_vector_type(8)));
typedef float f32x8 __attribute__((ext_vector_type(8)));
__device__ __forceinline__ bf16x8 pk8(float a0, float a1, float a2, float a3, float a4, float a5, float a6, float a7) {
    const f32x8 w = {a0, a1, a2, a3, a4, a5, a6, a7}; return __builtin_bit_cast(bf16x8, __builtin_convertvector(w, bf16v8)); }
#define PACK_STEP(x, s) pk8((x)[8 * (s)], (x)[8 * (s) + 1], (x)[8 * (s) + 2], (x)[8 * (s) + 3], (x)[8 * (s) + 4], (x)[8 * (s) + 5], (x)[8 * (s) + 6], (x)[8 * (s) + 7])
__device__ __forceinline__ int crow(int reg, int hh) { return (reg & 3) + 8 * (reg >> 2) + 4 * hh; }
template <int KIND> __device__ __forceinline__ bf16x8 mk_const(int ks, int hh, int r) {
    bf16x8 v;
#pragma unroll
    for (int j = 0; j < 8; ++j) { const int kn = 16 * ks + 8 * hh + j, kp = 16 * ks + 8 * (j >> 2) + 4 * hh + (j & 3);
        const bool on = KIND == 0 ? (kn <= r) : KIND == 1 ? (kn > r) : KIND == 2 ? (kn == r) : (kp == r);
        v[j] = on ? (short)0x3F80 : (short)0; }
    return v;
}
constexpr int HG_TASKS = NB * 8 * 2 * 32;
constexpr int HG_WLDS = 12288;
template <bool PASS2>
__device__ __forceinline__ void phase_hgrn(KParams p, const Ctx& F, int l) {
    const bf16_t* proj = (const bf16_t*)(p->ws + WS_R1);
    float* Usum = (float*)(p->ws + WS_R2); float* Dsum = Usum + (size_t)HG_TASKS * 4096;
    bf16_t* osc = (bf16_t*)(p->ws + WS_XA);
    int lz = F.lane; asm volatile("" : "+v"(lz));
    const int r = lz & 31, hh = lz >> 5;
    LAS unsigned char* wl = F.lds + F.wave * HG_WLDS;
    const LAS unsigned char* rdA = wl + (8 * hh) * 128 + r * 2;
    const LAS unsigned char* rdV = wl + 8192 + (4 * hh) * 128 + r * 2;
    for (int wg = blockIdx.x; wg < 256; wg += F.G) {
        const int b = wg >> 6, h = (wg >> 3) & 7, g = wg & 7;
        const int dir = F.wave & 1, tr = g * 4 + (F.wave >> 1);
        const int task = ((b * 8 + h) * 2 + dir) * 32 + tr;
        const int r0 = b * SEQ + tr * 128;
        const int fcol = (dir == 0 ? 1536 : 2048) + h * 64;
        if (l == 0) TP(PASS2 ? 30 : 40, F.lds);
        const float lb0 = hgrn_lb(p, l, h * 64 + r), lb1 = hgrn_lb(p, l, h * 64 + 32 + r);
        f32x16 S[2][2];
#pragma unroll
        for (int a = 0; a < 2; ++a) {
#pragma unroll
            for (int e = 0; e < 16; ++e) { S[a][0][e] = 0.f; S[a][1][e] = 0.f; } }
        if (PASS2) {
#pragma unroll
            for (int a = 0; a < 2; ++a)
#pragma unroll
                for (int c = 0; c < 2; ++c)
#pragma unroll
                    for (int e = 0; e < 16; ++e) S[a][c][e] = *(const float*)((const char*)Usum + ((unsigned)(task * 4096 + lz) * 4u + (unsigned)(((a * 2 + c) * 16 + e) * 256)));
        }
        if (l == 0) TP(PASS2 ? 31 : 41, F.lds);
#pragma unroll 1
        for (int ci = 0; ci < 4; ++ci) {
            const int rbase = dir == 0 ? r0 + 32 * ci : r0 + 127 - 32 * ci, sg = dir == 0 ? 1 : -1;
            {
                int lq = lz; asm volatile("" : "+v"(lq));
                const int lrow = lq >> 3, lcol = (lq & 7) * 8;
#pragma unroll
                for (int i = 0; i < 4; ++i) { const int tau = 8 * i + lrow; const char* pr = (const char*)proj + (unsigned)(((rbase + sg * tau) * PROJ + h * 64 + lcol) * 2);
                    const u32x4 vf = *(const u32x4*)(pr + (fcol - h * 64) * 2), vv = *(const u32x4*)(pr + 2560 * 2);
                    *(LAS u32x4*)(wl + tau * 128 + lcol * 2) = vf; *(LAS u32x4*)(wl + 8192 + tau * 128 + lcol * 2) = vv;
                    if (PASS2) { const u32x4 vq = *(const u32x4*)(pr + 1024 * 2); *(LAS u32x4*)(wl + 4096 + tau * 128 + lcol * 2) = vq; } }
            }
            __builtin_amdgcn_sched_barrier(0);
#define LOAD_VP(c, ks, dst) do { _Pragma("unroll") for (int j = 0; j < 8; ++j) (dst)[j] = (short)*(const LAS bf16_t*)(rdV + (16 * (ks) + 8 * (j >> 2) + (j & 3)) * 128 + 64 * (c)); } while (0)
            f32x16 O[2], sc;
            if (PASS2) {
#pragma unroll
                for (int e = 0; e < 16; ++e) { O[0][e] = 0.f; O[1][e] = 0.f; sc[e] = 0.f; } }
#pragma unroll
            for (int a = 0; a < 2; ++a) {
                const float lbv = a == 0 ? lb0 : lb1;
                bf16x8 Ahi[2], Alo[2];
                f32x16 kT, qT;
#pragma unroll
                for (int e = 0; e < 16; ++e) { kT[e] = 0.f; qT[e] = 0.f; }
#pragma unroll
                for (int ks = 0; ks < 2; ++ks) {
                    float lf[8], kk[8];
#pragma unroll
                    for (int j = 0; j < 8; ++j) { const float fl = bf2f(*(const LAS bf16_t*)(rdA + (16 * ks + j) * 128 + 64 * a));
                        const float f = lbv + (1.0f - lbv) * sigmoidf_(fl);
                        lf[j] = fmaxf(flog2(f), -115.0f); kk[j] = 1.0f - f; }
                    Ahi[ks] = pk8(lf[0], lf[1], lf[2], lf[3], lf[4], lf[5], lf[6], lf[7]);
                    float lo[8];
#pragma unroll
                    for (int j = 0; j < 8; ++j) lo[j] = lf[j] - bf2f((bf16_t)Ahi[ks][j]);
                    Alo[ks] = pk8(lo[0], lo[1], lo[2], lo[3], lo[4], lo[5], lo[6], lo[7]);
                    const bf16x8 Ak = pk8(kk[0], kk[1], kk[2], kk[3], kk[4], kk[5], kk[6], kk[7]);
                    const bf16x8 Id = mk_const<2>(ks, hh, r);
                    kT = MFMA32(Ak, Id, kT);
                    if (PASS2) { bf16x8 Aq;
#pragma unroll
                        for (int j = 0; j < 8; ++j) Aq[j] = (short)*(const LAS bf16_t*)(rdA + 4096 + (16 * ks + j) * 128 + 64 * a);
                        qT = MFMA32(Aq, Id, qT); }
                }
                __builtin_amdgcn_sched_barrier(0);
                if (PASS2) {
                    f32x16 bT;
#pragma unroll
                    for (int e = 0; e < 16; ++e) bT[e] = 0.f;
#pragma unroll
                    for (int ks = 0; ks < 2; ++ks) { const bf16x8 Mle = mk_const<0>(ks, hh, r); bT = MFMA32(Ahi[ks], Mle, bT); bT = MFMA32(Alo[ks], Mle, bT); }
#pragma unroll
                    for (int e = 0; e < 16; ++e) bT[e] = qT[e] * fexp2(bT[e]);
#pragma unroll
                    for (int s2 = 0; s2 < 2; ++s2) { const bf16x8 Qtp = PACK_STEP(bT, s2);
#pragma unroll
                        for (int c = 0; c < 2; ++c) O[c] = MFMA32(Qtp, PACK_STEP(S[a][c], s2), O[c]); }
                    __builtin_amdgcn_sched_barrier(0);
                }
                bf16x8 Kh0, Kh1;
                {
                    f32x16 RT;
#pragma unroll
                    for (int e = 0; e < 16; ++e) RT[e] = 0.f;
#pragma unroll
                    for (int ks = 0; ks < 2; ++ks) { const bf16x8 Mgt = mk_const<1>(ks, hh, r); RT = MFMA32(Ahi[ks], Mgt, RT); RT = MFMA32(Alo[ks], Mgt, RT); }
#pragma unroll
                    for (int e = 0; e < 16; ++e) { kT[e] *= fexp2(RT[e]); if (PASS2) qT[e] *= fexp2(fminf(-RT[e], 115.0f)); }
                    Kh0 = PACK_STEP(kT, 0); Kh1 = PACK_STEP(kT, 1);
                    if (PASS2) { sc = MFMA32(Kh0, PACK_STEP(qT, 0), sc); sc = MFMA32(Kh1, PACK_STEP(qT, 1), sc); }
                    __builtin_amdgcn_sched_barrier(0);
                }
                {
                    f32x16 CT;
#pragma unroll
                    for (int e = 0; e < 16; ++e) CT[e] = 0.f;
#pragma unroll
                    for (int ks = 0; ks < 2; ++ks) { bf16x8 One;
#pragma unroll
                        for (int j = 0; j < 8; ++j) One[j] = (short)0x3F80;
                        CT = MFMA32(Ahi[ks], One, CT); CT = MFMA32(Alo[ks], One, CT); }
#pragma unroll
                    for (int e = 0; e < 16; ++e) { const float dd = fexp2(CT[e]); S[a][0][e] *= dd; S[a][1][e] *= dd; if (!PASS2) CT[e] = dd; }
                    if (!PASS2 && r == 0) {
#pragma unroll
                        for (int e = 0; e < 16; ++e) Dsum[((size_t)task * 4 + ci) * 64 + 32 * a + crow(e, hh)] = CT[e]; }
                    __builtin_amdgcn_sched_barrier(0);
                }
                {
                    f32x16 Ks;
#pragma unroll
                    for (int e = 0; e < 16; ++e) Ks[e] = 0.f;
                    Ks = MFMA32(Kh0, mk_const<3>(0, hh, r), Ks); Ks = MFMA32(Kh1, mk_const<3>(1, hh, r), Ks);
#pragma unroll
                    for (int ks = 0; ks < 2; ++ks) { const bf16x8 Ksp = PACK_STEP(Ks, ks);
#pragma unroll
                        for (int c = 0; c < 2; ++c) { bf16x8 Vp; LOAD_VP(c, ks, Vp); S[a][c] = MFMA32(Ksp, Vp, S[a][c]); } }
                    __builtin_amdgcn_sched_barrier(0);
                }
            }
            if (PASS2) {
#pragma unroll
                for (int e = 0; e < 16; ++e) sc[e] = (crow(e, hh) <= r) ? sc[e] : 0.f;
#pragma unroll
                for (int ks = 0; ks < 2; ++ks) { const bf16x8 Pp = PACK_STEP(sc, ks);
#pragma unroll
                    for (int c = 0; c < 2; ++c) { bf16x8 Vp; LOAD_VP(c, ks, Vp); O[c] = MFMA32(Pp, Vp, O[c]); } }
                int lq2 = lz; asm volatile("" : "+v"(lq2));
                const int r2 = lq2 & 31, hh2 = lq2 >> 5;
#pragma unroll
                for (int c = 0; c < 2; ++c)
#pragma unroll
                    for (int e = 0; e < 16; ++e) *(bf16_t*)((char*)osc + (unsigned)((((dir * MTOK + rbase + sg * crow(e, hh2)) * DHG) + h * 64 + 32 * c + r2) * 2)) = f2bf(O[c][e]);
            }
#undef LOAD_VP
        }
        if (l == 0) TP(PASS2 ? 32 : 42, F.lds);
        if (!PASS2) {
#pragma unroll
            for (int a = 0; a < 2; ++a)
#pragma unroll
                for (int c = 0; c < 2; ++c)
#pragma unroll
                    for (int e = 0; e < 16; ++e) *(float*)((char*)Usum + ((unsigned)(task * 4096 + lz) * 4u + (unsigned)(((a * 2 + c) * 16 + e) * 256))) = S[a][c][e];
        } else {
            asm volatile("s_waitcnt vmcnt(0)" ::: "memory");
            __syncthreads();
            bf16_t* merged = (bf16_t*)(p->ws + WS_R3);
            const int ch4 = h * 64 + (F.lane & 15) * 4; const f32x4 nw4 = *(const f32x4*)(p->norm_hgrn_w + l * DHG + ch4);
#pragma unroll 1
            for (int ib = 0; ib < 16; ib += 8) {
            u32x2 qf[8], qb[8], gq[8];
#pragma unroll
            for (int i = 0; i < 8; ++i) { const int row = b * SEQ + g * 512 + F.wave * 64 + (ib + i) * 4 + (F.lane >> 4);
                qf[i] = *(const u32x2*)((const char*)osc + (unsigned)((row * DHG + ch4) * 2)); qb[i] = *(const u32x2*)((const char*)osc + (unsigned)(((MTOK + row) * DHG + ch4) * 2));
                gq[i] = *(const u32x2*)((const char*)proj + (unsigned)((row * PROJ + 3072 + ch4) * 2)); }
#pragma unroll
            for (int i = 0; i < 8; ++i) { const int row = b * SEQ + g * 512 + F.wave * 64 + (ib + i) * 4 + (F.lane >> 4);
                const f32x4 ot = (f32x4){__uint_as_float(qf[i][0] << 16) + __uint_as_float(qb[i][0] << 16), __uint_as_float(qf[i][0] & 0xFFFF0000u) + __uint_as_float(qb[i][0] & 0xFFFF0000u),
                                         __uint_as_float(qf[i][1] << 16) + __uint_as_float(qb[i][1] << 16), __uint_as_float(qf[i][1] & 0xFFFF0000u) + __uint_as_float(qb[i][1] & 0xFFFF0000u)};
                float ms = ot[0] * ot[0] + ot[1] * ot[1] + ot[2] * ot[2] + ot[3] * ot[3];
                ms += __int_as_float(__builtin_amdgcn_update_dpp(0, __float_as_int(ms), 0x128, 0xF, 0xF, false));
                ms += __int_as_float(__builtin_amdgcn_update_dpp(0, __float_as_int(ms), 0x124, 0xF, 0xF, false));
                ms += __int_as_float(__builtin_amdgcn_update_dpp(0, __float_as_int(ms), 0x122, 0xF, 0xF, false));
                ms += __int_as_float(__builtin_amdgcn_update_dpp(0, __float_as_int(ms), 0x121, 0xF, 0xF, false));
                const float rs = rsqrtf(ms * (1.0f / 64.0f) + NORM_EPS);
                const float g0 = __uint_as_float(gq[i][0] << 16), g1 = __uint_as_float(gq[i][0] & 0xFFFF0000u), g2 = __uint_as_float(gq[i][1] << 16), g3 = __uint_as_float(gq[i][1] & 0xFFFF0000u);
                u32x2 o; o[0] = cvt_pk_bf16(ot[0] * rs * nw4[0] * siluf_(g0), ot[1] * rs * nw4[1] * siluf_(g1)); o[1] = cvt_pk_bf16(ot[2] * rs * nw4[2] * siluf_(g2), ot[3] * rs * nw4[3] * siluf_(g3));
                *(u32x2*)((char*)merged + (unsigned)((row * DM + DLRU + ch4) * 2)) = o; }
            }
            __syncthreads();
        }
        if (l == 0) TP(PASS2 ? 33 : 43, F.lds);
    }
}

__device__ __forceinline__ void phase_hgrn_prefix(KParams p, const Ctx& F, int l) {
    float* Usum = (float*)(p->ws + WS_R2); const float* Dsum = Usum + (size_t)HG_TASKS * 4096;
    if (l == 0) TP(50, F.lds);
    for (int gt = blockIdx.x * NTHREADS + F.tid; gt < 64 * 4096; gt += F.G * NTHREADS) {
        const int seq = gt >> 12, e = gt & 4095, dir = seq & 1;
        const int tile = e >> 10, reg = (e >> 6) & 15, ln = e & 63; const int d = 32 * (tile >> 1) + crow(reg, ln >> 5);
        float s = 0.f;
#pragma unroll 1
        for (int kb = 0; kb < 32; kb += 16) {
            float u16[16], d16[16];
#pragma unroll
            for (int q = 0; q < 16; ++q) { const int k = kb + q, trp = dir == 0 ? k : 31 - k; const size_t tp = (size_t)seq * 32 + trp;
                u16[q] = Usum[tp * 4096 + e];
                d16[q] = Dsum[(tp * 4 + 0) * 64 + d] * Dsum[(tp * 4 + 1) * 64 + d] * Dsum[(tp * 4 + 2) * 64 + d] * Dsum[(tp * 4 + 3) * 64 + d]; }
#pragma unroll
            for (int q = 0; q < 16; ++q) { const float sin = s; s = d16[q] * s + u16[q]; u16[q] = sin; }
#pragma unroll
            for (int q = 0; q < 16; ++q) { const int k = kb + q, trp = dir == 0 ? k : 31 - k; const size_t tp = (size_t)seq * 32 + trp; Usum[tp * 4096 + e] = u16[q]; }
        }
    }
    if (l == 0) TP(51, F.lds);
}

constexpr int RT_PITCH = 2064;
__device__ __forceinline__ void phase_route(KParams p, const Ctx& F, int l) {
    const float* mod = (const float*)(p->ws + WS_MOD) + (size_t)l * NB * 6 * DM;
    const bf16_t* xa = (const bf16_t*)(p->ws + WS_XA); bf16_t* h2 = (bf16_t*)(p->ws + WS_R2);
    const float* nw = p->norm_ffn_w + l * DM;
    int* cnt = (int*)(p->ws + WS_CTL + CTL_CNT_OFF) + l * NEXP * CNT_STRIDE;
    int* rowcap = (int*)(p->ws + WS_ROWCAP); float* tokw = (float*)(p->ws + WS_TOKW);
    LAS int* hist = (LAS int*)(F.lds + LDS_MISC + 64);
    LAS int* tsel = (LAS int*)(F.lds + LDS_MISC + 1024);
    if (F.tid < 64) hist[F.tid] = 0;
    __syncthreads();
    int ntile = 0;
    const bf16_t* rwh = (const bf16_t*)(p->ws + WS_RWHI) + (size_t)l * 64 * DM; const bf16_t* rwl = (const bf16_t*)(p->ws + WS_RWLO) + (size_t)l * 64 * DM;
    LAS unsigned char* Ah = F.lds; LAS unsigned char* Al = F.lds + 32 * RT_PITCH;
    LAS float* part = (LAS float*)F.lds;
    LAS float* red = (LAS float*)(F.lds + 65536);
    const int r = F.lane & 31, hh = F.lane >> 5;
    for (int tile = blockIdx.x; tile < MTOK / 32; tile += F.G) {
        const int row0 = tile * 32, b = row0 >> 12;
        {
            f32x4 v[4][4]; float ss[4];
#pragma unroll
            for (int i = 0; i < 4; ++i) { const bf16_t* xr = xa + (size_t)(row0 + F.wave * 4 + i) * DM; ss[i] = 0.f;
#pragma unroll
                for (int q = 0; q < 4; ++q) { const u32x2 xv = *(const u32x2*)(xr + F.lane * 4 + 256 * q);
                    v[i][q] = (f32x4){__uint_as_float(xv[0] << 16), __uint_as_float(xv[0] & 0xFFFF0000u), __uint_as_float(xv[1] << 16), __uint_as_float(xv[1] & 0xFFFF0000u)}; } }
#pragma unroll
            for (int i = 0; i < 4; ++i) {
#pragma unroll
                for (int q = 0; q < 4; ++q) ss[i] += v[i][q][0] * v[i][q][0] + v[i][q][1] * v[i][q][1] + v[i][q][2] * v[i][q][2] + v[i][q][3] * v[i][q][3];
                ss[i] = rsqrtf(wave_sum(ss[i]) * (1.0f / DM) + NORM_EPS); }
#pragma unroll
            for (int q = 0; q < 4; ++q) { const int col = F.lane * 4 + 256 * q;
                const f32x4 w4 = *(const f32x4*)(nw + col), sh = *(const f32x4*)(mod + (size_t)b * 6 * DM + 3 * DM + col), s1 = *(const f32x4*)(mod + (size_t)b * 6 * DM + 4 * DM + col);
                const f32x4 g4 = w4 * (s1 + 1.0f);
#pragma unroll
                for (int i = 0; i < 4; ++i) { const int rl = F.wave * 4 + i;
                    const f32x4 o = v[i][q] * ss[i] * g4 + sh;
                    u32x2 pk; pk[0] = cvt_pk_bf16(o[0], o[1]); pk[1] = cvt_pk_bf16(o[2], o[3]);
                    *(u32x2*)(h2 + (size_t)(row0 + rl) * DM + col) = pk;
                    *(LAS u32x2*)(Ah + rl * RT_PITCH + col * 2) = pk;
                    u32x2 lo; lo[0] = cvt_pk_bf16(o[0] - __uint_as_float(pk[0] << 16), o[1] - __uint_as_float(pk[0] & 0xFFFF0000u));
                    lo[1] = cvt_pk_bf16(o[2] - __uint_as_float(pk[1] << 16), o[3] - __uint_as_float(pk[1] & 0xFFFF0000u));
                    *(LAS u32x2*)(Al + rl * RT_PITCH + col * 2) = lo; } }
        }
        __builtin_amdgcn_sched_barrier(0);
        f32x16 acc[2];
#pragma unroll
        for (int e = 0; e < 16; ++e) { acc[0][e] = 0.f; acc[1][e] = 0.f; }
        {
            bf16x8 bh[8][2];
#pragma unroll
            for (int ks = 0; ks < 8; ++ks)
#pragma unroll
                for (int nt = 0; nt < 2; ++nt) bh[ks][nt] = *(const bf16x8*)(rwh + (size_t)(nt * 32 + r) * DM + F.wave * 128 + ks * 16 + 8 * hh);
            __syncthreads();
#pragma unroll
            for (int ks = 0; ks < 8; ++ks) { const int k0 = F.wave * 128 + ks * 16 + 8 * hh;
                const bf16x8 ah = *(const LAS bf16x8*)(Ah + r * RT_PITCH + k0 * 2), al = *(const LAS bf16x8*)(Al + r * RT_PITCH + k0 * 2);
#pragma unroll
                for (int nt = 0; nt < 2; ++nt) { acc[nt] = MFMA32(ah, bh[ks][nt], acc[nt]); acc[nt] = MFMA32(al, bh[ks][nt], acc[nt]); } }
        }
        __builtin_amdgcn_sched_barrier(0);
        {
            bf16x8 bl[8][2];
#pragma unroll
            for (int ks = 0; ks < 8; ++ks)
#pragma unroll
                for (int nt = 0; nt < 2; ++nt) bl[ks][nt] = *(const bf16x8*)(rwl + (size_t)(nt * 32 + r) * DM + F.wave * 128 + ks * 16 + 8 * hh);
#pragma unroll
            for (int ks = 0; ks < 8; ++ks) { const int k0 = F.wave * 128 + ks * 16 + 8 * hh;
                const bf16x8 ah = *(const LAS bf16x8*)(Ah + r * RT_PITCH + k0 * 2);
#pragma unroll
                for (int nt = 0; nt < 2; ++nt) acc[nt] = MFMA32(ah, bl[ks][nt], acc[nt]); }
        }
        __syncthreads();
#pragma unroll
        for (int nt = 0; nt < 2; ++nt)
#pragma unroll
            for (int e = 0; e < 16; ++e) part[(F.wave * 32 + crow(e, hh)) * 64 + nt * 32 + r] = acc[nt][e];
        __syncthreads();
        {
            const int tk = F.tid >> 4, c4 = (F.tid & 15) * 4; f32x4 sum = (f32x4){0.f, 0.f, 0.f, 0.f};
#pragma unroll
            for (int w = 0; w < 8; ++w) sum += *(const LAS f32x4*)(part + (w * 32 + tk) * 64 + c4);
            *(LAS f32x4*)(red + tk * 64 + c4) = sum;
        }
        __syncthreads();
        if (F.tid < 32) {
            const int row = row0 + F.tid;
            const LAS float* lg = red + F.tid * 64;
            float gl[4];
#pragma unroll
            for (int j = 0; j < 4; ++j) gl[j] = lg[32 + j] + p->rg_b[l * NGRP + j];
            int gi = 0; float gm = gl[0];
#pragma unroll
            for (int j = 1; j < 4; ++j) if (gl[j] > gm) { gm = gl[j]; gi = j; }
            float gs = 0.f;
#pragma unroll
            for (int j = 0; j < 4; ++j) gs += __expf(gl[j] - gm);
            const float pg = 1.0f / gs;
            float el[8];
#pragma unroll
            for (int j = 0; j < 8; ++j) el[j] = lg[gi * 8 + j] + p->re_b[l * NEXP + gi * 8 + j];
            int i0 = 0; float v0 = el[0];
#pragma unroll
            for (int j = 1; j < 8; ++j) if (el[j] > v0) { v0 = el[j]; i0 = j; }
            int i1 = (i0 == 0) ? 1 : 0; float v1 = (i0 == 0) ? el[1] : el[0];
#pragma unroll
            for (int j = 0; j < 8; ++j) if (j != i0 && el[j] > v1) { v1 = el[j]; i1 = j; }
            const float ex = __expf(v1 - v0); const float w0 = pg / (1.0f + ex), w1 = pg * ex / (1.0f + ex);
            const int e0 = gi * 8 + i0, e1 = gi * 8 + i1;
            const int p0 = __hip_atomic_fetch_add(&hist[e0], 1, __ATOMIC_RELAXED, __HIP_MEMORY_SCOPE_WORKGROUP), p1 = __hip_atomic_fetch_add(&hist[e1], 1, __ATOMIC_RELAXED, __HIP_MEMORY_SCOPE_WORKGROUP);
            *(LAS i32x4*)(tsel + (ntile * 32 + F.tid) * 4) = (i32x4){e0, p0, e1, p1};
            *(float2*)(tokw + (size_t)row * 2) = make_float2(w0, w1);
        }
        ++ntile;
        __syncthreads();
    }
    if (F.tid < NEXP) { const int c = hist[F.tid]; hist[32 + F.tid] = c > 0 ? atomicAdd(&cnt[F.tid * CNT_STRIDE], c) : 0; }
    __syncthreads();
    for (int q = F.tid; q < ntile * 32; q += NTHREADS) { const int tile = (int)blockIdx.x + (q >> 5) * F.G, row = tile * 32 + (q & 31);
        const i32x4 t = *(const LAS i32x4*)(tsel + q * 4);
        rowcap[(size_t)t[0] * MTOK + hist[32 + t[0]] + t[1]] = row * 2; rowcap[(size_t)t[2] * MTOK + hist[32 + t[2]] + t[3]] = row * 2 + 1; }
    __syncthreads();
}

constexpr int MOE_MAX_UNITS = 4, HALF_ROWS = 128;
__device__ __forceinline__ void build_tile_table(KParams p, const Ctx& F, int l) {
    LAS int* tst = (LAS int*)(F.lds + LDS_MISC + 64);
    LAS int* ulist = (LAS int*)(F.lds + LDS_MISC + 256);
    LAS int* utok = (LAS int*)(F.lds + LDS_MISC + 1024);
    LAS float* utw = (LAS float*)(F.lds + LDS_MISC + 5120);
    const int* cnt = (const int*)(p->ws + WS_CTL + CTL_CNT_OFF) + l * NEXP * CNT_STRIDE;
    const int* rowcap = (const int*)(p->ws + WS_ROWCAP); const float* tokw = (const float*)(p->ws + WS_TOKW);
    LAS int* tord = (LAS int*)(F.lds + LDS_MISC + 9216);
    LAS int* cl = (LAS int*)(F.lds + LDS_MISC + 9984);
    if (F.tid < NEXP) cl[F.tid] = __hip_atomic_load(cnt + F.tid * CNT_STRIDE, __ATOMIC_RELAXED, __HIP_MEMORY_SCOPE_AGENT);
    __syncthreads();
    if (F.tid == 0) { int acc = 0, nbig = 0;
        for (int e = 0; e < NEXP; ++e) { const int c = cl[e]; tst[e] = acc; acc += (c + 255) >> 8; nbig += (c >> 8) + (((c & 255) > HALF_ROWS) ? 1 : 0); }
        tst[NEXP] = acc;
        int ib = 0, it2 = nbig;
        for (int e = 0; e < NEXP; ++e) { const int c = cl[e], nt = (c + 255) >> 8;
            for (int it = 0; it < nt; ++it) { const int valid = c - it * 256; if (valid > HALF_ROWS) tord[ib++] = (e << 8) | it; else tord[it2++] = (e << 8) | it; } } }
    __syncthreads();
    if (F.tid <= MOE_MAX_UNITS) { const int L = F.tid * F.G + (int)blockIdx.x, tm = tst[NEXP]; int pm = -1, pn = 0, a0 = 0, a1 = 0;
        if (F.tid < MOE_MAX_UNITS && L < tm * 4) { const int ei = tord[L >> 2], e = ei >> 8, it = ei & 255, c = cl[e];
            pm = tst[e] + it; pn = e * 4 + (L & 3); a0 = e * MTOK + it * 256; a1 = c - it * 256 < 256 ? c - it * 256 : 256; }
        ulist[4 * F.tid] = pm; ulist[4 * F.tid + 1] = pn; ulist[4 * F.tid + 2] = a0; ulist[4 * F.tid + 3] = a1; }
    __syncthreads();
    for (int q = F.tid; q < MOE_MAX_UNITS * 256; q += NTHREADS) { const int i = q >> 8, rl = q & 255;
        int v = -1; float w = 0.f;
        if (ulist[4 * i] >= 0 && rl < ulist[4 * i + 3]) { v = rowcap[ulist[4 * i + 2] + rl]; w = tokw[v]; }
        utok[q] = v; utw[q] = w; }
    __syncthreads();
    if (F.tid < MOE_MAX_UNITS) ulist[4 * F.tid + 2] = 256 * F.tid;
    __syncthreads();
}

template <bool FINAL>
__device__ __forceinline__ void phase_combine(KParams p, const Ctx& F, int l, bf16_t* xo) {
    const float* mod = (const float*)(p->ws + WS_MOD) + (size_t)l * NB * 6 * DM;
    const bf16_t* xa = (const bf16_t*)(p->ws + WS_XA); const bf16_t* y = (const bf16_t*)(p->ws + WS_R1 + WS_R1_Y);
    for (int row0 = F.gwave; row0 < MTOK; row0 += 2 * F.nwaves) {
        u32x2 xq[2][4], y0[2][4], y1[2][4];
#pragma unroll
        for (int u = 0; u < 2; ++u) { const size_t row = row0 + u * F.nwaves;
#pragma unroll
            for (int i = 0; i < 4; ++i) { const int col = F.lane * 4 + 256 * i;
                xq[u][i] = __builtin_nontemporal_load((const u32x2*)(xa + row * DM + col)); y0[u][i] = __builtin_nontemporal_load((const u32x2*)(y + (row * 2) * DM + col)); y1[u][i] = __builtin_nontemporal_load((const u32x2*)(y + (row * 2 + 1) * DM + col)); } }
#pragma unroll
        for (int u = 0; u < 2; ++u) { const int row = row0 + u * F.nwaves, b = row >> 12; f32x4 v[4]; float ss = 0.f;
#pragma unroll
            for (int i = 0; i < 4; ++i) { const int col = F.lane * 4 + 256 * i; const f32x4 g = *(const f32x4*)(mod + (size_t)b * 6 * DM + 5 * DM + col);
                const f32x4 xv = (f32x4){__uint_as_float(xq[u][i][0] << 16), __uint_as_float(xq[u][i][0] & 0xFFFF0000u), __uint_as_float(xq[u][i][1] << 16), __uint_as_float(xq[u][i][1] & 0xFFFF0000u)};
                f32x4 ys; ys[0] = __uint_as_float(y0[u][i][0] << 16) + __uint_as_float(y1[u][i][0] << 16); ys[1] = __uint_as_float(y0[u][i][0] & 0xFFFF0000u) + __uint_as_float(y1[u][i][0] & 0xFFFF0000u);
                ys[2] = __uint_as_float(y0[u][i][1] << 16) + __uint_as_float(y1[u][i][1] << 16); ys[3] = __uint_as_float(y0[u][i][1] & 0xFFFF0000u) + __uint_as_float(y1[u][i][1] & 0xFFFF0000u);
                v[i] = xv + g * ys; ss += v[i][0] * v[i][0] + v[i][1] * v[i][1] + v[i][2] * v[i][2] + v[i][3] * v[i][3]; }
            ss = wave_sum(ss); const float rstd = rsqrtf(ss * (1.0f / DM) + NORM_EPS);
            if (FINAL) {
#pragma unroll
                for (int i = 0; i < 4; ++i) { const int col = F.lane * 4 + 256 * i; const f32x4 w4 = *(const f32x4*)(p->final_w + col); __builtin_nontemporal_store(v[i] * rstd * w4, (f32x4*)(p->out + (size_t)row * DM + col)); }
            } else {
                const float* modn = mod + (size_t)NB * 6 * DM; const float* nwn = p->norm_mix_w + (l + 1) * DM; bf16_t* h = (bf16_t*)(p->ws + WS_R2);
#pragma unroll
                for (int i = 0; i < 4; ++i) { const int col = F.lane * 4 + 256 * i;
                    u32x2 pk; pk[0] = cvt_pk_bf16(v[i][0], v[i][1]); pk[1] = cvt_pk_bf16(v[i][2], v[i][3]);
                    *(u32x2*)(xo + (size_t)row * DM + col) = pk;
                    const f32x4 w4 = *(const f32x4*)(nwn + col), sh = *(const f32x4*)(modn + (size_t)b * 6 * DM + col), s1 = *(const f32x4*)(modn + (size_t)b * 6 * DM + DM + col);
                    const f32x4 o = v[i] * rstd * w4 * (s1 + 1.0f) + sh;
                    u32x2 pk2; pk2[0] = cvt_pk_bf16(o[0], o[1]); pk2[1] = cvt_pk_bf16(o[2], o[3]);
                    *(u32x2*)(h + (size_t)row * DM + col) = pk2; }
            }
        }
    }
}


__device__ __forceinline__ Ctx make_ctx(LAS unsigned char* lds) {
    int tz = threadIdx.x; asm volatile("" : "+v"(tz));
    Ctx F; F.lds = lds; F.tid = tz; F.lane = tz & 63; F.wave = __builtin_amdgcn_readfirstlane(tz >> 6);
    F.G = gridDim.x; F.gwave = blockIdx.x * NWAVES + F.wave; F.nwaves = F.G * NWAVES; return F;
}

constexpr int PH_PER_LAYER = 10, N_PHASES = 1 + DEPTH * PH_PER_LAYER;
#ifndef DBG_MASK
#define DBG_MASK 0xFFFFFFFFu
#endif
#define IN(k) ((((DBG_MASK) >> ((k) == 0 ? 0 : (((k) - 1) % PH_PER_LAYER) + 1)) & 1u) && lo <= (k) && (k) < hi)
#define SEAM(k) do { if (IN(k) && IN((k) + 1)) xcd_barrier(bar); if constexpr (DBG_TIMEPH == (k)) tstamp[1] = __builtin_amdgcn_s_memrealtime(); } while (0)
#define SITE KParams P = get_params(); const Ctx F = make_ctx(lds);
#ifndef DBG_REPEAT
#define DBG_REPEAT 0u
#endif
#define NREP(k) (1 + (int)(((DBG_REPEAT) >> ((k) == 0 ? 0 : (((k) - 1) % PH_PER_LAYER) + 1)) & 1u))
#ifndef DBG_TIMEPH
#define DBG_TIMEPH (-1)
#endif
#define PHASE(k, ...) { if constexpr (DBG_TIMEPH == (k)) { if (tstamp[0] == 0ull) tstamp[0] = __builtin_amdgcn_s_memrealtime(); } if (IN(k)) { __VA_ARGS__ } if constexpr (NREP(k) == 2) { if (IN(k)) { xcd_barrier(bar); __VA_ARGS__ } } }

template <int l>
__device__ __forceinline__ void run_layer(LAS unsigned char* const lds, const int lo, const int hi, const XcdBarrier& bar, unsigned long long (&tstamp)[2]) {
        const int base = 1 + l * PH_PER_LAYER;
        if constexpr (l == 0) {
            PHASE(base + 0, { SITE phase_convert(P, F); } { SITE phase_norm1(P, F, l, P->x); })
            SEAM(base + 0);
        }
        PHASE(base + 1, SITE
            pg8::Gemm g{(const bf16_t*)(P->ws + WS_R2), (const bf16_t*)(P->ws + WS_WIN) + (size_t)l * PROJ * DM, MTOK, PROJ, DM};
            pg8::StaticOrder S; S.init(MTOK, PROJ, F.G, (int)blockIdx.x);
            pg8::EpiBf16 E{(bf16_t*)(P->ws + WS_R1), PROJ};
            pg8::gemm_phase(F.lds, g, S, E);)
        SEAM(base + 1);
        PHASE(base + 2, SITE phase_lru<false>(P, F, l);)
        PHASE(base + 2, SITE phase_hgrn<false>(P, F, l);)
        SEAM(base + 2);
        PHASE(base + 3, SITE phase_lru<true>(P, F, l);)
        if (IN(base + 3)) { SITE phase_hgrn_prefix(P, F, l); }
        SEAM(base + 3);
        PHASE(base + 4, SITE phase_hgrn<true>(P, F, l);)
        SEAM(base + 4);
        PHASE(base + 5, SITE
            pg8::Gemm g{(const bf16_t*)(P->ws + WS_R3), (const bf16_t*)(P->ws + WS_WOUT) + (size_t)l * DM * DM, MTOK, DM, DM};
            pg8::StaticOrder S; S.init(MTOK, DM, F.G, (int)blockIdx.x);
            pg8::EpiResid<l == 0> E{(l == 0) ? (const void*)P->x : (const void*)P->out, (bf16_t*)(P->ws + WS_XA), (const float*)(P->ws + WS_MOD) + (size_t)l * NB * 6 * DM + 2 * DM};
            pg8::gemm_phase(F.lds, g, S, E);)
        SEAM(base + 5);
        PHASE(base + 6, SITE phase_route(P, F, l);)
        SEAM(base + 6);
        PHASE(base + 7, SITE
            build_tile_table(P, F, l);
            pg8::Gemm g{(const bf16_t*)(P->ws + WS_R2), (const bf16_t*)(P->ws + WS_WGU) + (size_t)l * NEXP * 1024 * DM, MTOK, NEXP * 1024, DM};
            pg8::MoeOrder S{(const LAS int*)(F.lds + LDS_MISC + 256)};
            pg8::EpiGateUp E{(bf16_t*)(P->ws + WS_R1)};
            pg8::gemm_phase_gather(F.lds, g, S, E, (const LAS int*)(F.lds + LDS_MISC + 1024));)
        SEAM(base + 7);
        PHASE(base + 8, SITE
            build_tile_table(P, F, l);
            pg8::Gemm g{(const bf16_t*)(P->ws + WS_R1), (const bf16_t*)(P->ws + WS_WD) + (size_t)l * NEXP * 1024 * DEXP, MPAD, NEXP * 1024, DEXP};
            pg8::MoeOrder S{(const LAS int*)(F.lds + LDS_MISC + 256)};
            pg8::EpiDown E{(bf16_t*)(P->ws + WS_R1 + WS_R1_Y), (const LAS int*)(F.lds + LDS_MISC + 1024), (const LAS float*)(F.lds + LDS_MISC + 5120)};
            pg8::gemm_phase(F.lds, g, S, E);)
        SEAM(base + 8);
        PHASE(base + 9, SITE if (l == DEPTH - 1) phase_combine<true>(P, F, l, nullptr); else phase_combine<false>(P, F, l, (bf16_t*)P->out);)
        SEAM(base + 9);
    }

__global__ void __launch_bounds__(NTHREADS, 2) mega(Params p_unused) {
    (void)p_unused;
    extern __shared__ __attribute__((aligned(16))) unsigned char lds_raw[];
    LAS unsigned char* const lds = (LAS unsigned char*)lds_raw;
    int lo, hi; XcdBarrier bar; unsigned long long tstamp[2] = {0ull, 0ull};
    { KParams P = get_params(); lo = (int)P->ph_lo; hi = (int)P->ph_hi;
      if (threadIdx.x < 12) ((LAS unsigned*)(lds + LDS_MISC))[threadIdx.x] = 0u;
      __syncthreads();
      bar.bar = (unsigned*)(P->ws + WS_CTL); bar.x = 0; bar.st = nullptr;
      if (hi - lo > 1) bar = xcd_barrier_post((unsigned*)(P->ws + WS_CTL), (volatile LAS unsigned*)(lds + LDS_MISC)); }

    PHASE(0, SITE phase_prologue(P, F);)
    SEAM(0);
    run_layer<0>(lds, lo, hi, bar, tstamp);
    run_layer<1>(lds, lo, hi, bar, tstamp);
    if constexpr (DBG_TA >= 0) { if (blockIdx.x == 0 && threadIdx.x == 0) { const LAS unsigned long long* ts_ = (const LAS unsigned long long*)(lds + LDS_MISC + 32);
        const unsigned long long dt = (ts_[1] - ts_[0]) * 10ull, t0 = __builtin_amdgcn_s_memrealtime();
        while (__builtin_amdgcn_s_memrealtime() - t0 < dt) __builtin_amdgcn_s_sleep(8); } }
    if constexpr (DBG_TIMEPH >= 0) { if (blockIdx.x == 0 && threadIdx.x == 0) { const unsigned long long dt = (tstamp[1] - tstamp[0]) * 10ull, t0 = __builtin_amdgcn_s_memrealtime();
        while (__builtin_amdgcn_s_memrealtime() - t0 < dt) __builtin_amdgcn_s_sleep(8); } }
#undef IN
#undef SEAM
#undef SITE
}

extern "C" void kernel_launch(void* const* d_in, const int* in_sizes, int n_in, void* d_out, int out_size, void* d_ws, size_t ws_size, hipStream_t stream) {
    static int grid = 0;
    if (grid == 0) {
        if (n_in != 26 || in_sizes[0] != MTOK * DM || out_size != MTOK * DM || ws_size < WS_END) {
            fprintf(stderr, "kernel_launch: unexpected shapes (n_in %d, in0 %d, out %d, ws %zu, need %zu); nothing launched\n", n_in, n_in > 0 ? in_sizes[0] : -1, out_size, ws_size, (size_t)WS_END); grid = -1; return; }
        int dev = 0, cus = 0, per_cu = 0;
        if (hipGetDevice(&dev) != hipSuccess || hipDeviceGetAttribute(&cus, hipDeviceAttributeMultiprocessorCount, dev) != hipSuccess) { fprintf(stderr, "kernel_launch: device query failed\n"); grid = -1; return; }
        if (hipFuncSetAttribute((const void*)mega, hipFuncAttributeMaxDynamicSharedMemorySize, LDS_BYTES) != hipSuccess) { fprintf(stderr, "kernel_launch: hipFuncSetAttribute failed\n"); grid = -1; return; }
        if (hipOccupancyMaxActiveBlocksPerMultiprocessor(&per_cu, (const void*)mega, NTHREADS, LDS_BYTES) != hipSuccess || per_cu < 1)
            fprintf(stderr, "kernel_launch: note: occupancy query reports %d workgroups per CU\n", per_cu);
        (void)hipGetLastError();
        grid = cus;
    }
    if (grid < 0) return;
    if (hipMemsetAsync((char*)d_ws + WS_CTL, 0, CTL_ZERO_BYTES, stream) != hipSuccess) { fprintf(stderr, "kernel_launch: memset failed\n"); return; }
    Params p{};
    const float** pf = (const float**)&p;
    for (int i = 0; i < 26; ++i) pf[i] = (const float*)d_in[i];
    p.out = (float*)d_out; p.ws = (unsigned char*)d_ws;
#if MK_PER_PHASE
    for (int ph = 0; ph < N_PHASES; ++ph) { p.ph_lo = ph; p.ph_hi = ph + 1;
        hipLaunchKernelGGL(mega, dim3(grid), dim3(NTHREADS), LDS_BYTES, stream, p);
        const hipError_t le = hipPeekAtLastError();
        if (le != hipSuccess) { fprintf(stderr, "kernel_launch: launch %d failed: %s\n", ph, hipGetErrorName(le)); break; } }
#else
    p.ph_lo = 0; p.ph_hi = N_PHASES;
    hipLaunchKernelGGL(mega, dim3(grid), dim3(NTHREADS), LDS_BYTES, stream, p);
    const hipError_t le = hipPeekAtLastError();
    if (le != hipSuccess) fprintf(stderr, "kernel_launch: launch failed: %s\n", hipGetErrorName(le));
#endif
}
```
